# Optimizing an MI355X kernel written in HIP

```python
import math
import jax
import jax.numpy as jnp
from jax import lax
import numpy as np

D_MODEL = 1024
BATCH = 32
SEQ = 256
DEPTH = 2
DEC_BATCH = 4
DEC_SEQ = 2048
PAST_LEN = 256

GRID_W = 64
MIX_W = D_MODEL // 2
N_BRANCH = 3
A_HEADS = 4
A_HEAD_DIM = MIX_W // (2 * A_HEADS)
ROPE_THETA = 10000.0
Q_BLOCK = 128
B_HEADS = 4
B_VDIM = MIX_W // B_HEADS
B_KDIM = B_VDIM // 2
GLA_RANK = 16
GLA_TAU = 16.0
GLA_CHUNK = 32
S5_W = MIX_W
S5_GROUP = 16
S5_G = S5_W // S5_GROUP
S5_P = 64
FFN_DIM = -(-8 * D_MODEL // (3 * 256)) * 256
EPS = 1e-6
IN_WIDTHS = (MIX_W, MIX_W, MIX_W, B_HEADS * B_KDIM, B_HEADS * B_KDIM, MIX_W, MIX_W, 2 * GLA_RANK, S5_W, N_BRANCH * D_MODEL)
IN_DIM = sum(IN_WIDTHS)

kernel_name = "hybrid_diffattn_gla_s5_dit_step"


def rms_norm(x, g):
    xf = x.astype(jnp.float32)
    return xf * lax.rsqrt(jnp.mean(xf * xf, axis=-1, keepdims=True) + EPS) * g


def split_cols(z):
    idx = [int(i) for i in np.cumsum(IN_WIDTHS)[:-1]]
    return jnp.split(z, idx, axis=-1)


def axial_rope_tables(n_tok):
    rows = n_tok // GRID_W
    t = jnp.arange(rows * GRID_W)
    row = (t // GRID_W).astype(jnp.float32)
    col = (t % GRID_W).astype(jnp.float32)
    half = A_HEAD_DIM // 2
    inv = ROPE_THETA ** (-jnp.arange(0, half, 2, dtype=jnp.float32) / half)
    ang = jnp.concatenate([row[:, None] * inv, col[:, None] * inv], axis=-1)
    return jnp.cos(ang), jnp.sin(ang)


def apply_axial_rope(x, cos, sin):
    half = A_HEAD_DIM // 2
    q4 = half // 2
    c = cos[None, :, None, None, :]
    s = sin[None, :, None, None, :]

    def rot(xp, cp, sp):
        x1, x2 = xp[..., :q4], xp[..., q4:]
        return jnp.concatenate([x1 * cp - x2 * sp, x2 * cp + x1 * sp], axis=-1)

    return jnp.concatenate([rot(x[..., :half], c[..., :q4], s[..., :q4]),
                            rot(x[..., half:], c[..., q4:], s[..., q4:])], axis=-1)


def diff_attention(q, k, v, lam):
    bsz, lq, nh, _, d = q.shape
    nb = lq // Q_BLOCK
    qb = q.astype(jnp.float32).reshape(bsz, nb, Q_BLOCK, nh, 2, d).swapaxes(0, 1)
    kf = k.astype(jnp.float32)
    vf = v.astype(jnp.float32)
    scale = d ** -0.5

    def block(qblk):
        s = jnp.einsum('bqhmd,bkhmd->bhmqk', qblk, kf) * scale
        p = jax.nn.softmax(s, axis=-1)
        w = p[:, :, 0] - lam * p[:, :, 1]
        return jnp.einsum('bhqk,bkhe->bqhe', w, vf)

    o = lax.map(block, qb)
    return o.swapaxes(0, 1).reshape(bsz, lq, nh, 2 * d)


def gla_chunked(q, k, v, log_a, s0):
    bsz, n_tok, nh, dk = q.shape
    dv = v.shape[-1]
    n = n_tok // GLA_CHUNK
    f32 = jnp.float32
    q = q.astype(f32).reshape(bsz, n, GLA_CHUNK, nh, dk)
    k = k.astype(f32).reshape(bsz, n, GLA_CHUNK, nh, dk)
    v = v.astype(f32).reshape(bsz, n, GLA_CHUNK, nh, dv)
    bc = jnp.cumsum(log_a.astype(f32).reshape(bsz, n, GLA_CHUNK, nh, dk), axis=2)
    rel = bc[:, :, :, None] - bc[:, :, None, :]
    causal = jnp.tril(jnp.ones((GLA_CHUNK, GLA_CHUNK), dtype=bool))[None, None, :, :, None, None]
    decay = jnp.where(causal, jnp.exp(jnp.minimum(rel, 0.0)), 0.0)
    attn = jnp.einsum('bnthk,bnshk,bntshk->bnhts', q, k, decay)
    intra = jnp.einsum('bnhts,bnshv->bnthv', attn, v)
    b_last = bc[:, :, -1]
    kdec = k * jnp.exp(b_last[:, :, None] - bc)
    ds = jnp.einsum('bnchk,bnchv->nbhkv', kdec, v)

    def step(state, inp):
        dec, d_state = inp
        return dec[..., None] * state + d_state, state

    s_final, s_start = lax.scan(step, s0.astype(f32), (jnp.exp(b_last).swapaxes(0, 1), ds))
    inter = jnp.einsum('bnchk,nbhkv->bnchv', q * jnp.exp(bc), s_start)
    return (intra + inter).reshape(bsz, n_tok, nh, dv), s_final


def complex_affine_combine(e1, e2):
    a1r, a1i, b1r, b1i = e1
    a2r, a2i, b2r, b2i = e2
    return (a2r * a1r - a2i * a1i, a2r * a1i + a2i * a1r,
            a2r * b1r - a2i * b1i + b2r, a2r * b1i + a2i * b1r + b2i)


def s5_scan(u, lam_re, lam_im, log_dt, b_re, b_im, c_re, c_im, h0, reverse):
    f32 = jnp.float32
    dt = jnp.exp(log_dt.astype(f32))[:, None]
    lr = lam_re.astype(f32)
    li = lam_im.astype(f32)
    mag = jnp.exp(lr * dt)
    ar = mag * jnp.cos(li * dt)
    ai = mag * jnp.sin(li * dt)
    den = lr * lr + li * li
    fr = ((ar - 1.0) * lr + ai * li) / den
    fi = (ai * lr - (ar - 1.0) * li) / den
    bbr = fr[..., None] * b_re - fi[..., None] * b_im
    bbi = fr[..., None] * b_im + fi[..., None] * b_re
    bu_r = jnp.einsum('gpi,blgi->blgp', bbr, u)
    bu_i = jnp.einsum('gpi,blgi->blgp', bbi, u)
    a_r = jnp.broadcast_to(ar, bu_r.shape)
    a_i = jnp.broadcast_to(ai, bu_r.shape)
    pr, pim, hr, hi = lax.associative_scan(complex_affine_combine, (a_r, a_i, bu_r, bu_i), axis=1, reverse=reverse)
    h0 = h0.astype(f32)
    h0r = h0[:, 0][:, None]
    h0i = h0[:, 1][:, None]
    hr = pr * h0r - pim * h0i + hr
    hi = pr * h0i + pim * h0r + hi
    y = jnp.einsum('gip,blgp->blgi', c_re, hr) - jnp.einsum('gip,blgp->blgi', c_im, hi)
    idx = 0 if reverse else -1
    return y, jnp.stack([hr[:, idx], hi[:, idx]], axis=1)


def trunk_layer(x, cond, p, lam_init, ctx, rope):
    bsz, n_tok, _ = x.shape
    dtype = x.dtype
    f32 = jnp.float32
    mod = jax.nn.silu(cond.astype(f32)) @ p['w_mod'] + p['b_mod']
    sh1, sc1, g1, sh2, sc2, g2 = jnp.split(mod[:, None, :], 6, axis=-1)
    h = rms_norm(x, p['norm1_g']) * (1.0 + sc1) + sh1
    aq, ak, av, bq, bk, bv, bg, br, cu, gz = split_cols(h @ p['w_in'])

    aq = rms_norm(aq.reshape(bsz, n_tok, A_HEADS, 2, A_HEAD_DIM), p['diff_qn_g'])
    ak = rms_norm(ak.reshape(bsz, n_tok, A_HEADS, 2, A_HEAD_DIM), p['diff_kn_g'])
    av = av.reshape(bsz, n_tok, A_HEADS, 2 * A_HEAD_DIM)
    lv = p['diff_lam']
    lam = jnp.exp(jnp.sum(lv[0] * lv[1])) - jnp.exp(jnp.sum(lv[2] * lv[3])) + lam_init
    if ctx is None:
        keys, vals = ak, av
    else:
        cos, sin = rope
        aq = apply_axial_rope(aq, cos, sin)
        keys = jnp.concatenate([ctx['k'], apply_axial_rope(ak, cos, sin)], axis=1)
        vals = jnp.concatenate([ctx['v'], av], axis=1)
    oa = diff_attention(aq, keys, vals, lam)
    oa = (rms_norm(oa, p['diff_subln_g']) * (1.0 - lam_init)).reshape(bsz, n_tok, MIX_W)

    bq = bq.reshape(bsz, n_tok, B_HEADS, B_KDIM) * (B_KDIM ** -0.5)
    bk = bk.reshape(bsz, n_tok, B_HEADS, B_KDIM)
    bv = bv.reshape(bsz, n_tok, B_HEADS, B_VDIM)
    r_f, r_b = jnp.split(br, 2, axis=-1)
    la_f = (jax.nn.log_sigmoid(r_f @ p['gla_wa2'][0] + p['gla_ba'][0]) / GLA_TAU).reshape(bsz, n_tok, B_HEADS, B_KDIM)
    la_b = (jax.nn.log_sigmoid(r_b @ p['gla_wa2'][1] + p['gla_ba'][1]) / GLA_TAU).reshape(bsz, n_tok, B_HEADS, B_KDIM)
    s0 = jnp.zeros((bsz, 2, B_HEADS, B_KDIM, B_VDIM), f32) if ctx is None else ctx['gla']
    flip = lambda t: jnp.flip(t, axis=1)
    o_f, s_f = gla_chunked(bq, bk, bv, la_f, s0[:, 0])
    o_b, s_b = gla_chunked(flip(bq), flip(bk), flip(bv), flip(la_b), s0[:, 1])
    ob = rms_norm(o_f + flip(o_b), p['gla_on_g']) * jax.nn.silu(bg.reshape(bsz, n_tok, B_HEADS, B_VDIM))
    ob = ob.reshape(bsz, n_tok, MIX_W)

    u = cu.astype(f32).reshape(bsz, n_tok, S5_G, S5_GROUP)
    h0 = jnp.zeros((bsz, 2, 2, S5_G, S5_P), f32) if ctx is None else ctx['s5']
    y_f, hf = s5_scan(u, p['s5_lam_re'][0], p['s5_lam_im'][0], p['s5_log_dt'][0], p['s5_b_re'][0], p['s5_b_im'][0],
                      p['s5_c_re'][0], p['s5_c_im'][0], h0[:, 0], False)
    y_b, hb = s5_scan(u, p['s5_lam_re'][1], p['s5_lam_im'][1], p['s5_log_dt'][1], p['s5_b_re'][1], p['s5_b_im'][1],
                      p['s5_c_re'][1], p['s5_c_im'][1], h0[:, 1], True)
    yc = jax.nn.gelu((y_f + y_b).reshape(bsz, n_tok, S5_W) + p['s5_d'] * cu)
    glu_a, glu_b = jnp.split(yc @ p['s5_w_glu'] + p['s5_b_glu'], 2, axis=-1)
    oc = glu_a * jax.nn.sigmoid(glu_b)

    branches = jnp.einsum('blrm,rmd->blrd', jnp.stack([oa, ob, oc], axis=2), p['w_branch'])
    gates = jax.nn.sigmoid(gz.reshape(bsz, n_tok, N_BRANCH, D_MODEL))
    merged = jnp.sum(gates * branches, axis=2)
    x = x + g1 * (merged @ p['w_out'])

    h = rms_norm(x, p['norm2_g']) * (1.0 + sc2) + sh2
    x = x + g2 * ((jax.nn.silu(h @ p['w_ffn_gate']) * (h @ p['w_ffn_up'])) @ p['w_ffn_down'])
    x = x.astype(dtype)
    if ctx is None:
        return x, (ak, av, jnp.stack([s_f, s_b], axis=1), jnp.stack([hf, hb], axis=1))
    return x, None


def setup_inputs(seed: int = 0) -> dict:
    key = jax.random.key(seed)
    keys = jax.random.split(key, 48)
    counter = iter(range(48))
    f32 = jnp.float32

    def nrm(shape, scale):
        return jax.random.normal(keys[next(counter)], shape, f32) * scale

    def gain(shape):
        return 1.0 + nrm(shape, 0.02)

    return {
        'x_prompt': nrm((BATCH, SEQ, D_MODEL), 1.0),
        'x_sample': nrm((DEC_BATCH, DEC_SEQ, D_MODEL), 1.0),
        'cache_diff_k': nrm((DEC_BATCH, DEPTH, PAST_LEN, A_HEADS, 2, A_HEAD_DIM), 1.0),
        'cache_diff_v': nrm((DEC_BATCH, DEPTH, PAST_LEN, A_HEADS, 2 * A_HEAD_DIM), 1.0),
        'state_gla': nrm((DEC_BATCH, DEPTH, 2, B_HEADS, B_KDIM, B_VDIM), 1.0),
        'state_s5': nrm((DEC_BATCH, DEPTH, 2, 2, S5_G, S5_P), 0.1),
        'c': nrm((DEC_BATCH, D_MODEL), 1.0),
        'c_ctx': nrm((D_MODEL,), 1.0),
        'w_mod': nrm((DEPTH, D_MODEL, 6 * D_MODEL), D_MODEL ** -0.5),
        'b_mod': nrm((DEPTH, 6 * D_MODEL), 0.02),
        'norm1_g': gain((DEPTH, D_MODEL)),
        'norm2_g': gain((DEPTH, D_MODEL)),
        'w_in': nrm((DEPTH, D_MODEL, IN_DIM), D_MODEL ** -0.5),
        'diff_qn_g': gain((DEPTH, A_HEAD_DIM)),
        'diff_kn_g': gain((DEPTH, A_HEAD_DIM)),
        'diff_lam': nrm((DEPTH, 4, A_HEAD_DIM), 0.1),
        'diff_subln_g': gain((DEPTH, 2 * A_HEAD_DIM)),
        'gla_wa2': nrm((DEPTH, 2, GLA_RANK, B_HEADS * B_KDIM), GLA_RANK ** -0.5),
        'gla_ba': nrm((DEPTH, 2, B_HEADS * B_KDIM), 0.1),
        'gla_on_g': gain((DEPTH, B_VDIM)),
        's5_lam_re': -0.5 + nrm((DEPTH, 2, S5_G, S5_P), 0.01),
        's5_lam_im': math.pi * jnp.arange(S5_P, dtype=f32) + nrm((DEPTH, 2, S5_G, S5_P), 0.01),
        's5_log_dt': jax.random.uniform(keys[next(counter)], (DEPTH, 2, S5_G), f32, minval=math.log(1e-3), maxval=math.log(1e-1)),
        's5_b_re': nrm((DEPTH, 2, S5_G, S5_P, S5_GROUP), (2 * S5_GROUP) ** -0.5),
        's5_b_im': nrm((DEPTH, 2, S5_G, S5_P, S5_GROUP), (2 * S5_GROUP) ** -0.5),
        's5_c_re': nrm((DEPTH, 2, S5_G, S5_GROUP, S5_P), S5_P ** -0.5),
        's5_c_im': nrm((DEPTH, 2, S5_G, S5_GROUP, S5_P), S5_P ** -0.5),
        's5_d': nrm((DEPTH, S5_W), 1.0),
        's5_w_glu': nrm((DEPTH, S5_W, 2 * S5_W), S5_W ** -0.5),
        's5_b_glu': nrm((DEPTH, 2 * S5_W), 0.02),
        'w_branch': nrm((DEPTH, N_BRANCH, MIX_W, D_MODEL), MIX_W ** -0.5),
        'w_out': nrm((DEPTH, D_MODEL, D_MODEL), D_MODEL ** -0.5),
        'w_ffn_gate': nrm((DEPTH, D_MODEL, FFN_DIM), D_MODEL ** -0.5),
        'w_ffn_up': nrm((DEPTH, D_MODEL, FFN_DIM), D_MODEL ** -0.5),
        'w_ffn_down': nrm((DEPTH, FFN_DIM, D_MODEL), FFN_DIM ** -0.5),
    }


def reference(x_prompt, x_sample, cache_diff_k, cache_diff_v, state_gla, state_s5, c, c_ctx,
              w_mod, b_mod, norm1_g, norm2_g, w_in, diff_qn_g, diff_kn_g, diff_lam, diff_subln_g,
              gla_wa2, gla_ba, gla_on_g, s5_lam_re, s5_lam_im, s5_log_dt, s5_b_re, s5_b_im,
              s5_c_re, s5_c_im, s5_d, s5_w_glu, s5_b_glu, w_branch, w_out, w_ffn_gate, w_ffn_up, w_ffn_down):
    weights = dict(w_mod=w_mod, b_mod=b_mod, norm1_g=norm1_g, norm2_g=norm2_g, w_in=w_in,
                   diff_qn_g=diff_qn_g, diff_kn_g=diff_kn_g, diff_lam=diff_lam, diff_subln_g=diff_subln_g,
                   gla_wa2=gla_wa2, gla_ba=gla_ba, gla_on_g=gla_on_g,
                   s5_lam_re=s5_lam_re, s5_lam_im=s5_lam_im, s5_log_dt=s5_log_dt,
                   s5_b_re=s5_b_re, s5_b_im=s5_b_im, s5_c_re=s5_c_re, s5_c_im=s5_c_im,
                   s5_d=s5_d, s5_w_glu=s5_w_glu, s5_b_glu=s5_b_glu,
                   w_branch=w_branch, w_out=w_out,
                   w_ffn_gate=w_ffn_gate, w_ffn_up=w_ffn_up, w_ffn_down=w_ffn_down)
    cond_ctx = jnp.broadcast_to(c_ctx, (x_prompt.shape[0], c_ctx.shape[-1]))
    rope = axial_rope_tables(x_sample.shape[1])
    y_prompt, y_sample = x_prompt, x_sample
    k_list, v_list, gla_list, s5_list = [], [], [], []
    for l in range(DEPTH):
        p = {name: w[l] for name, w in weights.items()}
        lam_init = 0.8 - 0.6 * math.exp(-0.3 * l)
        y_prompt, (k_l, v_l, g_l, s_l) = trunk_layer(y_prompt, cond_ctx, p, lam_init, None, None)
        k_list.append(k_l)
        v_list.append(v_l)
        gla_list.append(g_l)
        s5_list.append(s_l)
        ctx = dict(k=cache_diff_k[:, l], v=cache_diff_v[:, l], gla=state_gla[:, l], s5=state_s5[:, l])
        y_sample, _ = trunk_layer(y_sample, c, p, lam_init, ctx, rope)
    new_diff_k = jnp.stack(k_list, axis=1)
    new_diff_v = jnp.stack(v_list, axis=1)
    new_gla_state = jnp.stack(gla_list, axis=1)
    new_s5_state = jnp.stack(s5_list, axis=1)
    return (y_prompt, y_sample, new_diff_k, new_diff_v, new_gla_state, new_s5_state)
```

```cpp
#include <hip/hip_runtime.h>
#include <stdint.h>
#include <cstdio>

typedef unsigned short bf16_t;
typedef short bf16x8 __attribute__((ext_vector_type(8)));
typedef float f32x4 __attribute__((ext_vector_type(4)));
#define LAS __attribute__((address_space(3)))

constexpr int D = 1024, NPROMPT = 8192, M = 16384;
constexpr int SEQ = 256, DSEQ = 2048;
constexpr int IN_DIM = 6688, FFN = 2816;
constexpr float EPS = 1e-6f;
constexpr int C_AQ = 0, C_AK = 512, C_AV = 1024, C_BQ = 1536, C_BK = 1792, C_BV = 2048, C_BG = 2560, C_BR = 3072, C_CU = 3104, C_GZ = 3616;
constexpr int N_MIX = 3616;
constexpr size_t O_YP = 0, O_YS = 8388608, O_NK = 16777216, O_NV = 25165824, O_NG = 33554432, O_NS = 37748736;

constexpr size_t MiB = 1u << 20;
constexpr size_t W_CTL = 0, CTL_BYTES = 65536;
constexpr size_t W_MOD = 65536;
constexpr size_t W_MISC = 65536 + 262144;
constexpr size_t W_XN = 1 * MiB;
constexpr size_t W_AQ = 33 * MiB;
constexpr size_t W_AK = 49 * MiB;
constexpr size_t W_AV = 66 * MiB;
constexpr size_t W_BQ = 83 * MiB;
constexpr size_t W_BK = 91 * MiB;
constexpr size_t W_BV = 99 * MiB;
constexpr size_t W_BG = 115 * MiB;
constexpr size_t W_BR = 131 * MiB;
constexpr size_t W_CU = 133 * MiB;
constexpr size_t W_GF = 149 * MiB;
constexpr size_t W_GB = 165 * MiB;
constexpr size_t W_YF = 181 * MiB;
constexpr size_t W_OA = 197 * MiB;
constexpr size_t W_OB = 213 * MiB;
constexpr size_t W_OC = 229 * MiB;
constexpr size_t W_GATES = 245 * MiB;
constexpr size_t W_GDS = 149 * MiB;
constexpr size_t W_GLA = 245 * MiB;
constexpr size_t W_MERGED = 341 * MiB;
constexpr size_t W_H = 373 * MiB;
constexpr size_t W_MF = W_H;
constexpr size_t W_WB = 461 * MiB;
constexpr size_t WB_LAYER = 36 * MiB;
constexpr size_t WB_WI = 0, WB_WZ = WB_WI + 3840 * 1024 * 2, WB_WG = WB_WZ + 3072 * 1024 * 2, WB_WR = WB_WG + 1024 * 512 * 2, WB_WO = WB_WR + 3 * 1024 * 512 * 2,
                 WB_WU = WB_WO + 1024 * 1024 * 2, WB_WD = WB_WU + 5632 * 1024 * 2;
static_assert(WB_WD + 1024 * 2816 * 2 == WB_LAYER, "weight copy map");
constexpr size_t W_TAB0 = 373 * MiB;
constexpr size_t W_UH = 405 * MiB;
constexpr size_t W_HLOC = 429 * MiB;
constexpr size_t W_TAB1 = 533 * MiB;
constexpr size_t W_ATAB = 524288;
constexpr size_t W_KG = 565 * MiB;
constexpr size_t W_KAUX = 569 * MiB;
constexpr size_t W_XB0 = 133 * MiB;
constexpr size_t W_XB1 = 565 * MiB;
constexpr size_t W_END = 581 * MiB;

constexpr int NT = 512, NWAVE = 8;
constexpr int LDS_BYTES = 163840;
constexpr int LDS_MISC = 163840 - 256;

__device__ __forceinline__ float bf2f(bf16_t h) { return __uint_as_float((unsigned)h << 16); }
typedef float f32x2_t __attribute__((ext_vector_type(2)));
typedef __bf16 bf16x2_t __attribute__((ext_vector_type(2)));
__device__ __forceinline__ unsigned pk2(float lo, float hi) { const f32x2_t v = {lo, hi}; return __builtin_bit_cast(unsigned, __builtin_convertvector(v, bf16x2_t)); }
__device__ __forceinline__ unsigned pk2_valu(float lo, float hi) { unsigned r; asm("v_cvt_pk_bf16_f32 %0, %1, %2" : "=v"(r) : "v"(lo), "v"(hi)); return r; }
__device__ __forceinline__ bf16_t f2bf(float f) { return (bf16_t)(pk2(f, 0.f) & 0xffffu); }
__device__ __forceinline__ float shx(float v, int k, int lane) { return __builtin_bit_cast(float, __builtin_amdgcn_ds_bpermute((lane ^ k) << 2, __builtin_bit_cast(int, v))); }
__device__ __forceinline__ float xsum32(float v) { const auto rr = __builtin_amdgcn_permlane32_swap(__float_as_uint(v), __float_as_uint(v), false, false); return __uint_as_float(rr[0]) + __uint_as_float(rr[1]); }
__device__ __forceinline__ float sigmoidf_(float x) { return 1.f / (1.f + __expf(-x)); }
__device__ __forceinline__ float siluf_(float x) { return x / (1.f + __expf(-x)); }
__device__ __forceinline__ float gelu_tanh(float x) { return 0.5f * x * (1.f + tanhf(0.7978845608028654f * (x + 0.044715f * x * x * x))); }
__device__ __forceinline__ int cond_row(int m) { return m < NPROMPT ? 0 : 1 + ((m - NPROMPT) >> 11); }
__device__ __forceinline__ int krow_of(int m) { return m < NPROMPT ? m : NPROMPT + ((m - NPROMPT) >> 11) * 2304 + 256 + ((m - NPROMPT) & 2047); }

#define XB_TMO      128
#define XB_XCNT(j)  (256  + 64 * (j))
#define XB_XSUB(j)  (1280 + 64 * (j))
#define XB_XGEN(j)  (2304 + 64 * (j))
#define XB_TOP      3328
#define XB_TOPGEN   3392
#define XCD_BAR_WORDS 3456
#define XB_SPIN_CAP (1u << 18)
__device__ __forceinline__ unsigned xb_ld(unsigned* p)              { return __hip_atomic_load(p, __ATOMIC_RELAXED, __HIP_MEMORY_SCOPE_AGENT); }
__device__ __forceinline__ unsigned xb_add(unsigned* p, unsigned v) { return __hip_atomic_fetch_add(p, v, __ATOMIC_RELAXED, __HIP_MEMORY_SCOPE_AGENT); }
__device__ __forceinline__ unsigned xb_xcc_id() { return (unsigned)__builtin_amdgcn_s_getreg((3 << 11) | 20) & 0xFu; }
#define XB_SPIN(cond, bar) do { unsigned _sp = 0; while (cond) { __builtin_amdgcn_s_sleep(1); \
    if ((++_sp & 255u) == 0u) { if (xb_ld(&(bar)[XB_TMO])) break; if (_sp > XB_SPIN_CAP) { atomicAdd(&(bar)[XB_TMO], 1u); break; } } } } while (0)
struct XcdBarrier { unsigned* bar; unsigned x; volatile LAS unsigned* st; };
__device__ __forceinline__ XcdBarrier xcd_barrier_post(unsigned* bar, volatile LAS unsigned* st) {
    XcdBarrier b; b.bar = bar; b.x = xb_xcc_id(); b.st = st;
    if (threadIdx.x == 0) (void)xb_add(&bar[XB_XCNT(b.x)], 1u);
    return b;
}
__device__ __forceinline__ void xcd_barrier_complete(unsigned* bar, unsigned x, unsigned& nloc, unsigned& nx) {
    const unsigned G = gridDim.x * gridDim.y * gridDim.z;
    unsigned sum, cnt, mine, sp = 0u;
    for (;;) {
        sum = 0u; cnt = 0u; mine = 0u;
#pragma unroll
        for (unsigned j = 0; j < 16; ++j) { const unsigned c = xb_ld(&bar[XB_XCNT(j)]); sum += c; cnt += (c > 0u) ? 1u : 0u; mine = (j == x) ? c : mine; }
        if (sum == G) break;
        __builtin_amdgcn_s_sleep(1);
        if ((++sp & 255u) == 0u) { if (xb_ld(&bar[XB_TMO])) break; if (sp > XB_SPIN_CAP) { atomicAdd(&bar[XB_TMO], 1u); break; } }
    }
    nloc = mine > 0u ? mine : 1u; nx = cnt > 0u ? cnt : 1u;
}
__device__ __forceinline__ void xcd_barrier(const XcdBarrier& b) {
    asm volatile("s_waitcnt vmcnt(0)" ::: "memory");
    __syncthreads();
    if (threadIdx.x == 0) {
        unsigned* bar = b.bar; asm volatile("" : "+s"(bar));
        unsigned bx = b.x; asm volatile("" : "+s"(bx));
        __builtin_amdgcn_s_waitcnt(0);
        unsigned nloc = b.st[0], nx = b.st[1];
        if (nloc == 0u) { xcd_barrier_complete(bar, bx, nloc, nx); b.st[0] = nloc; b.st[1] = nx; }
        const unsigned old = xb_add(&bar[XB_XSUB(bx)], 1u);
        const unsigned gen = old / nloc;
        if (old + 1u == (gen + 1u) * nloc) {
            __builtin_amdgcn_fence(__ATOMIC_RELEASE, "agent");
            asm volatile("s_waitcnt vmcnt(0)" ::: "memory");
            const unsigned og = xb_add(&bar[XB_TOP], 1u);
            const unsigned tg = og / nx;
            if (og + 1u == (tg + 1u) * nx) xb_add(&bar[XB_TOPGEN], 1u);
            else XB_SPIN(xb_ld(&bar[XB_TOPGEN]) == tg, bar);
            __builtin_amdgcn_fence(__ATOMIC_ACQUIRE, "agent");
            xb_add(&bar[XB_XGEN(bx)], 1u);
            asm volatile("s_waitcnt vmcnt(0)" ::: "memory");
        } else {
            XB_SPIN(xb_ld(&bar[XB_XGEN(bx)]) == gen, bar);
            __builtin_amdgcn_fence(__ATOMIC_ACQUIRE, "agent");
            asm volatile("s_waitcnt vmcnt(0)" ::: "memory");
        }
    }
    __syncthreads();
}

__device__ __forceinline__ int launder_v(int x) { asm volatile("" : "+v"(x)); return x; }
__device__ __forceinline__ int launder_s(int x) { asm volatile("" : "+s"(x)); return x; }
struct Params { const float* in[35]; float* out; unsigned char* ws; };
struct Ctx {
    unsigned char* lds;
    int tid, lane, wave, G, bid;
};
typedef const __attribute__((address_space(4))) Params* KArgPtr;
__device__ __forceinline__ KArgPtr kargs() { KArgPtr p = (KArgPtr)__builtin_amdgcn_kernarg_segment_ptr(); asm volatile("" : "+s"(p)); return p; }
#define PHASE_CTX(C0) KArgPtr Pk = kargs(); Ctx C = (C0); C.tid = launder_v(C0.tid); C.lane = C.tid & 63; C.wave = __builtin_amdgcn_readfirstlane(C.tid >> 6); C.bid = launder_s(C0.bid)
#define GAS __attribute__((address_space(1)))
#define IN_(i) ((const float*)(GAS const float*)(Pk->in[i]))
#define WS_ ((unsigned char*)(GAS unsigned char*)(Pk->ws))
#define OUT_ ((float*)(GAS float*)(Pk->out))
#define WSP(T, off) ((T*)(WS_ + (off)))
#define c_x_prompt IN_(0)
#define c_x_sample IN_(1)
#define c_cache_k IN_(2)
#define c_cache_v IN_(3)
#define c_state_gla IN_(4)
#define c_state_s5 IN_(5)
#define c_c IN_(6)
#define c_c_ctx IN_(7)
#define c_w_mod IN_(8)
#define c_b_mod IN_(9)
#define c_norm1_g IN_(10)
#define c_norm2_g IN_(11)
#define c_w_in IN_(12)
#define c_qn_g IN_(13)
#define c_kn_g IN_(14)
#define c_diff_lam IN_(15)
#define c_subln_g IN_(16)
#define c_gla_wa2 IN_(17)
#define c_gla_ba IN_(18)
#define c_gla_on_g IN_(19)
#define c_s5_lam_re IN_(20)
#define c_s5_lam_im IN_(21)
#define c_s5_log_dt IN_(22)
#define c_s5_b_re IN_(23)
#define c_s5_b_im IN_(24)
#define c_s5_c_re IN_(25)
#define c_s5_c_im IN_(26)
#define c_s5_d IN_(27)
#define c_s5_w_glu IN_(28)
#define c_s5_b_glu IN_(29)
#define c_w_branch IN_(30)
#define c_w_out IN_(31)
#define c_w_gate IN_(32)
#define c_w_up IN_(33)
#define c_w_down IN_(34)
#define c_out OUT_
#define c_X (OUT_ + O_YP)
#define c_MOD WSP(float, W_MOD)
#define c_MISC WSP(float, W_MISC)
#define c_XN WSP(bf16_t, W_XN)
#define c_AQ WSP(bf16_t, W_AQ)
#define c_AK WSP(bf16_t, W_AK)
#define c_AV WSP(bf16_t, W_AV)
#define c_BQ WSP(bf16_t, W_BQ)
#define c_BK WSP(bf16_t, W_BK)
#define c_BV WSP(bf16_t, W_BV)
#define c_BG WSP(bf16_t, W_BG)
#define c_BR WSP(float, W_BR)
#define c_CU WSP(bf16_t, W_CU)
#define c_GF WSP(bf16_t, W_GF)
#define c_GB WSP(bf16_t, W_GB)
#define c_YF WSP(bf16_t, W_YF)
#define c_OA WSP(bf16_t, W_OA)
#define c_OB WSP(bf16_t, W_OB)
#define c_OC WSP(bf16_t, W_OC)
#define c_GATES WSP(bf16_t, W_GATES)
#define c_MERGED WSP(bf16_t, W_MERGED)
#define c_H WSP(bf16_t, W_H)

__device__ __forceinline__ void ph_mod(const Ctx& C0) {
    PHASE_CTX(C0);
    float (*sc)[1024] = (float (*)[1024])C.lds;
    float (*red)[5][64] = (float (*)[5][64])(C.lds + 5 * 1024 * 4);
    for (int item = C.bid; item < 192; item += C.G) {
        const int l = item / 96, n0 = (item % 96) * 64, tid = C.tid;
        __syncthreads();
        for (int i = tid; i < 5 * 1024; i += NT) { const int r = i >> 10, k = i & 1023; const float v = r == 0 ? c_c_ctx[k] : c_c[(r - 1) * 1024 + k]; sc[r][k] = siluf_(v); }
        __syncthreads();
        const int cn = tid & 63, ks = tid >> 6;
        float acc[5] = {0.f, 0.f, 0.f, 0.f, 0.f};
        const float* w = c_w_mod + (size_t)l * 1024 * 6144 + n0 + cn;
        for (int k = ks * 128; k < ks * 128 + 128; ++k) { const float wv = w[(size_t)k * 6144];
#pragma unroll
            for (int r = 0; r < 5; ++r) acc[r] += sc[r][k] * wv; }
#pragma unroll
        for (int r = 0; r < 5; ++r) red[ks][r][cn] = acc[r];
        __syncthreads();
        if (tid < 320) { const int r = tid >> 6, cc = tid & 63; float s = 0.f;
#pragma unroll
            for (int k8 = 0; k8 < 8; ++k8) s += red[k8][r][cc];
            c_MOD[((size_t)l * 5 + r) * 6144 + n0 + cc] = s + c_b_mod[(size_t)l * 6144 + n0 + cc]; }
    }
}
__device__ __forceinline__ void ph_prep(const Ctx& C0) {
    PHASE_CTX(C0);
    if (C.bid != C.G - 1) return;
    const int tid = C.tid; float* misc = c_MISC;
    if (tid < 2) {
        const float* lv = c_diff_lam + tid * 256; float s01 = 0.f, s23 = 0.f;
        for (int i = 0; i < 64; ++i) { s01 += lv[i] * lv[64 + i]; s23 += lv[128 + i] * lv[192 + i]; }
        const float lam_init = 0.8f - 0.6f * expf(-0.3f * (float)tid);
        misc[tid] = expf(s01) - expf(s23) + lam_init;
    }
    for (int i = tid; i < 64 * 16; i += NT) {
        const int pos = i >> 4, f = i & 15;
        const float inv = powf(10000.f, -(float)(2 * f) / 32.f);
        const float ang = (float)pos * inv;
        misc[64 + i] = cosf(ang); misc[64 + 1024 + i] = sinf(ang);
    }
}
__device__ __forceinline__ void ph_cache(const Ctx& C0, int l, int wg0 = 0) {
    PHASE_CTX(C0);
    if (C.bid < wg0) return;
#pragma unroll 4
    for (int i = (C.bid - wg0) * NT + C.tid; i < 4 * 256 * 128; i += (C.G - wg0) * NT) {
        const int col = (i & 127) * 4, j = (i >> 7) & 255, b = i >> 15;
        const size_t src = ((size_t)(b * 2 + l) * 256 + j) * 512 + col;
        const size_t dst = (size_t)(NPROMPT + b * 2304 + j) * 512 + col;
        const f32x4 kx = *(const f32x4*)(c_cache_k + src), vx = *(const f32x4*)(c_cache_v + src);
        uint2 ko, vo; ko.x = pk2(kx[0], kx[1]); ko.y = pk2(kx[2], kx[3]); vo.x = pk2(vx[0], vx[1]); vo.y = pk2(vx[2], vx[3]);
        *(uint2*)(c_AK + dst) = ko; *(uint2*)(c_AV + dst) = vo;
    }
}
__device__ __forceinline__ void ph_norm(const Ctx& C0, const void* x0, const void* x1, bool in_bf16, const float* g, const float* MODl, int which) {
    PHASE_CTX(C0);
    const int lane = C.lane;
    for (int m = C.bid * NWAVE + C.wave; m < M; m += C.G * NWAVE) {
        const size_t ro = m < NPROMPT ? (size_t)m * D : (size_t)(m - NPROMPT) * D;
        const float* mod = MODl + (size_t)cond_row(m) * 6144 + which * 3072;
        float4 v[4]; float ss = 0.f;
        if (in_bf16) { const bf16_t* xr = (const bf16_t*)(m < NPROMPT ? x0 : x1) + ro;
#pragma unroll
            for (int j = 0; j < 4; ++j) { const uint2 w = *(const uint2*)(xr + j * 256 + lane * 4);
                v[j] = make_float4(__uint_as_float(w.x << 16), __uint_as_float(w.x & 0xffff0000u), __uint_as_float(w.y << 16), __uint_as_float(w.y & 0xffff0000u)); }
        } else { const float* xr = (const float*)(m < NPROMPT ? x0 : x1) + ro;
#pragma unroll
            for (int j = 0; j < 4; ++j) v[j] = *(const float4*)(xr + j * 256 + lane * 4); }
#pragma unroll
        for (int j = 0; j < 4; ++j) ss += v[j].x * v[j].x + v[j].y * v[j].y + v[j].z * v[j].z + v[j].w * v[j].w;
#pragma unroll
        for (int o = 1; o < 32; o <<= 1) ss += shx(ss, o, lane);
        ss = xsum32(ss);
        const float rs = rsqrtf(ss * (1.f / D) + EPS);
#pragma unroll
        for (int j = 0; j < 4; ++j) {
            const int c0 = j * 256 + lane * 4;
            const float4 gg = *(const float4*)(g + c0), sh = *(const float4*)(mod + c0), sc = *(const float4*)(mod + 1024 + c0);
            ushort4 o;
            o.x = f2bf(v[j].x * rs * gg.x * (1.f + sc.x) + sh.x); o.y = f2bf(v[j].y * rs * gg.y * (1.f + sc.y) + sh.y);
            o.z = f2bf(v[j].z * rs * gg.z * (1.f + sc.z) + sh.z); o.w = f2bf(v[j].w * rs * gg.w * (1.f + sc.w) + sh.w);
            *(ushort4*)(c_XN + (size_t)m * D + c0) = o;
        }
    }
}

typedef float f32x16 __attribute__((ext_vector_type(16)));
typedef short s16x4 __attribute__((ext_vector_type(4)));
typedef unsigned u32x4_t __attribute__((ext_vector_type(4)));
constexpr int AT_KROW = 72;
constexpr int AT_VROW = 68;
constexpr int AT_KBYTES = 2 * 64 * AT_KROW * 2, AT_VBYTES = 128 * AT_VROW * 2, AT_BUF = AT_KBYTES + AT_VBYTES;
__device__ __forceinline__ unsigned pk_bf16(float lo, float hi) { return pk2(lo, hi); }
template <int XM = 0>
__device__ __forceinline__ void ph_attn(const Ctx& C0, int l, int item_lo = 0, int item_hi = 512, int nwg = 0) {
    PHASE_CTX(C0);
    const int tid = C.tid, lane = C.lane, w = C.wave, map = w >> 2, qb = w & 3, r32 = lane & 31, hi = lane >> 5;
    unsigned char* lds = C.lds;
    const float* subg = c_subln_g + l * 128;
    const float lam = c_MISC[l];
    const bf16_t* AKp = c_AK; const bf16_t* AVp = c_AV;
    const int sk_key = tid >> 3, sk_ch = tid & 7;
    const int sv_kp = tid & 31, sv_ec = tid >> 5;
    constexpr int AT_NBUF = 3;
    constexpr float CS = 0.125f * 1.4426950408889634f;
    const int NW = nwg > 0 ? nwg : C.G;
    if (C.bid >= NW) return;
    const int vbid = (NW % 8 == 0) ? (C.bid & 7) * (NW / 8) + (C.bid >> 3) : C.bid;
    for (int item = item_lo + vbid; item < item_hi; item += NW) {
        int m0, kr0, Lk, h;
        if (item < 256) { const int b = item >> 3; h = (item >> 1) & 3; const int q2 = item & 1; m0 = b * 256 + q2 * 128; kr0 = b * 256; Lk = 256; }
        else { const int j = item - 256; const int b = j >> 6; h = (j >> 4) & 3; const int q2 = j & 15; m0 = NPROMPT + b * 2048 + q2 * 128; kr0 = NPROMPT + b * 2304; Lk = 2304; }
        const int NTL = Lk >> 6;
        bf16x8* sQ = (bf16x8*)(lds + AT_NBUF * AT_BUF) + (w * 4) * 64 + lane;
        f32x16 o[4];
#pragma unroll
        for (int eb = 0; eb < 4; ++eb)
#pragma unroll
            for (int r = 0; r < 16; ++r) o[eb][r] = 0.f;
        float mrun = -1e30f, lsum = 0.f, alpha = 1.f, mc = 0.f;
        uint4 kreg0, kreg1, vreg0, vreg1;
        unsigned pfw[16];
#define PF(ks_) __builtin_bit_cast(bf16x8, (u32x4_t){pfw[4 * (ks_)], pfw[4 * (ks_) + 1], pfw[4 * (ks_) + 2], pfw[4 * (ks_) + 3]})
        f32x16 pa0, pa1;
#define AT_LOAD(t_) do { const bf16_t* kp_ = AKp + (size_t)(kr0 + (t_) * 64 + sk_key) * 512 + h * 128 + sk_ch * 16; kreg0 = *(const uint4*)kp_; kreg1 = *(const uint4*)(kp_ + 8); \
            const bf16_t* vp_ = AVp + (size_t)(kr0 + (t_) * 64 + 2 * sv_kp) * 512 + h * 128 + sv_ec * 8; vreg0 = *(const uint4*)vp_; vreg1 = *(const uint4*)(vp_ + 512); } while (0)
#define AT_WRITE(t_) do { unsigned char* wb_ = lds + ((t_) % AT_NBUF) * AT_BUF; \
            bf16_t* kd_ = (bf16_t*)wb_ + ((sk_ch >> 2) * 64 + sk_key) * AT_KROW + (sk_ch & 3) * 16; *(uint4*)kd_ = kreg0; *(uint4*)(kd_ + 8) = kreg1; \
            bf16_t* vt_ = (bf16_t*)(wb_ + AT_KBYTES) + (sv_ec * 8) * AT_VROW + 2 * sv_kp; \
            const unsigned a_[4] = {vreg0.x, vreg0.y, vreg0.z, vreg0.w}, b_[4] = {vreg1.x, vreg1.y, vreg1.z, vreg1.w}; \
            _Pragma("unroll") for (int i = 0; i < 4; ++i) { *(unsigned*)(vt_ + (2 * i) * AT_VROW) = (a_[i] & 0xffffu) | (b_[i] << 16); *(unsigned*)(vt_ + (2 * i + 1) * AT_VROW) = (a_[i] >> 16) | (b_[i] & 0xffff0000u); } } while (0)
#define SB() __builtin_amdgcn_sched_barrier(0)
#define AT_M(P0, P1) do { asm volatile("s_nop 15\n\ts_nop 7" : "+v"(P0), "+v"(P1)); float mt_ = -1e30f; \
            _Pragma("unroll") for (int r = 0; r < 16; ++r) asm("v_max3_f32 %0, %1, %2, %3" : "=v"(mt_) : "v"(mt_), "v"(P0[r]), "v"(P1[r])); \
            { const auto rr_ = __builtin_amdgcn_permlane32_swap(__float_as_uint(mt_), __float_as_uint(mt_), false, false); asm("v_max_f32_e32 %0, %1, %2" : "=v"(mt_) : "v"(__uint_as_float(rr_[0])), "v"(__uint_as_float(rr_[1]))); } \
            float mn_; asm("v_max_f32_e32 %0, %1, %2" : "=v"(mn_) : "v"(mrun), "v"(mt_)); \
            alpha = __builtin_amdgcn_exp2f((mrun - mn_) * CS); mrun = mn_; mc = -mn_ * CS; } while (0)
#define AT_EXP2(P, i_) do { if (XM == 2) { P[i_] = __builtin_fmaf(P[i_], CS, mc); P[(i_) + 1] = __builtin_fmaf(P[(i_) + 1], CS, mc); } else { P[i_] = __builtin_amdgcn_exp2f(__builtin_fmaf(P[i_], CS, mc)); P[(i_) + 1] = __builtin_amdgcn_exp2f(__builtin_fmaf(P[(i_) + 1], CS, mc)); } \
            asm volatile("" : "+v"(P[i_]), "+v"(P[(i_) + 1])); } while (0)
#define AT_X(HASV, tv_, P0, P1) do { const bf16_t* sVt_ = (const bf16_t*)(lds + ((tv_) % AT_NBUF) * AT_BUF + AT_KBYTES) + r32 * AT_VROW + 4 * hi; \
            _Pragma("unroll") for (int eb = 0; eb < 4; ++eb) { s16x4 vl_[4], vh_[4]; \
                if (HASV) { _Pragma("unroll") for (int ks = 0; ks < 4; ++ks) { vl_[ks] = *(const s16x4*)(sVt_ + eb * 32 * AT_VROW + ks * 16); vh_[ks] = *(const s16x4*)(sVt_ + eb * 32 * AT_VROW + ks * 16 + 8); } SB(); } \
                _Pragma("unroll") for (int ks = 0; ks < 4; ++ks) { \
                    if (HASV) { const bf16x8 vf_ = __builtin_shufflevector(vl_[ks], vh_[ks], 0, 1, 2, 3, 4, 5, 6, 7); o[eb] = __builtin_amdgcn_mfma_f32_32x32x16_bf16(vf_, PF(ks), o[eb], 0, 0, 0); } \
                    if (eb < 2) AT_EXP2(P0, eb * 8 + ks * 2); else AT_EXP2(P1, (eb - 2) * 8 + ks * 2); SB(); } } } while (0)
#define AT_Q(t_, P0, P1) do { const bf16_t* sKm_ = (const bf16_t*)(lds + ((t_) % AT_NBUF) * AT_BUF) + (map * 64) * AT_KROW + r32 * AT_KROW + hi * 8; \
            bf16x8 kf0_[4], kf1_[4], qf_[4]; \
            _Pragma("unroll") for (int s4 = 0; s4 < 4; ++s4) { qf_[s4] = sQ[s4 * 64]; kf0_[s4] = *(const bf16x8*)(sKm_ + s4 * 16); kf1_[s4] = *(const bf16x8*)(sKm_ + 32 * AT_KROW + s4 * 16); } \
            _Pragma("unroll") for (int r = 0; r < 16; ++r) { P0[r] = 0.f; P1[r] = 0.f; } SB(); \
            _Pragma("unroll") for (int s4 = 0; s4 < 4; ++s4) { P0 = __builtin_amdgcn_mfma_f32_32x32x16_bf16(kf0_[s4], qf_[s4], P0, 0, 0, 0); P1 = __builtin_amdgcn_mfma_f32_32x32x16_bf16(kf1_[s4], qf_[s4], P1, 0, 0, 0); } } while (0)
#define AT_S(P0, P1) do { float ps_ = 0.f; \
            _Pragma("unroll") for (int c = 0; c < 4; ++c) { ps_ += (P0[4 * c] + P0[4 * c + 1]) + (P0[4 * c + 2] + P0[4 * c + 3]) + (P1[4 * c] + P1[4 * c + 1]) + (P1[4 * c + 2] + P1[4 * c + 3]); \
                pfw[4 * (c >> 1) + (c & 1) * 2] = pk2_valu(P0[4 * c], P0[4 * c + 1]); pfw[4 * (c >> 1) + (c & 1) * 2 + 1] = pk2_valu(P0[4 * c + 2], P0[4 * c + 3]); \
                pfw[8 + 4 * (c >> 1) + (c & 1) * 2] = pk2_valu(P1[4 * c], P1[4 * c + 1]); pfw[8 + 4 * (c >> 1) + (c & 1) * 2 + 1] = pk2_valu(P1[4 * c + 2], P1[4 * c + 3]); } \
            lsum += ps_; } while (0)
#define AT_RESCALE() do { if (__any(alpha != 1.f)) { lsum *= alpha; _Pragma("unroll") for (int eb = 0; eb < 4; ++eb) _Pragma("unroll") for (int r = 0; r < 16; ++r) o[eb][r] *= alpha; } } while (0)
#define AT_STEP(t_) do { \
            if (XM != 5) { AT_Q(t_, pa0, pa1); } AT_M(pa0, pa1); \
            if ((t_) > 0 && XM != 3) { AT_X(true, (t_) - 1, pa0, pa1); } else { AT_X(false, 0, pa0, pa1); } \
            AT_RESCALE(); AT_S(pa0, pa1); \
            if (XM != 6) __syncthreads();                        \
            if ((t_) + 2 < NTL && XM != 4) { AT_WRITE((t_) + 2); if ((t_) + 3 < NTL) AT_LOAD((t_) + 3); } } while (0)
        { const bf16_t* qp = c_AQ + (size_t)(m0 + qb * 32 + r32) * 512 + h * 128 + map * 64 + hi * 8;
#pragma unroll
          for (int s4 = 0; s4 < 4; ++s4) sQ[s4 * 64] = *(const bf16x8*)(qp + s4 * 16); }
        AT_LOAD(0);
        __syncthreads();
        AT_WRITE(0); AT_LOAD(1); AT_WRITE(1); AT_LOAD(2);
        __syncthreads();
        AT_STEP(0); alpha = 1.f;
#pragma unroll 1
        for (int t = 1; t < NTL; ++t) { AT_STEP(t); }
        { const bf16_t* sVt_ = (const bf16_t*)(lds + ((NTL - 1) % AT_NBUF) * AT_BUF + AT_KBYTES) + r32 * AT_VROW + 4 * hi;
#pragma unroll
          for (int eb = 0; eb < 4; ++eb)
#pragma unroll
              for (int ks = 0; ks < 4; ++ks) { const s16x4 lo = *(const s16x4*)(sVt_ + eb * 32 * AT_VROW + ks * 16), hv = *(const s16x4*)(sVt_ + eb * 32 * AT_VROW + ks * 16 + 8);
                  o[eb] = __builtin_amdgcn_mfma_f32_32x32x16_bf16(__builtin_shufflevector(lo, hv, 0, 1, 2, 3, 4, 5, 6, 7), PF(ks), o[eb], 0, 0, 0); } }
#undef PF
#undef AT_Q
#undef AT_S
#undef AT_LOAD
#undef AT_WRITE
#undef SB
#undef AT_M
#undef AT_EXP2
#undef AT_X
#undef AT_RESCALE
#undef AT_STEP
        lsum = xsum32(lsum);
        const float inv = 1.f / lsum;
        __syncthreads();
        float* xb = (float*)lds + (size_t)qb * (32 * 129);
        if (map == 1) {
#pragma unroll
            for (int eb = 0; eb < 4; ++eb)
#pragma unroll
                for (int r = 0; r < 16; ++r) xb[r32 * 129 + eb * 32 + (r & 3) + 8 * (r >> 2) + 4 * hi] = o[eb][r] * inv;
        }
        __syncthreads();
        if (map == 0 && (XM == 0 || lsum == 12345.678f)) {
            float ss = 0.f;
#pragma unroll
            for (int eb = 0; eb < 4; ++eb)
#pragma unroll
                for (int r = 0; r < 16; ++r) { const float d = o[eb][r] * inv - lam * xb[r32 * 129 + eb * 32 + (r & 3) + 8 * (r >> 2) + 4 * hi]; o[eb][r] = d; ss += d * d; }
            ss = xsum32(ss);
            const float lam_init = 0.8f - 0.6f * __expf(-0.3f * (float)l);
            const float rs = rsqrtf(ss * (1.f / 128.f) + EPS) * (1.f - lam_init);
            bf16_t* op = c_OA + (size_t)(m0 + qb * 32 + r32) * 512 + h * 128;
#pragma unroll
            for (int eb = 0; eb < 4; ++eb)
#pragma unroll
                for (int r4 = 0; r4 < 4; ++r4) {
                    const int e0 = eb * 32 + 8 * r4 + 4 * hi;
                    uint2 wv;
                    wv.x = pk_bf16(o[eb][4 * r4] * rs * subg[e0], o[eb][4 * r4 + 1] * rs * subg[e0 + 1]);
                    wv.y = pk_bf16(o[eb][4 * r4 + 2] * rs * subg[e0 + 2], o[eb][4 * r4 + 3] * rs * subg[e0 + 3]);
                    *(uint2*)(op + e0) = wv;
                }
        }
    }
}

constexpr int GT = 64;
constexpr size_t G_QK = 0;
constexpr size_t G_KDT = 48 * MiB;
constexpr size_t G_VT = 64 * MiB;
constexpr size_t G_SST = 80 * MiB;
constexpr size_t G_DEC = 112 * MiB;
constexpr size_t G_CQB = 112 * MiB + 524288;
__device__ __forceinline__ void ph_gla_prep(const Ctx& C0, int l) {
    PHASE_CTX(C0);
    const int tid = C.tid, dir = tid >> 8, h = (tid >> 6) & 3, kc = tid & 63, c = h * 64 + kc;
    float* sBR = (float*)C.lds;
    float* sPre = (float*)(C.lds + 8192);
    unsigned char* gb = WS_ + W_GLA;
    float wa[16];
#pragma unroll
    for (int r = 0; r < 16; ++r) wa[r] = c_gla_wa2[(((size_t)l * 2 + dir) * 16 + r) * 256 + c];
    const float bias = c_gla_ba[((size_t)l * 2 + dir) * 256 + c];
    bf16_t* QA = (bf16_t*)(gb + G_QK + (size_t)(dir * 3 + 0) * 8 * MiB); bf16_t* KA = (bf16_t*)(gb + G_QK + (size_t)(dir * 3 + 1) * 8 * MiB);
    for (int gc = C.bid; gc < 256; gc += C.G) {
        const int m0 = gc * GT;
        __syncthreads();
        { const float4* src = (const float4*)(c_BR + (size_t)m0 * 32); ((float4*)sBR)[tid] = src[tid]; }
        __syncthreads();
        float run = 0.f;
#pragma unroll 4
        for (int t = 0; t < 64; ++t) {
            float x = bias;
#pragma unroll
            for (int r = 0; r < 16; ++r) x += sBR[t * 32 + dir * 16 + r] * wa[r];
            const float ls = fminf(x, 0.f) - __logf(1.f + __expf(-fabsf(x)));
            run += ls * (1.f / 16.f); sPre[t * 512 + tid] = run;
        }
        const float p31 = sPre[31 * 512 + tid], p63 = run;
        const float cqb = __expf(dir == 0 ? p31 : p63 - p31), ckd = __expf(dir == 0 ? p63 - p31 : p31);
        bf16_t* KDT = (bf16_t*)(gb + G_KDT) + ((((size_t)gc * 4 + h) * 2 + dir) * 64 + kc) * 64;
        const bf16_t* BQp = c_BQ; const bf16_t* BKp = c_BK;
        bf16_t qn[8], kn[8];
#pragma unroll
        for (int tt = 0; tt < 8; ++tt) { const size_t idx = (size_t)(m0 + tt) * 256 + c; qn[tt] = BQp[idx]; kn[tt] = BKp[idx]; }
#pragma unroll 1
        for (int t8 = 0; t8 < 8; ++t8) {
            unsigned kdw[4];
            bf16_t qc[8], kc8[8];
#pragma unroll
            for (int tt = 0; tt < 8; ++tt) { qc[tt] = qn[tt]; kc8[tt] = kn[tt]; }
            { const int tn = t8 < 7 ? (t8 + 1) * 8 : 56;
#pragma unroll
              for (int tt = 0; tt < 8; ++tt) { const size_t idx = (size_t)(m0 + tn + tt) * 256 + c; qn[tt] = BQp[idx]; kn[tt] = BKp[idx]; } }
#pragma unroll
            for (int tt = 0; tt < 8; ++tt) {
                const int t = t8 * 8 + tt;
                const int te = dir == 0 ? t : t - 1;
                const float e = te < 0 ? 0.f : sPre[(te < 0 ? 0 : te) * 512 + tid];
                const float d = e - p31;
                const size_t idx = (size_t)(m0 + t) * 256 + c;
                const float qv = bf2f(qc[tt]), kv = bf2f(kc8[tt]);
                const float ed = __expf(dir == 0 ? d : -d), eid = __expf(dir == 0 ? -d : d);
                QA[idx] = f2bf(qv * ed); KA[idx] = f2bf(kv * eid);
                const float kd = kv * eid * ckd;
                if (tt & 1) kdw[tt >> 1] |= (unsigned)f2bf(kd) << 16; else kdw[tt >> 1] = (unsigned)f2bf(kd);
            }
            *(uint4*)(KDT + t8 * 8) = make_uint4(kdw[0], kdw[1], kdw[2], kdw[3]);
        }
        ((float*)(gb + G_DEC))[(((size_t)gc * 4 + h) * 2 + dir) * 64 + kc] = __expf(p63);
        ((float*)(gb + G_CQB))[(((size_t)gc * 4 + h) * 2 + dir) * 64 + kc] = cqb;
        { const int hv = tid >> 7, vv = tid & 127; const bf16_t* BVp = c_BV;
          bf16_t* VT = (bf16_t*)(gb + G_VT) + (((size_t)gc * 4 + hv) * 128 + vv) * 64;
#pragma unroll 4
          for (int t8 = 0; t8 < 8; ++t8) { unsigned w4[4];
#pragma unroll
              for (int tt = 0; tt < 8; ++tt) { const unsigned x = BVp[(size_t)(m0 + t8 * 8 + tt) * 512 + hv * 128 + vv]; if (tt & 1) w4[tt >> 1] |= x << 16; else w4[tt >> 1] = x; }
              *(uint4*)(VT + t8 * 8) = make_uint4(w4[0], w4[1], w4[2], w4[3]); } }
        __syncthreads();
        { const int lane = C.lane, wv = C.wave, hh = wv >> 1, dd_ = wv & 1, r32 = lane & 31, hi = lane >> 5;
          const size_t cu = ((size_t)gc * 4 + hh) * 2 + dd_;
          const bf16_t* vtb = (const bf16_t*)(gb + G_VT) + ((size_t)gc * 4 + hh) * 128 * 64;
          const bf16_t* kdb = (const bf16_t*)(gb + G_KDT) + cu * 64 * 64;
          bf16_t* DS = WSP(bf16_t, W_GDS) + cu * 128 * 64;
#pragma unroll 2
          for (int t = 0; t < 8; ++t) { const int vb = t & 3, kb = t >> 2;
              f32x16 acc;
#pragma unroll
              for (int r = 0; r < 16; ++r) acc[r] = 0.f;
              bf16x8 a4[4], b4[4];
#pragma unroll
              for (int s4 = 0; s4 < 4; ++s4) { a4[s4] = *(const bf16x8*)(vtb + (size_t)(vb * 32 + r32) * 64 + s4 * 16 + hi * 8); b4[s4] = *(const bf16x8*)(kdb + (size_t)(kb * 32 + r32) * 64 + s4 * 16 + hi * 8); }
#pragma unroll
              for (int s4 = 0; s4 < 4; ++s4) acc = __builtin_amdgcn_mfma_f32_32x32x16_bf16(a4[s4], b4[s4], acc, 0, 0, 0);
#pragma unroll
              for (int r = 0; r < 16; ++r) DS[(size_t)(vb * 32 + (r & 3) + 8 * (r >> 2) + 4 * hi) * 64 + kb * 32 + r32] = f2bf(acc[r]); } }
    }
}
__device__ __forceinline__ int crow16(int r, int hi) { return (r & 3) + 8 * (r >> 2) + 4 * hi; }
__device__ __forceinline__ void ph_gla_scan(const Ctx& C0, int l) {
    PHASE_CTX(C0);
    const int tid = C.tid;
    unsigned char* gb = WS_ + W_GLA;
    const bf16_t* DSb = WSP(bf16_t, W_GDS);
    for (int task = C.bid; task < 576; task += C.G) {
        const int it = task < 64 ? 287 - (task >> 1) : (task - 64) >> 1, part = task & 1;
        const int dir = it & 1, h = (it >> 1) & 3, s = it >> 3;
        const bool latent = s >= 32;
        const int nch = latent ? 32 : 4, gc0 = latent ? 128 + (s - 32) * 32 : s * 4;
        const int v = part * 64 + (tid >> 3), kc0 = (tid & 7) * 8;
        float S[8];
        if (latent) { const float* si = c_state_gla + ((((size_t)(s - 32) * 2 + l) * 2 + dir) * 4 + h) * 8192 + v;
#pragma unroll
            for (int e = 0; e < 8; ++e) S[e] = si[(size_t)(kc0 + e) * 128]; }
        else {
#pragma unroll
            for (int e = 0; e < 8; ++e) S[e] = 0.f; }
#pragma unroll 4
        for (int n = 0; n < nch; ++n) {
            const int gc = gc0 + (dir == 0 ? n : nch - 1 - n);
            const size_t cu = ((size_t)gc * 4 + h) * 2 + dir;
            const uint4 dsw = *(const uint4*)(DSb + (cu * 128 + v) * 64 + kc0);
            const float4 d0 = *(const float4*)((const float*)(gb + G_DEC) + cu * 64 + kc0), d1 = *(const float4*)((const float*)(gb + G_DEC) + cu * 64 + kc0 + 4);
            const float4 q0 = *(const float4*)((const float*)(gb + G_CQB) + cu * 64 + kc0), q1 = *(const float4*)((const float*)(gb + G_CQB) + cu * 64 + kc0 + 4);
            uint4 st; st.x = pk2(S[0] * q0.x, S[1] * q0.y); st.y = pk2(S[2] * q0.z, S[3] * q0.w); st.z = pk2(S[4] * q1.x, S[5] * q1.y); st.w = pk2(S[6] * q1.z, S[7] * q1.w);
            *(uint4*)((bf16_t*)(gb + G_SST) + (cu * 128 + v) * 64 + kc0) = st;
            const unsigned dw[4] = {dsw.x, dsw.y, dsw.z, dsw.w}; const float dc[8] = {d0.x, d0.y, d0.z, d0.w, d1.x, d1.y, d1.z, d1.w};
#pragma unroll
            for (int q = 0; q < 4; ++q) { S[2 * q] = dc[2 * q] * S[2 * q] + __uint_as_float(dw[q] << 16); S[2 * q + 1] = dc[2 * q + 1] * S[2 * q + 1] + __uint_as_float(dw[q] & 0xffff0000u); }
        }
        if (!latent) { float* so = c_out + O_NG + ((((size_t)s * 2 + l) * 2 + dir) * 4 + h) * 8192 + v;
#pragma unroll
            for (int e = 0; e < 8; ++e) so[(size_t)(kc0 + e) * 128] = S[e]; }
    }
}
__device__ __forceinline__ void ph_gla_out(const Ctx& C0, int l) {
    PHASE_CTX(C0);
    const int lane = C.lane, r32 = lane & 31, hi = lane >> 5;
    unsigned char* gb = WS_ + W_GLA;
    float* sO = (float*)C.lds + C.wave * (32 * 132);
    const float* ong = c_gla_on_g + l * 128;
    const bool bal = C.G == 256;
    const int nw = bal ? 1024 : C.G * NWAVE, wv = bal ? (C.bid - 128) * NWAVE + C.wave : C.bid * NWAVE + C.wave;
    if (bal && C.bid < 128) return;
    for (int task = wv; task < 2048; task += nw) {
        const int gc = task >> 3, h = (task >> 1) & 3, jb = task & 1, m0 = gc * GT;
        f32x16 o[4];
#pragma unroll
        for (int vq = 0; vq < 4; ++vq)
#pragma unroll
            for (int r = 0; r < 16; ++r) o[vq][r] = 0.f;
#pragma unroll
        for (int dir = 0; dir < 2; ++dir) {
            const bf16_t* QA = (const bf16_t*)(gb + G_QK + (size_t)(dir * 3 + 0) * 8 * MiB); const bf16_t* KA = (const bf16_t*)(gb + G_QK + (size_t)(dir * 3 + 1) * 8 * MiB);
            const size_t cu = ((size_t)gc * 4 + h) * 2 + dir;
            bf16x8 qf[4], kf[2][4];
            { const bf16_t* qp = QA + (size_t)(m0 + jb * 32 + r32) * 256 + h * 64 + hi * 8;
              const bf16_t* kp0 = KA + (size_t)(m0 + r32) * 256 + h * 64 + hi * 8; const bf16_t* kp1 = kp0 + (size_t)32 * 256;
#pragma unroll
              for (int s4 = 0; s4 < 4; ++s4) { qf[s4] = *(const bf16x8*)(qp + s4 * 16); kf[0][s4] = *(const bf16x8*)(kp0 + s4 * 16); kf[1][s4] = *(const bf16x8*)(kp1 + s4 * 16); } }
            const bf16_t* vtb = (const bf16_t*)(gb + G_VT) + (((size_t)gc * 4 + h) * 128 + r32) * 64 + 4 * hi;
            const bf16_t* stb = (const bf16_t*)(gb + G_SST) + (cu * 128 + r32) * 64 + hi * 8;
            s16x4 vlo[2][4], vhi[2][4]; bf16x8 sf[2][4];
#define GO_LOADV(b_, vq_) do { _Pragma("unroll") for (int s4 = 0; s4 < 4; ++s4) { vlo[b_][s4] = *(const s16x4*)(vtb + (size_t)(vq_) * 32 * 64 + s4 * 16); vhi[b_][s4] = *(const s16x4*)(vtb + (size_t)(vq_) * 32 * 64 + s4 * 16 + 8); sf[b_][s4] = *(const bf16x8*)(stb + (size_t)(vq_) * 32 * 64 + s4 * 16); } } while (0)
            GO_LOADV(0, 0);
            bf16x8 pf[4];
#pragma unroll
            for (int ib = 0; ib < 2; ++ib) {
                f32x16 p;
#pragma unroll
                for (int r = 0; r < 16; ++r) p[r] = 0.f;
#pragma unroll
                for (int s4 = 0; s4 < 4; ++s4) p = __builtin_amdgcn_mfma_f32_32x32x16_bf16(kf[ib][s4], qf[s4], p, 0, 0, 0);
                const int j = jb * 32 + r32;
#pragma unroll
                for (int r = 0; r < 16; ++r) { const int i = ib * 32 + crow16(r, hi); const bool keep = dir == 0 ? (i <= j) : (i >= j); if (!keep) p[r] = 0.f; }
#pragma unroll
                for (int s2 = 0; s2 < 2; ++s2) { union { bf16x8 v; unsigned u[4]; } a;
#pragma unroll
                    for (int q = 0; q < 4; ++q) a.u[q] = pk2(p[8 * s2 + 2 * q], p[8 * s2 + 2 * q + 1]);
                    pf[2 * ib + s2] = a.v; }
            }
#pragma unroll
            for (int vq = 0; vq < 4; ++vq) {
                if (vq < 3) GO_LOADV((vq + 1) & 1, vq + 1);
#pragma unroll
                for (int ks = 0; ks < 4; ++ks) { const bf16x8 vf = __builtin_shufflevector(vlo[vq & 1][ks], vhi[vq & 1][ks], 0, 1, 2, 3, 4, 5, 6, 7);
                    o[vq] = __builtin_amdgcn_mfma_f32_32x32x16_bf16(vf, pf[ks], o[vq], 0, 0, 0); }
#pragma unroll
                for (int s4 = 0; s4 < 4; ++s4) o[vq] = __builtin_amdgcn_mfma_f32_32x32x16_bf16(sf[vq & 1][s4], qf[s4], o[vq], 0, 0, 0);
            }
#undef GO_LOADV
        }
        float ss = 0.f;
#pragma unroll
        for (int vq = 0; vq < 4; ++vq)
#pragma unroll
            for (int r = 0; r < 16; ++r) ss += o[vq][r] * o[vq][r];
        ss = xsum32(ss);
        const float rs = rsqrtf(ss * (1.f / 128.f) + EPS);
#pragma unroll
        for (int vq = 0; vq < 4; ++vq)
#pragma unroll
            for (int q4 = 0; q4 < 4; ++q4) *(float4*)(sO + r32 * 132 + vq * 32 + 8 * q4 + 4 * hi) = make_float4(o[vq][4 * q4] * rs, o[vq][4 * q4 + 1] * rs, o[vq][4 * q4 + 2] * rs, o[vq][4 * q4 + 3] * rs);
        { const int j = lane >> 1, vc = (lane & 1) * 64; const float* row = sO + j * 132 + vc;
          const size_t off = (size_t)(m0 + jb * 32 + j) * 512 + h * 128 + vc;
          const bf16_t* BGp = c_BG + off; bf16_t* OBp = c_OB + off;
#pragma unroll
          for (int c8 = 0; c8 < 8; ++c8) {
              const float4 f0 = *(const float4*)(row + c8 * 8), f1 = *(const float4*)(row + c8 * 8 + 4);
              const uint4 gr = *(const uint4*)(BGp + c8 * 8); const float* og = ong + vc + c8 * 8;
              uint4 ow;
              ow.x = pk2(f0.x * og[0] * __uint_as_float(gr.x << 16), f0.y * og[1] * __uint_as_float(gr.x & 0xffff0000u));
              ow.y = pk2(f0.z * og[2] * __uint_as_float(gr.y << 16), f0.w * og[3] * __uint_as_float(gr.y & 0xffff0000u));
              ow.z = pk2(f1.x * og[4] * __uint_as_float(gr.z << 16), f1.y * og[5] * __uint_as_float(gr.z & 0xffff0000u));
              ow.w = pk2(f1.z * og[6] * __uint_as_float(gr.w << 16), f1.w * og[7] * __uint_as_float(gr.w & 0xffff0000u));
              *(uint4*)(OBp + c8 * 8) = ow; } }
    }
}

namespace pg8 {
#define PG8_LAS __attribute__((address_space(3)))
typedef unsigned short bf16_t;
typedef short bf16x8 __attribute__((ext_vector_type(8)));
typedef float f32x4 __attribute__((ext_vector_type(4)));
typedef unsigned u32x4 __attribute__((ext_vector_type(4)));
constexpr int BM = 256, BK = 64, HALF = 128, HTB = HALF * BK * 2  , STAGE_BYTES = 8 * HTB, NXCD = 8, WGM = 8;

__host__ __device__ __forceinline__ int lds_byte(int r, int c) { const int st = (r >> 4) * 2 + (c >> 5), rr = r & 15, cc = c & 31, ob = rr * 64 + cc * 2; return st * 1024 + (ob ^ (((ob >> 9) & 1) << 5)); }
__host__ __device__ __forceinline__ void stage_rc(int b, int& R, int& C) { const int st = b / 1024, sb = b % 1024, swz = sb ^ (((sb >> 9) & 1) << 5); R = (st >> 1) * 16 + swz / 64; C = (st & 1) * 32 + (swz % 64) / 2; }
__host__ __device__ __forceinline__ int perm32(int rho) { const int n = rho >> 4, i = rho & 15; return 8 * (i >> 2) + 4 * n + (i & 3); }

struct Unit { int pm, pn, z, h; };
struct Gemm { const bf16_t* A; const bf16_t* Bt; int M, N, K; size_t za, zb; int lda, ldb; };

struct StaticOrder {
    int nM, nN, nwg, G, c;
    __host__ __device__ void init(int M, int N, int G_, int c_) { nM = M / BM; nN = N / BM; nwg = nM * nN; G = G_; c = c_; }
    static constexpr bool HALF = false;
    __host__ __device__ void map(int L, Unit& u) const {
        int wgid = L; { const int q = nwg / NXCD, r = nwg % NXCD, xcd = wgid % NXCD, off = wgid / NXCD; wgid = (xcd < r ? xcd * (q + 1) : r * (q + 1) + (xcd - r) * q) + off; }
        const int nig = WGM * nN, gid = wgid / nig, fm = gid * WGM, gsz = (nM - fm) < WGM ? (nM - fm) : WGM;
        u.pm = fm + ((wgid % nig) % gsz); u.pn = (wgid % nig) / gsz; u.z = 0; u.h = 0;
    }
    __host__ __device__ bool next(int i, Unit& u) const {
        const long L = (long)i * G + c; if (L >= nwg) return false;
        map((int)L, u); return true;
    }
    __device__ __forceinline__ void a_ready(const Unit&) const {}
    __device__ __forceinline__ void done(const Unit&) const {}
};
__device__ __forceinline__ unsigned cvt_pk_bf16(float lo, float hi) { unsigned r; asm volatile("v_cvt_pk_bf16_f32 %0, %1, %2" : "=v"(r) : "v"(lo), "v"(hi)); return r; }
typedef float f32x2 __attribute__((ext_vector_type(2)));
template <class Epi, class Sched, bool ALIGN_EPI = false, bool SP2 = false>
__device__ __forceinline__ void gemm_phase(PG8_LAS unsigned char* lds, const Gemm g, const Sched& S, const Epi& E) {
    int tid_ = threadIdx.x; asm volatile("" : "+v"(tid_));
    const int tid = tid_, wid = __builtin_amdgcn_readfirstlane(tid >> 6), lane = tid & 63, wr = wid >> 2, wc = wid & 3, fr = lane & 15, fq = lane >> 4;
    const int K = g.K, nt = K / BK;
    unsigned voffA[2], voffB[2];
#pragma unroll
    for (int i = 0; i < 2; ++i) { int R, C; stage_rc(tid * 16 + i * 8192, R, C); const int Rb = Epi::PERM ? ((R & ~31) + perm32(R & 31)) : R;
        voffA[i] = (unsigned)(R * g.lda + C) * 2u; voffB[i] = (unsigned)(Rb * g.ldb + C) * 2u; }
    const size_t kstep = (size_t)(BK * 2);
    const size_t hstepA = (size_t)HALF * g.lda * 2, hstepB = (size_t)HALF * g.ldb * 2;
    const size_t tstepA = 2 * hstepA, tstepB = 2 * hstepB;
    const unsigned ldsw = (unsigned)wid * 1024u;
    const int aoff = lds_byte(wr * 64 + fr, fq * 8), boff = lds_byte(wc * 32 + fr, fq * 8);
#define PG8_SA(b, h) (((b) * 2 + (h)) * HTB)
#define PG8_SB(b, h) ((4 + (b) * 2 + (h)) * HTB)
#define PG8_STAGE(bufoff, gbase, voff) do { _Pragma("unroll") for (int _i = 0; _i < 2; ++_i) \
        __builtin_amdgcn_global_load_lds((const unsigned*)((const char*)(gbase) + (voff)[_i]), (PG8_LAS unsigned*)(lds + (bufoff) + ldsw + _i * 8192), 16, 0, 0); } while (0)
#define PG8_LDA(dst, b, h) do { _Pragma("unroll") for (int m = 0; m < 4; ++m) _Pragma("unroll") for (int k = 0; k < 2; ++k) dst[m][k] = *(const PG8_LAS bf16x8*)(lds + PG8_SA(b, h) + aoff + m * 2048 + k * 1024); } while (0)
#define PG8_LDB(dst, b, h) do { _Pragma("unroll") for (int n = 0; n < 2; ++n) _Pragma("unroll") for (int k = 0; k < 2; ++k) dst[n][k] = *(const PG8_LAS bf16x8*)(lds + PG8_SB(b, h) + boff + n * 2048 + k * 1024); } while (0)
#define PG8_MMA(ai, bj, At, Bt) do { __builtin_amdgcn_s_setprio(1); _Pragma("unroll") for (int m = 0; m < 4; ++m) _Pragma("unroll") for (int n = 0; n < 2; ++n) _Pragma("unroll") for (int k = 0; k < 2; ++k) \
        acc[ai][bj][m][n] = __builtin_amdgcn_mfma_f32_16x16x32_bf16(Bt[n][k], At[m][k], acc[ai][bj][m][n], 0, 0, 0); __builtin_amdgcn_s_setprio(0); } while (0)
#define PG8_WAIT_V(n) asm volatile("s_waitcnt vmcnt(" #n ")" ::: "memory")
#define PG8_WAIT_L(n) asm volatile("s_waitcnt lgkmcnt(" #n ")" ::: "memory")
#define PG8_BAR __builtin_amdgcn_s_barrier()
#define PG8_SCHED __builtin_amdgcn_sched_barrier(0)
    Unit cur, nxt; int ui = 0;
    if (!S.next(0, cur)) return;
    f32x4 acc[2][2][4][2];
#pragma unroll
    for (int a = 0; a < 2; ++a)
#pragma unroll
        for (int b = 0; b < 2; ++b)
#pragma unroll
            for (int m = 0; m < 4; ++m)
#pragma unroll
                for (int n = 0; n < 2; ++n) acc[a][b][m][n] = (f32x4){0.f, 0.f, 0.f, 0.f};
    bf16x8 At[4][2], B0[2][2], B1[2][2];
    const char* cA = (const char*)g.A + (size_t)cur.pm * tstepA + (size_t)cur.z * g.za; const char* cB = (const char*)g.Bt + (size_t)cur.pn * tstepB + (size_t)cur.z * g.zb;
    S.a_ready(cur);
    if constexpr (SP2) {
        PG8_STAGE(PG8_SB(0, 0), cB, voffB); PG8_STAGE(PG8_SB(0, 1), cB + hstepB, voffB); PG8_STAGE(PG8_SA(0, 0), cA, voffA); PG8_STAGE(PG8_SA(0, 1), cA + hstepA, voffA);
        if (wr == 1) PG8_BAR;
        PG8_WAIT_V(2); PG8_BAR;
        PG8_STAGE(PG8_SB(1, 0), cB + kstep, voffB); PG8_STAGE(PG8_SA(1, 0), cA + kstep, voffA); PG8_STAGE(PG8_SB(1, 1), cB + hstepB + kstep, voffB);
        PG8_WAIT_V(6); PG8_BAR;
    } else {
        PG8_STAGE(PG8_SB(0, 0), cB, voffB); PG8_STAGE(PG8_SA(0, 0), cA, voffA); PG8_STAGE(PG8_SB(0, 1), cB + hstepB, voffB); PG8_STAGE(PG8_SA(0, 1), cA + hstepA, voffA);
        if (wr == 1) PG8_BAR;
        PG8_WAIT_V(4); PG8_BAR;
        PG8_STAGE(PG8_SB(1, 0), cB + kstep, voffB); PG8_STAGE(PG8_SA(1, 0), cA + kstep, voffA); PG8_STAGE(PG8_SB(1, 1), cB + hstepB + kstep, voffB);
        PG8_WAIT_V(6); PG8_BAR;
    }
    for (;;) {
        const bool has_next = S.next(ui + 1, nxt);
        const char* nA = has_next ? (const char*)g.A + (size_t)nxt.pm * tstepA + (size_t)nxt.z * g.za : cA; const char* nB = has_next ? (const char*)g.Bt + (size_t)nxt.pn * tstepB + (size_t)nxt.z * g.zb : cB;
        for (int t = 0; t < nt; t += 2) {
            const bool last = (t == nt - 2);
            const char* a1 = cA + (size_t)(t + 1) * kstep;
            const char* a2 = last ? nA : cA + (size_t)(t + 2) * kstep; const char* b2 = last ? nB : cB + (size_t)(t + 2) * kstep;
            const char* a3 = a2 + kstep; const char* b3 = b2 + kstep;
            if (last && has_next) S.a_ready(nxt);
            if constexpr (SP2) {
            PG8_LDB(B0, 0, 0); PG8_LDB(B1, 0, 1); PG8_SCHED; PG8_LDA(At, 0, 0); PG8_STAGE(PG8_SA(1, 1), a1 + hstepA, voffA);
            PG8_WAIT_V(8); PG8_WAIT_L(0); PG8_BAR; if (!Sched::HALF || cur.h != 2) { PG8_MMA(0, 0, At, B0); PG8_MMA(0, 1, At, B1); } PG8_BAR; PG8_SCHED;
            PG8_LDA(At, 0, 1); PG8_STAGE(PG8_SB(0, 0), b2, voffB); PG8_STAGE(PG8_SB(0, 1), b2 + hstepB, voffB); PG8_STAGE(PG8_SA(0, 0), a2, voffA);
            PG8_WAIT_V(8); PG8_WAIT_L(0); PG8_BAR; if (!Sched::HALF || cur.h != 1) { PG8_MMA(1, 0, At, B0); PG8_MMA(1, 1, At, B1); } PG8_BAR; PG8_SCHED;
            PG8_LDB(B0, 1, 0); PG8_LDB(B1, 1, 1); PG8_SCHED; PG8_LDA(At, 1, 0); PG8_STAGE(PG8_SA(0, 1), a2 + hstepA, voffA);
            PG8_WAIT_V(8); PG8_WAIT_L(0); PG8_BAR; if (!Sched::HALF || cur.h != 2) { PG8_MMA(0, 0, At, B0); PG8_MMA(0, 1, At, B1); } PG8_BAR; PG8_SCHED;
            PG8_LDA(At, 1, 1); PG8_STAGE(PG8_SB(1, 0), b3, voffB); PG8_STAGE(PG8_SB(1, 1), b3 + hstepB, voffB); PG8_STAGE(PG8_SA(1, 0), a3, voffA);
            PG8_WAIT_V(8); PG8_WAIT_L(0); PG8_BAR; if (!Sched::HALF || cur.h != 1) { PG8_MMA(1, 0, At, B0); PG8_MMA(1, 1, At, B1); } PG8_BAR; PG8_SCHED;
            } else {
            PG8_LDB(B0, 0, 0); PG8_SCHED; PG8_LDA(At, 0, 0); PG8_STAGE(PG8_SA(1, 1), a1 + hstepA, voffA);
            PG8_WAIT_L(8); PG8_BAR; PG8_WAIT_L(0); PG8_MMA(0, 0, At, B0); PG8_BAR; PG8_SCHED;
            PG8_LDB(B1, 0, 1); PG8_STAGE(PG8_SB(0, 0), b2, voffB);
            PG8_BAR; PG8_WAIT_L(0); PG8_MMA(0, 1, At, B1); PG8_BAR;
            PG8_LDA(At, 0, 1); PG8_STAGE(PG8_SA(0, 0), a2, voffA);
            PG8_BAR; PG8_WAIT_L(0); PG8_MMA(1, 0, At, B0); PG8_BAR; PG8_SCHED;
            PG8_STAGE(PG8_SB(0, 1), b2 + hstepB, voffB);
            PG8_WAIT_V(6); PG8_BAR; PG8_MMA(1, 1, At, B1); PG8_BAR;
            PG8_LDB(B0, 1, 0); PG8_SCHED; PG8_LDA(At, 1, 0); PG8_STAGE(PG8_SA(0, 1), a2 + hstepA, voffA);
            PG8_WAIT_L(8); PG8_BAR; PG8_WAIT_L(0); PG8_MMA(0, 0, At, B0); PG8_BAR; PG8_SCHED;
            PG8_LDB(B1, 1, 1); PG8_STAGE(PG8_SB(1, 0), b3, voffB);
            PG8_BAR; PG8_WAIT_L(0); PG8_MMA(0, 1, At, B1); PG8_BAR;
            PG8_LDA(At, 1, 1); PG8_STAGE(PG8_SA(1, 0), a3, voffA);
            PG8_BAR; PG8_WAIT_L(0); PG8_MMA(1, 0, At, B0); PG8_BAR; PG8_SCHED;
            PG8_STAGE(PG8_SB(1, 1), b3 + hstepB, voffB);
            PG8_WAIT_V(6); PG8_BAR; PG8_MMA(1, 1, At, B1); PG8_BAR;
            }
        }
        if constexpr (ALIGN_EPI) { if (wr == 0) PG8_BAR; }
        if constexpr (!Epi::AFTER_DRAIN) { E(acc, cur, wr, wc, fr, fq); S.done(cur); }
        if (!has_next) break;
#pragma unroll
        for (int a = 0; a < 2; ++a)
#pragma unroll
            for (int b = 0; b < 2; ++b)
#pragma unroll
                for (int m = 0; m < 4; ++m)
#pragma unroll
                    for (int n = 0; n < 2; ++n) acc[a][b][m][n] = (f32x4){0.f, 0.f, 0.f, 0.f};
        cur = nxt; cA = nA; cB = nB; ++ui;
        if constexpr (ALIGN_EPI) { if (wr == 1) PG8_BAR; }
    }
    PG8_WAIT_V(0);
    if constexpr (!ALIGN_EPI) { if (wr == 0) PG8_BAR; }
    PG8_BAR;
    if constexpr (Epi::AFTER_DRAIN) { E.fused(acc, cur, wr, wc, fr, fq, lds, wid, lane); S.done(cur); }
#undef PG8_SA
#undef PG8_SB
#undef PG8_STAGE
#undef PG8_LDA
#undef PG8_LDB
#undef PG8_MMA
#undef PG8_WAIT_V
#undef PG8_WAIT_L
#undef PG8_BAR
#undef PG8_SCHED
}
}

__device__ __forceinline__ void wconv_item(const float* W, int ld, int col0, int k0, bf16_t* WT, int K, int drow0, LAS float* scr, int lane) {
    if (W == nullptr) {
#pragma unroll
        for (int j = 0; j < 4; ++j) { const int n = (lane >> 3) + 8 * j; *(uint4*)(WT + (size_t)(drow0 + n) * K + k0 + 8 * (lane & 7)) = make_uint4(0u, 0u, 0u, 0u); }
        return;
    }
    float wv[32];
#pragma unroll
    for (int i = 0; i < 32; ++i) { const int kk = 2 * i + (lane >> 5); wv[i] = W[(size_t)(k0 + kk) * ld + col0 + (lane & 31)]; }
#pragma unroll
    for (int i = 0; i < 32; ++i) { const int kk = 2 * i + (lane >> 5); scr[kk * 33 + (lane & 31)] = wv[i]; }
    asm volatile("s_waitcnt lgkmcnt(0)" ::: "memory");
    const int c = lane & 7;
#pragma unroll
    for (int j = 0; j < 4; ++j) { const int n = (lane >> 3) + 8 * j; const LAS float* s = scr + (8 * c) * 33 + n;
        uint4 o; o.x = pk2(s[0 * 33], s[1 * 33]); o.y = pk2(s[2 * 33], s[3 * 33]); o.z = pk2(s[4 * 33], s[5 * 33]); o.w = pk2(s[6 * 33], s[7 * 33]);
        *(uint4*)(WT + (size_t)(drow0 + n) * K + k0 + 8 * c) = o; }
    asm volatile("s_waitcnt lgkmcnt(0)" ::: "memory");
}
__device__ __forceinline__ void ph_wconv(const Ctx& C0) {
    PHASE_CTX(C0);
    LAS float* scr = (LAS float*)((LAS unsigned char*)C.lds + C.wave * 16384);
    const int lane = C.lane;
    __syncthreads();
    constexpr int I_WI = 120 * 16, I_WZ = 96 * 16, I_WG = 32 * 8, I_WR = 96 * 8, I_WO = 32 * 16, I_WU = 176 * 16, I_WD = 32 * 44;
    constexpr int I_LAYER = I_WI + I_WZ + I_WG + I_WR + I_WO + I_WU + I_WD;
    for (int it = C.bid * NWAVE + C.wave; it < 2 * I_LAYER; it += C.G * NWAVE) {
        const int l = it / I_LAYER; int r = it % I_LAYER;
        unsigned char* wb = WS_ + W_WB + (size_t)l * WB_LAYER;
        if (r < I_WI) { const int rb = r >> 4, kb = r & 15, pn = rb >> 3, tb = rb & 7; int col = -1;
            if (pn < 4) col = 256 * pn + 64 * (tb & 3) + 32 * (tb >> 2);
            else if (pn < 6) col = C_AV + 256 * (pn - 4) + 32 * tb;
            else if (pn == 6) col = C_BQ + 32 * tb; else if (pn == 7) col = C_BK + 32 * tb;
            else if (pn < 10) col = C_BV + 256 * (pn - 8) + 32 * tb; else if (pn < 12) col = C_BG + 256 * (pn - 10) + 32 * tb;
            else if (pn < 14) col = C_CU + 256 * (pn - 12) + 32 * tb; else if (tb == 0) col = C_BR;
            wconv_item(col < 0 ? nullptr : c_w_in + (size_t)l * 1024 * IN_DIM, IN_DIM, col, kb * 64, (bf16_t*)(wb + WB_WI), 1024, rb * 32, scr, lane); continue; }
        r -= I_WI;
        if (r < I_WZ) { const int rb = r >> 4, kb = r & 15; wconv_item(c_w_in + (size_t)l * 1024 * IN_DIM, IN_DIM, C_GZ + 32 * rb, kb * 64, (bf16_t*)(wb + WB_WZ), 1024, rb * 32, scr, lane); continue; }
        r -= I_WZ;
        if (r < I_WG) { const int rb = r >> 3, kb = r & 7, pn = rb >> 3, tb = rb & 7; wconv_item(c_s5_w_glu + (size_t)l * 512 * 1024, 1024, 512 * (tb >> 2) + 128 * pn + 32 * (tb & 3), kb * 64, (bf16_t*)(wb + WB_WG), 512, rb * 32, scr, lane); continue; }
        r -= I_WG;
        if (r < I_WR) { const int rb = r >> 3, kb = r & 7, br = rb >> 5, rbb = rb & 31; wconv_item(c_w_branch + ((size_t)l * 3 + br) * 512 * 1024, 1024, 32 * rbb, kb * 64, (bf16_t*)(wb + WB_WR), 512, rb * 32, scr, lane); continue; }
        r -= I_WR;
        if (r < I_WO) { const int rb = r >> 4, kb = r & 15; wconv_item(c_w_out + (size_t)l * 1024 * 1024, 1024, 32 * rb, kb * 64, (bf16_t*)(wb + WB_WO), 1024, rb * 32, scr, lane); continue; }
        r -= I_WO;
        if (r < I_WU) { const int rb = r >> 4, kb = r & 15, pn = rb >> 3, tb = rb & 7; const float* src = (tb >> 2) ? c_w_up : c_w_gate;
            wconv_item(src + (size_t)l * 1024 * FFN, FFN, 128 * pn + 32 * (tb & 3), kb * 64, (bf16_t*)(wb + WB_WU), 1024, rb * 32, scr, lane); continue; }
        r -= I_WU;
        { const int rb = r / 44, kb = r % 44; wconv_item(c_w_down + (size_t)l * FFN * 1024, 1024, 32 * rb, kb * 64, (bf16_t*)(wb + WB_WD), FFN, rb * 32, scr, lane); }
    }
}

__device__ __forceinline__ uint4 pack8(const f32x4& a, const f32x4& b) { uint4 w; w.x = pk2(a[0], a[1]); w.y = pk2(a[2], a[3]); w.z = pk2(b[0], b[1]); w.w = pk2(b[2], b[3]); return w; }
struct EpiIn {
    static constexpr bool PERM = true, AFTER_DRAIN = false;
    unsigned char* ws_; float* out_; const float* qg; const float* kg; int l; int pad_;
    __device__ __forceinline__ void operator()(const f32x4 (&acc)[2][2][4][2], const pg8::Unit& u, int wr, int wc, int fr_, int fq_) const {
        int fr = fr_, fq = fq_; asm volatile("" : "+v"(fr), "+v"(fq));
        KArgPtr Pk = kargs(); unsigned char* ws = Pk->ws; float* out = Pk->out;
        const int pn = u.pn, rowb = u.pm * 256 + wr * 64 + fr;
        if (pn < 4) {
            const bool isk = pn >= 2; const float* g = isk ? kg : qg;
            const bool latent = u.pm >= 32;
            const float* cosT = (const float*)(ws + W_MISC) + 64; const float* sinT = cosT + 1024;
            bf16_t* dstb = isk ? (bf16_t*)(ws + W_AK) : (bf16_t*)(ws + W_AQ);
            const int colb = (pn & 1) * 256 + 64 * wc + 8 * fq;
#pragma unroll
            for (int ai = 0; ai < 2; ++ai)
#pragma unroll
                for (int m = 0; m < 4; ++m) {
                    const int row = rowb + ai * 128 + m * 16;
                    f32x4 v[2][2]; float ss = 0.f;
#pragma unroll
                    for (int bj = 0; bj < 2; ++bj)
#pragma unroll
                        for (int n = 0; n < 2; ++n) { v[bj][n] = acc[ai][bj][m][n]; ss += v[bj][n][0] * v[bj][n][0] + v[bj][n][1] * v[bj][n][1] + v[bj][n][2] * v[bj][n][2] + v[bj][n][3] * v[bj][n][3]; }
                    ss += shx(ss, 16, fq * 16 + fr); ss = xsum32(ss);
                    const float rs = rsqrtf(ss * (1.f / 64.f) + EPS);
                    { const float* gp = (isk ? Pk->in[14] : Pk->in[13]) + l * 64 + launder_s(0);
#pragma unroll
                      for (int bj = 0; bj < 2; ++bj)
#pragma unroll
                        for (int n = 0; n < 2; ++n) v[bj][n] = v[bj][n] * rs * *(const f32x4*)(gp + 32 * bj + 8 * fq + 4 * n); }
                    if (isk && !latent) {
                        float* o = out + O_NK + ((size_t)((row >> 8) * 2 + l) * 256 + (row & 255)) * 512 + colb;
#pragma unroll
                        for (int bj = 0; bj < 2; ++bj) { *(f32x4*)(o + 32 * bj) = v[bj][0]; *(f32x4*)(o + 32 * bj + 4) = v[bj][1]; }
                    }
                    if (latent) {
                        const int t = (row - NPROMPT) & 2047;
#pragma unroll
                        for (int bj = 0; bj < 2; ++bj) {
                            const int pos = bj ? (t & 63) : (t >> 6);
#pragma unroll
                            for (int n = 0; n < 2; ++n) {
                                const f32x4 cc = *(const f32x4*)(cosT + pos * 16 + 8 * (fq & 1) + 4 * n), sn = *(const f32x4*)(sinT + pos * 16 + 8 * (fq & 1) + 4 * n);
                                f32x4 ot;
#pragma unroll
                                for (int e = 0; e < 4; ++e) ot[e] = shx(v[bj][n][e], 32, fq * 16 + fr);
                                v[bj][n] = (fq & 2) ? (v[bj][n] * cc + ot * sn) : (v[bj][n] * cc - ot * sn);
                            }
                        }
                    }
                    bf16_t* d = dstb + (size_t)(isk ? krow_of(row) : row) * 512 + colb;
#pragma unroll
                    for (int bj = 0; bj < 2; ++bj) *(uint4*)(d + 32 * bj) = pack8(v[bj][0], v[bj][1]);
                }
            return;
        }
        const int cb = 32 * wc + 8 * fq;
        if (pn < 6) {
            bf16_t* AV = (bf16_t*)(ws + W_AV);
#pragma unroll
            for (int ai = 0; ai < 2; ++ai)
#pragma unroll
                for (int m = 0; m < 4; ++m) { const int row = rowb + ai * 128 + m * 16;
#pragma unroll
                    for (int bj = 0; bj < 2; ++bj) { const int col = (pn - 4) * 256 + 128 * bj + cb;
                        *(uint4*)(AV + (size_t)krow_of(row) * 512 + col) = pack8(acc[ai][bj][m][0], acc[ai][bj][m][1]);
                        if (row < NPROMPT) { float* o = out + O_NV + ((size_t)((row >> 8) * 2 + l) * 256 + (row & 255)) * 512 + col; *(f32x4*)o = acc[ai][bj][m][0]; *(f32x4*)(o + 4) = acc[ai][bj][m][1]; } } }
            return;
        }
        if (pn == 14) {
            if (wc == 0) { float* BR = (float*)(ws + W_BR);
#pragma unroll
                for (int ai = 0; ai < 2; ++ai)
#pragma unroll
                    for (int m = 0; m < 4; ++m) { const int row = rowb + ai * 128 + m * 16; *(f32x4*)(BR + (size_t)row * 32 + 8 * fq) = acc[ai][0][m][0]; *(f32x4*)(BR + (size_t)row * 32 + 8 * fq + 4) = acc[ai][0][m][1]; } }
            return;
        }
        bf16_t* dst; int ldd, c0; int mode = 0;
        if (pn == 6) { dst = (bf16_t*)(ws + W_BQ); ldd = 256; c0 = 0; mode = 1; }
        else if (pn == 7) { dst = (bf16_t*)(ws + W_BK); ldd = 256; c0 = 0; }
        else if (pn < 10) { dst = (bf16_t*)(ws + W_BV); ldd = 512; c0 = (pn - 8) * 256; }
        else if (pn < 12) { dst = (bf16_t*)(ws + W_BG); ldd = 512; c0 = (pn - 10) * 256; mode = 2; }
        else {
            bf16_t* UH = (bf16_t*)(ws + W_UH);
#pragma unroll
            for (int ai = 0; ai < 2; ++ai)
#pragma unroll
                for (int m = 0; m < 4; ++m) { const int row = rowb + ai * 128 + m * 16;
#pragma unroll
                    for (int bj = 0; bj < 2; ++bj) { const int col = (pn - 12) * 256 + 128 * bj + cb, g = col >> 4, ch0 = col & 15;
                        *(uint4*)(UH + ((size_t)g * 512 + (row >> 5)) * 768 + (row & 31) * 16 + ch0) = pack8(acc[ai][bj][m][0], acc[ai][bj][m][1]); } }
            return;
        }
#pragma unroll
        for (int ai = 0; ai < 2; ++ai)
#pragma unroll
            for (int m = 0; m < 4; ++m) { const int row = rowb + ai * 128 + m * 16;
#pragma unroll
                for (int bj = 0; bj < 2; ++bj) { f32x4 a = acc[ai][bj][m][0], b = acc[ai][bj][m][1];
                    if (mode == 1) { a = a * 0.125f; b = b * 0.125f; }
                    if (mode == 2) {
#pragma unroll
                        for (int e = 0; e < 4; ++e) { a[e] = siluf_(a[e]); b[e] = siluf_(b[e]); } }
                    *(uint4*)(dst + (size_t)row * ldd + c0 + 128 * bj + cb) = pack8(a, b); } }
    }
};
struct EpiGate {
    static constexpr bool PERM = true, AFTER_DRAIN = false;
    bf16_t* G;
    __device__ __forceinline__ void operator()(const f32x4 (&acc)[2][2][4][2], const pg8::Unit& u, int wr, int wc, int fr_, int fq_) const {
        int fr = fr_, fq = fq_; asm volatile("" : "+v"(fr), "+v"(fq));
        const int rowb = u.pm * 256 + wr * 64 + fr, cb = u.pn * 256 + 32 * wc + 8 * fq;
#pragma unroll
        for (int ai = 0; ai < 2; ++ai)
#pragma unroll
            for (int m = 0; m < 4; ++m) { const int row = rowb + ai * 128 + m * 16;
#pragma unroll
                for (int bj = 0; bj < 2; ++bj) { f32x4 a = acc[ai][bj][m][0], b = acc[ai][bj][m][1];
#pragma unroll
                    for (int e = 0; e < 4; ++e) { a[e] = sigmoidf_(a[e]); b[e] = sigmoidf_(b[e]); }
                    *(uint4*)(G + (size_t)row * 3072 + cb + 128 * bj) = pack8(a, b); } }
    }
};
struct EpiGlu {
    static constexpr bool PERM = true, AFTER_DRAIN = false;
    bf16_t* OC; const float* bias;
    __device__ __forceinline__ void operator()(const f32x4 (&acc)[2][2][4][2], const pg8::Unit& u, int wr, int wc, int fr_, int fq_) const {
        int fr = fr_, fq = fq_; asm volatile("" : "+v"(fr), "+v"(fq));
        const int rowb = u.pm * 256 + wr * 64 + fr, col = u.pn * 128 + 32 * wc + 8 * fq;
        const f32x4 ba0 = *(const f32x4*)(bias + col), ba1 = *(const f32x4*)(bias + col + 4), bb0 = *(const f32x4*)(bias + 512 + col), bb1 = *(const f32x4*)(bias + 512 + col + 4);
#pragma unroll
        for (int ai = 0; ai < 2; ++ai)
#pragma unroll
            for (int m = 0; m < 4; ++m) { const int row = rowb + ai * 128 + m * 16;
                f32x4 a0 = acc[ai][0][m][0] + ba0, a1 = acc[ai][0][m][1] + ba1, b0 = acc[ai][1][m][0] + bb0, b1 = acc[ai][1][m][1] + bb1;
#pragma unroll
                for (int e = 0; e < 4; ++e) { a0[e] *= sigmoidf_(b0[e]); a1[e] *= sigmoidf_(b1[e]); }
                *(uint4*)(OC + (size_t)row * 512 + col) = pack8(a0, a1); }
    }
};
struct EpiBranch {
    static constexpr bool PERM = true, AFTER_DRAIN = false;
    const bf16_t* G; bf16_t* MG;
    __device__ __forceinline__ void operator()(const f32x4 (&acc)[2][2][4][2], const pg8::Unit& u, int wr, int wc, int fr_, int fq_) const {
        int fr = fr_, fq = fq_; asm volatile("" : "+v"(fr), "+v"(fq));
        const int rowb = u.pm * 256 + wr * 64 + fr, cb = u.pn * 256 + 32 * wc + 8 * fq, r = u.z;
#pragma unroll
        for (int ai = 0; ai < 2; ++ai)
#pragma unroll
            for (int m = 0; m < 4; ++m) { const int row = rowb + ai * 128 + m * 16;
#pragma unroll
                for (int bj = 0; bj < 2; ++bj) { const int col = cb + 128 * bj;
                    const uint4 gr = *(const uint4*)(G + (size_t)row * 3072 + r * 1024 + col);
                    f32x4 g0, g1;
                    g0[0] = __uint_as_float(gr.x << 16); g0[1] = __uint_as_float(gr.x & 0xffff0000u); g0[2] = __uint_as_float(gr.y << 16); g0[3] = __uint_as_float(gr.y & 0xffff0000u);
                    g1[0] = __uint_as_float(gr.z << 16); g1[1] = __uint_as_float(gr.z & 0xffff0000u); g1[2] = __uint_as_float(gr.w << 16); g1[3] = __uint_as_float(gr.w & 0xffff0000u);
                    f32x4 a = acc[ai][bj][m][0] * g0, b = acc[ai][bj][m][1] * g1;
                    bf16_t* mp = MG + (size_t)row * 1024 + col;
                    if (r > 0) { const uint4 pr = *(const uint4*)mp;
                        a[0] += __uint_as_float(pr.x << 16); a[1] += __uint_as_float(pr.x & 0xffff0000u); a[2] += __uint_as_float(pr.y << 16); a[3] += __uint_as_float(pr.y & 0xffff0000u);
                        b[0] += __uint_as_float(pr.z << 16); b[1] += __uint_as_float(pr.z & 0xffff0000u); b[2] += __uint_as_float(pr.w << 16); b[3] += __uint_as_float(pr.w & 0xffff0000u); }
                    *(uint4*)mp = pack8(a, b); } }
    }
};
struct EpiRes {
    static constexpr bool PERM = true, AFTER_DRAIN = false;
    const void* x0; const void* x1; void* o0; void* o1; const float* MODg; int in_bf16, out_bf16;
    __device__ __forceinline__ void operator()(const f32x4 (&acc)[2][2][4][2], const pg8::Unit& u, int wr, int wc, int fr_, int fq_) const {
        int fr = fr_, fq = fq_; asm volatile("" : "+v"(fr), "+v"(fq));
        const int rowb = u.pm * 256 + wr * 64 + fr, cb = u.pn * 256 + 32 * wc + 8 * fq;
        const float* mg = MODg + (size_t)cond_row(u.pm * 256) * 6144;
        const bool ctx = u.pm < NPROMPT / 256;
        const void* xi0 = ctx ? x0 : x1; void* xo0 = ctx ? o0 : o1;
#pragma unroll
        for (int bj = 0; bj < 2; ++bj) { const int col = cb + 128 * bj;
            const f32x4 m0 = *(const f32x4*)(mg + col), m1 = *(const f32x4*)(mg + col + 4);
#pragma unroll
            for (int ai = 0; ai < 2; ++ai)
#pragma unroll
                for (int m = 0; m < 4; ++m) { const int row = rowb + ai * 128 + m * 16;
                    const size_t off = (size_t)(ctx ? row : row - NPROMPT) * D + col;
                    f32x4 a, b;
                    if (in_bf16) { const uint4 w = *(const uint4*)((const bf16_t*)xi0 + off);
                        a[0] = __uint_as_float(w.x << 16); a[1] = __uint_as_float(w.x & 0xffff0000u); a[2] = __uint_as_float(w.y << 16); a[3] = __uint_as_float(w.y & 0xffff0000u);
                        b[0] = __uint_as_float(w.z << 16); b[1] = __uint_as_float(w.z & 0xffff0000u); b[2] = __uint_as_float(w.w << 16); b[3] = __uint_as_float(w.w & 0xffff0000u); }
                    else { a = *(const f32x4*)((const float*)xi0 + off); b = *(const f32x4*)((const float*)xi0 + off + 4); }
                    a += m0 * acc[ai][bj][m][0]; b += m1 * acc[ai][bj][m][1];
                    if (out_bf16) *(uint4*)((bf16_t*)xo0 + off) = pack8(a, b);
                    else { *(f32x4*)((float*)xo0 + off) = a; *(f32x4*)((float*)xo0 + off + 4) = b; } } }
    }
};
struct EpiFfn {
    static constexpr bool PERM = true, AFTER_DRAIN = false;
    bf16_t* H;
    __device__ __forceinline__ void operator()(const f32x4 (&acc)[2][2][4][2], const pg8::Unit& u, int wr, int wc, int fr_, int fq_) const {
        int fr = fr_, fq = fq_; asm volatile("" : "+v"(fr), "+v"(fq));
        const int rowb = u.pm * 256 + wr * 64 + fr, col = u.pn * 128 + 32 * wc + 8 * fq;
#pragma unroll
        for (int ai = 0; ai < 2; ++ai) {
            if (u.h != 0 && u.h != ai + 1) continue;
#pragma unroll
            for (int m = 0; m < 4; ++m) { const int row = rowb + ai * 128 + m * 16;
                f32x4 a0 = acc[ai][0][m][0], a1 = acc[ai][0][m][1];
#pragma unroll
                for (int e = 0; e < 4; ++e) { a0[e] = siluf_(a0[e]) * acc[ai][1][m][0][e]; a1[e] = siluf_(a1[e]) * acc[ai][1][m][1][e]; }
                *(uint4*)(H + (size_t)row * FFN + col) = pack8(a0, a1); } }
    }
};
struct FfnOrder {
    pg8::StaticOrder S;
    static constexpr bool HALF = true;
    __device__ bool next(int i, pg8::Unit& u) const {
        if (S.G != 256 || S.nwg != 1408) return S.next(i, u);
        if (i < 5) { S.map(i * 256 + S.c, u); return true; }
        if (i > 5) return false;
        S.map(1280 + ((S.c >> 4) << 3) + (S.c & 7), u); u.h = 1 + ((S.c >> 3) & 1); return true;
    }
    __device__ __forceinline__ void a_ready(const pg8::Unit&) const {}
    __device__ __forceinline__ void done(const pg8::Unit&) const {}
};
struct BranchOrder {
    pg8::StaticOrder S;
    static constexpr bool HALF = false;
    __device__ bool next(int i, pg8::Unit& u) const { if (i >= 3) return false; if (!S.next(0, u)) return false; u.z = i; return true; }
    __device__ __forceinline__ void a_ready(const pg8::Unit&) const {}
    __device__ __forceinline__ void done(const pg8::Unit&) const {}
};
constexpr int S5T = 32;
constexpr size_t TE_BYTES = 256 * 512 * 2, TC_BYTES = 512 * 768 * 2, TAB_TE = 0, TAB_TC = 32 * TE_BYTES;
__device__ __forceinline__ unsigned char* s5_tab(unsigned char* ws, int l) { return ws + (l == 0 ? W_TAB0 : W_TAB1); }
template <int MODE>
__device__ __forceinline__ void ph_s5_tables(const Ctx& C0) {
    PHASE_CTX(C0);
    float* sApr = (float*)C.lds;
    float* sApi = sApr + 2 * 33 * 64;
    float* sBr = sApi + 2 * 33 * 64;
    float* sBi = sBr + 2 * 64 * 16;
    float* sCr = sBi + 2 * 64 * 16;
    float* sCi = sCr + 2 * 16 * 64;
    float* sK = sCi + 2 * 16 * 64;
    float* sD = sK + 2 * 32 * 260;
    const int tid = C.tid;
    for (int item0 = (MODE == 0 ? C.G - 1 - C.bid : C.bid); item0 < (MODE == 0 ? 64 : 256); item0 += C.G) {
        const int item = MODE == 0 ? item0 * 4 : item0;
        const int l = item >> 7, g = (item >> 2) & 31, sub = item & 3;
        __syncthreads();
        constexpr int AUXF = 2 * 2 * 33 * 64 + 2 * 2 * 64 * 16 + 2 * 2 * 16 * 64;
        float* aux = WSP(float, W_KAUX) + ((size_t)l * 32 + g) * (AUXF + 16);
        if (MODE == 1) {
            f32x4 av[9];
#pragma unroll
            for (int q = 0; q < 9; ++q) { const int i = tid + q * NT; av[q] = i < AUXF / 4 ? ((const f32x4*)aux)[i] : (f32x4){0.f, 0.f, 0.f, 0.f}; }
            const float dv = tid < 16 ? aux[AUXF + tid] : 0.f;
#pragma unroll
            for (int q = 0; q < 9; ++q) { const int i = tid + q * NT; if (i < AUXF / 4) ((f32x4*)sApr)[i] = av[q]; }
            if (tid < 16) sD[tid] = dv;
        }
        if (MODE == 0) {
        for (int i = tid; i < 2 * 33 * 64; i += NT) {
            const int dir = i / (33 * 64), t = (i / 64) % 33, p = i & 63; const size_t ld = (size_t)l * 2 + dir;
            const float lr = c_s5_lam_re[(ld * 32 + g) * 64 + p], li = c_s5_lam_im[(ld * 32 + g) * 64 + p], dt = expf(c_s5_log_dt[ld * 32 + g]);
            const float mag = expf(lr * dt * (float)t); float sn, cs; sincosf(li * dt * (float)t, &sn, &cs);
            sApr[(dir * 33 + t) * 64 + p] = mag * cs; sApi[(dir * 33 + t) * 64 + p] = mag * sn; }
        if (tid < 128) {
            const int dir = tid >> 6, p = tid & 63; const size_t ld = (size_t)l * 2 + dir;
            const float lr = c_s5_lam_re[(ld * 32 + g) * 64 + p], li = c_s5_lam_im[(ld * 32 + g) * 64 + p], dt = expf(c_s5_log_dt[ld * 32 + g]);
            const float mag = expf(lr * dt); const float ar = mag * cosf(li * dt), ai = mag * sinf(li * dt), den = lr * lr + li * li;
            const float fr = ((ar - 1.f) * lr + ai * li) / den, fi = (ai * lr - (ar - 1.f) * li) / den;
            for (int c = 0; c < 16; ++c) { const float br_ = c_s5_b_re[((ld * 32 + g) * 64 + p) * 16 + c], bi_ = c_s5_b_im[((ld * 32 + g) * 64 + p) * 16 + c];
                sBr[(dir * 64 + p) * 16 + c] = fr * br_ - fi * bi_; sBi[(dir * 64 + p) * 16 + c] = fr * bi_ + fi * br_; }
            for (int o = 0; o < 16; ++o) { sCr[(dir * 16 + o) * 64 + p] = c_s5_c_re[((ld * 32 + g) * 16 + o) * 64 + p]; sCi[(dir * 16 + o) * 64 + p] = c_s5_c_im[((ld * 32 + g) * 16 + o) * 64 + p]; }
        }
        if (tid >= 128 && tid < 144) sD[tid - 128] = c_s5_d[(size_t)l * 512 + g * 16 + (tid - 128)];
        }
        __syncthreads();
        if (MODE == 0) {
            for (int i = tid; i < AUXF / 4; i += NT) ((f32x4*)aux)[i] = ((const f32x4*)sApr)[i];
            if (tid < 16) aux[AUXF + tid] = sD[tid];
        }
        if (tid < 128 && MODE == 0) {
            const int dir = tid >> 6, p = tid & 63; float* at = WSP(float, W_ATAB) + ((((size_t)l * 32 + g) * 2 + dir) * 64 + p) * 2;
            at[0] = sApr[(dir * 33 + 32) * 64 + p]; at[1] = sApi[(dir * 33 + 32) * 64 + p];
        }
        float* Kg = WSP(float, W_KG) + ((size_t)l * 32 + g) * 16384;
        if (MODE == 1) { f32x4 kv[8];
#pragma unroll
            for (int q = 0; q < 8; ++q) kv[q] = ((const f32x4*)Kg)[tid + q * NT];
#pragma unroll
            for (int q = 0; q < 8; ++q) { const int i = tid + q * NT; ((f32x4*)sK)[(i >> 6) * 65 + (i & 63)] = kv[q]; } }
        if (MODE == 0) for (int combo = tid; combo < 1024; combo += NT) {
            const int dir = combo >> 9, tau = (combo >> 4) & 31, o = combo & 15;
            float acc[16];
#pragma unroll
            for (int c = 0; c < 16; ++c) acc[c] = 0.f;
#pragma unroll 4
            for (int p = 0; p < 64; ++p) {
                const float cr = sCr[(dir * 16 + o) * 64 + p], ci = sCi[(dir * 16 + o) * 64 + p], ar = sApr[(dir * 33 + tau) * 64 + p], ai = sApi[(dir * 33 + tau) * 64 + p];
                const float wr = cr * ar - ci * ai, wi = cr * ai + ci * ar;
#pragma unroll
                for (int c = 0; c < 16; ++c) acc[c] += wr * sBr[(dir * 64 + p) * 16 + c] - wi * sBi[(dir * 64 + p) * 16 + c];
            }
#pragma unroll
            for (int c = 0; c < 16; ++c) Kg[((dir * 32 + tau) * 16 + o) * 16 + c] = acc[c];
        }
        if (MODE == 0) continue;
        __syncthreads();
        unsigned char* tab = s5_tab(WS_, l);
        bf16_t* TC = (bf16_t*)(tab + TAB_TC + (size_t)g * TC_BYTES);
        bf16_t* TE = (bf16_t*)(tab + TAB_TE + (size_t)g * TE_BYTES);
        for (int ch = tid; ch < 128 * 64; ch += NT) {
            const int n = sub * 128 + (ch >> 6), kc = ch & 63, j = n >> 4, o = n & 15, i = kc >> 1, c0 = (kc & 1) * 8;
            const float* src = sK + (i <= j ? j - i : 32 + i - j) * 260 + o * 16 + c0;
            f32x4 a = *(const f32x4*)src, b = *(const f32x4*)(src + 4);
            if (i == j) { const float* s1 = sK + 32 * 260 + o * 16 + c0; a += *(const f32x4*)s1; b += *(const f32x4*)(s1 + 4); const float dv = sD[o];
#pragma unroll
                for (int e = 0; e < 4; ++e) { a[e] += (o == c0 + e) ? dv : 0.f; b[e] += (o == c0 + 4 + e) ? dv : 0.f; } }
            *(uint4*)(TC + (size_t)n * 768 + kc * 8) = pack8(a, b);
        }
        for (int ch = tid; ch < 128 * 32; ch += NT) {
            const int n = sub * 128 + (ch >> 5), kq = ch & 31, j = n >> 4, o = n & 15;
            const int kk = kq * 8, dir = kk >> 7, ri = (kk >> 6) & 1, p0 = kk & 63; const int tau = dir == 0 ? j + 1 : S5T - j;
            const float* pc = sCr + (dir * 16 + o) * 64 + p0; const float* pa = sApr + (dir * 33 + tau) * 64 + p0;
            const f32x4 cr0 = *(const f32x4*)pc, cr1 = *(const f32x4*)(pc + 4), ci0 = *(const f32x4*)(pc + 2 * 16 * 64), ci1 = *(const f32x4*)(pc + 2 * 16 * 64 + 4);
            const f32x4 ar0 = *(const f32x4*)pa, ar1 = *(const f32x4*)(pa + 4), ai0 = *(const f32x4*)(pa + 2 * 33 * 64), ai1 = *(const f32x4*)(pa + 2 * 33 * 64 + 4);
            const f32x4 v0 = ri == 0 ? (cr0 * ar0 - ci0 * ai0) : -(cr0 * ai0 + ci0 * ar0), v1 = ri == 0 ? (cr1 * ar1 - ci1 * ai1) : -(cr1 * ai1 + ci1 * ar1);
            *(uint4*)(TC + (size_t)n * 768 + 512 + kq * 8) = pack8(v0, v1);
        }
        for (int ch = tid; ch < 64 * 64; ch += NT) {
            const int n = sub * 64 + (ch >> 6), kc = ch & 63, dir = n >> 7, ri = (n >> 6) & 1, p = n & 63, i = kc >> 1, c0 = (kc & 1) * 8;
            const int tau = dir == 0 ? S5T - 1 - i : i;
            const float ar = sApr[(dir * 33 + tau) * 64 + p], ai = sApi[(dir * 33 + tau) * 64 + p];
            float v[8];
#pragma unroll
            for (int e = 0; e < 8; ++e) { const float br_ = sBr[(dir * 64 + p) * 16 + c0 + e], bi_ = sBi[(dir * 64 + p) * 16 + c0 + e];
                v[e] = ri == 0 ? (ar * br_ - ai * bi_) : (ar * bi_ + ai * br_); }
            uint4 w; w.x = pk2(v[0], v[1]); w.y = pk2(v[2], v[3]); w.z = pk2(v[4], v[5]); w.w = pk2(v[6], v[7]);
            *(uint4*)(TE + (size_t)n * 512 + kc * 8) = w;
        }
    }
}
__device__ __forceinline__ void ph_s5_scan(const Ctx& C0, int l) {
    PHASE_CTX(C0);
    const int lane = C.lane;
    const float* HL = WSP(float, W_HLOC); bf16_t* UH = WSP(bf16_t, W_UH);
    for (int w0 = C.bid * NWAVE + C.wave; w0 < 36 * 64; w0 += C.G * NWAVE) {
        const int w = (w0 + 36 * 64 - 512) % (36 * 64);
        const int dir = w & 1, g = (w >> 1) & 31, s = 35 - (w >> 6);
        const bool latent = s >= 32;
        const int nch = latent ? 64 : 8, ch0 = latent ? 256 + (s - 32) * 64 : s * 8;
        const float* at = WSP(float, W_ATAB) + ((((size_t)l * 32 + g) * 2 + dir) * 64 + lane) * 2;
        const float ar = at[0], ai = at[1];
        float hr = 0.f, hi = 0.f;
        if (latent) { const float* si = c_state_s5 + ((((size_t)(s - 32) * 2 + l) * 2 + dir) * 2) * 2048 + g * 64 + lane; hr = si[0]; hi = si[2048]; }
#pragma unroll 4
        for (int n = 0; n < nch; ++n) {
            const int ch = ch0 + (dir == 0 ? n : nch - 1 - n);
            const float* hl = HL + ((size_t)g * 512 + ch) * 256 + dir * 128 + lane;
            const float lr_ = hl[0], li_ = hl[64];
            bf16_t* uh = UH + ((size_t)g * 512 + ch) * 768 + 512 + dir * 128 + lane;
            uh[0] = f2bf(hr); uh[64] = f2bf(hi);
            const float nr = ar * hr - ai * hi + lr_, ni = ar * hi + ai * hr + li_;
            hr = nr; hi = ni;
        }
        if (!latent) { float* so = c_out + O_NS + ((((size_t)s * 2 + l) * 2 + dir) * 2) * 2048 + g * 64 + lane; so[0] = hr; so[2048] = hi; }
    }
}
struct ZOrder {
    int nz, nM, nN, G, c;
    static constexpr bool HALF = false;
    __device__ bool next(int i, pg8::Unit& u) const { const int L = i * G + c; if (c >= G || L >= nz * nM * nN) return false; u.h = 0; u.z = L / (nM * nN); const int r = L % (nM * nN); u.pm = r % nM; u.pn = r / nM; return true; }
    __device__ __forceinline__ void a_ready(const pg8::Unit&) const {}
    __device__ __forceinline__ void done(const pg8::Unit&) const {}
};
struct EpiHloc {
    static constexpr bool PERM = true, AFTER_DRAIN = false;
    float* HL;
    __device__ __forceinline__ void operator()(const f32x4 (&acc)[2][2][4][2], const pg8::Unit& u, int wr, int wc, int fr_, int fq_) const {
        int fr = fr_, fq = fq_; asm volatile("" : "+v"(fr), "+v"(fq));
        const int rowb = u.pm * 256 + wr * 64 + fr, cb = 32 * wc + 8 * fq;
#pragma unroll
        for (int ai = 0; ai < 2; ++ai)
#pragma unroll
            for (int m = 0; m < 4; ++m) { const int row = rowb + ai * 128 + m * 16;
#pragma unroll
                for (int bj = 0; bj < 2; ++bj) { float* o = HL + ((size_t)u.z * 512 + row) * 256 + 128 * bj + cb; *(f32x4*)o = acc[ai][bj][m][0]; *(f32x4*)(o + 4) = acc[ai][bj][m][1]; } }
    }
};
struct EpiS5Y {
    static constexpr bool PERM = true, AFTER_DRAIN = false;
    bf16_t* YC;
    __device__ __forceinline__ void operator()(const f32x4 (&acc)[2][2][4][2], const pg8::Unit& u, int wr, int wc, int fr_, int fq_) const {
        int fr = fr_, fq = fq_; asm volatile("" : "+v"(fr), "+v"(fq));
        const int rowb = u.pm * 256 + wr * 64 + fr, g = u.z;
#pragma unroll
        for (int ai = 0; ai < 2; ++ai)
#pragma unroll
            for (int m = 0; m < 4; ++m) { const int chunk = rowb + ai * 128 + m * 16;
#pragma unroll
                for (int bj = 0; bj < 2; ++bj) { const int n = u.pn * 256 + 128 * bj + 32 * wc + 8 * fq, j = n >> 4, o0 = n & 15;
                    f32x4 a = acc[ai][bj][m][0], b = acc[ai][bj][m][1];
#pragma unroll
                    for (int e = 0; e < 4; ++e) { a[e] = gelu_tanh(a[e]); b[e] = gelu_tanh(b[e]); }
                    *(uint4*)(YC + ((size_t)chunk * 32 + j) * 512 + g * 16 + o0) = pack8(a, b); } }
    }
};
template <class Epi, class Sched>
__device__ __forceinline__ void run_gemm(const Ctx& C, const bf16_t* A, const bf16_t* Bt, int N, int K, size_t za, size_t zb, const Sched& S, const Epi& E, int lda = 0, int ldb = 0) {
    __syncthreads();
    pg8::Gemm g{A, Bt, M, N, K, za, zb, lda ? lda : K, ldb ? ldb : K};
    pg8::gemm_phase<Epi, Sched, true, true>((LAS unsigned char*)C.lds, g, S, E);
}

#define LAYER_PTRS() const float* MODl = c_MOD + (size_t)l * 5 * 6144; const float* xin0 = l == 0 ? c_x_prompt : c_X; const float* xin1 = l == 0 ? c_x_sample : c_X + (size_t)NPROMPT * D; \
    unsigned char* wb = WS_ + W_WB + (size_t)l * WB_LAYER; (void)MODl; (void)xin0; (void)xin1; (void)wb
__device__ __forceinline__ void g_norm1(const Ctx& C0, int l) { PHASE_CTX(C0); LAYER_PTRS(); if (l == 0) ph_norm(C, c_x_prompt, c_x_sample, false, c_norm1_g + l * 1024, MODl, 0); else ph_norm(C, WSP(bf16_t, W_XB0), WSP(bf16_t, W_XB1), true, c_norm1_g + l * 1024, MODl, 0); }
__device__ __forceinline__ void g_norm2(const Ctx& C0, int l) { PHASE_CTX(C0); LAYER_PTRS(); ph_norm(C, WSP(bf16_t, W_XB0), WSP(bf16_t, W_XB1), true, c_norm2_g + l * 1024, MODl, 1); }
__device__ __forceinline__ void g_inproj(const Ctx& C0, int l) { PHASE_CTX(C0); LAYER_PTRS();
    EpiIn e{WS_, OUT_, c_qn_g + l * 64, c_kn_g + l * 64, l, 0}; pg8::StaticOrder S; S.init(M, 3840, C.G, C.bid);
    run_gemm(C, c_XN, (const bf16_t*)(wb + WB_WI), 3840, 1024, 0, 0, S, e); }
__device__ __forceinline__ void g_s5a(const Ctx& C0, int l) { PHASE_CTX(C0);
    EpiHloc e{WSP(float, W_HLOC)}; ZOrder S{32, 2, 1, C.G, C.bid};
    run_gemm(C, WSP(bf16_t, W_UH), (const bf16_t*)(s5_tab(WS_, l) + TAB_TE), 256, 512, (size_t)512 * 768 * 2, TE_BYTES, S, e, 768, 512); }
__device__ __forceinline__ void g_s5c(const Ctx& C0, int l) { PHASE_CTX(C0);
    EpiS5Y e{c_YF}; ZOrder S{32, 2, 2, C.G, C.bid};
    run_gemm(C, WSP(bf16_t, W_UH), (const bf16_t*)(s5_tab(WS_, l) + TAB_TC), 512, 768, (size_t)512 * 768 * 2, TC_BYTES, S, e, 768, 768); }
__device__ __forceinline__ void g_glu(const Ctx& C0, int l) { PHASE_CTX(C0); LAYER_PTRS();
    EpiGlu e{c_OC, c_s5_b_glu + (size_t)l * 1024}; pg8::StaticOrder S; S.init(M, 1024, C.G, C.bid);
    run_gemm(C, c_YF, (const bf16_t*)(wb + WB_WG), 1024, 512, 0, 0, S, e); }
__device__ __forceinline__ void g_gates(const Ctx& C0, int l) { PHASE_CTX(C0); LAYER_PTRS();
    EpiGate e{c_GATES}; pg8::StaticOrder S; S.init(M, 3072, C.G, C.bid);
    run_gemm(C, c_XN, (const bf16_t*)(wb + WB_WZ), 3072, 1024, 0, 0, S, e); }
__device__ __forceinline__ void g_branch(const Ctx& C0, int l) { PHASE_CTX(C0); LAYER_PTRS();
    EpiBranch e{c_GATES, c_MERGED}; BranchOrder S; S.S.init(M, 1024, C.G, C.bid);
    run_gemm(C, c_OA, (const bf16_t*)(wb + WB_WR), 1024, 512, (size_t)M * 512 * 2, (size_t)1024 * 512 * 2, S, e); }
__device__ __forceinline__ void g_out(const Ctx& C0, int l) { PHASE_CTX(C0); LAYER_PTRS();
    EpiRes e{WSP(bf16_t, W_XB0), WSP(bf16_t, W_XB1), WSP(bf16_t, W_XB0), WSP(bf16_t, W_XB1), MODl + 2048, 1, 1};
    if (l == 0) { e.x0 = c_x_prompt; e.x1 = c_x_sample; e.in_bf16 = 0; }
    pg8::StaticOrder S; S.init(M, 1024, C.G, C.bid);
    run_gemm(C, c_MERGED, (const bf16_t*)(wb + WB_WO), 1024, 1024, 0, 0, S, e); }
__device__ __forceinline__ void g_ffn(const Ctx& C0, int l) { PHASE_CTX(C0); LAYER_PTRS();
    EpiFfn e{c_H}; FfnOrder S; S.S.init(M, 5632, C.G, C.bid);
    run_gemm(C, c_XN, (const bf16_t*)(wb + WB_WU), 5632, 1024, 0, 0, S, e); }
__device__ __forceinline__ void g_down(const Ctx& C0, int l) { PHASE_CTX(C0); LAYER_PTRS();
    EpiRes e{WSP(bf16_t, W_XB0), WSP(bf16_t, W_XB1), WSP(bf16_t, W_XB0), WSP(bf16_t, W_XB1), MODl + 5120, 1, 1};
    if (l == 1) { e.o0 = c_X; e.o1 = c_X + (size_t)NPROMPT * D; e.out_bf16 = 0; }
    pg8::StaticOrder S; S.init(M, 1024, C.G, C.bid);
    run_gemm(C, c_H, (const bf16_t*)(wb + WB_WD), 1024, FFN, 0, 0, S, e); }

__global__ void __launch_bounds__(NT, 2) mk_fwd(Params P_unused) {
    extern __shared__ __attribute__((aligned(16))) unsigned char lds[];
    Ctx C;
    C.lds = lds; C.tid = threadIdx.x; C.lane = C.tid & 63; C.wave = __builtin_amdgcn_readfirstlane(C.tid >> 6); C.G = gridDim.x; C.bid = blockIdx.x;
    volatile LAS unsigned* MISCL = (volatile LAS unsigned*)((LAS unsigned char*)lds + LDS_MISC);
    if (C.tid < 64) MISCL[C.tid] = 0u;
    __syncthreads();
    XcdBarrier bar;
    { KArgPtr Pk = kargs(); bar = xcd_barrier_post((unsigned*)(WS_ + W_CTL) + 1024, MISCL + 8); }
#define GRID_BAR() xcd_barrier(bar)

#ifndef DUP
#define DUP -1
#endif
#define RUN(id, stmt) do { stmt; if (DUP == (id)) { stmt; } } while (0)
    RUN(0, ph_s5_tables<0>(C); ph_mod(C); ph_prep(C); ph_wconv(C));
    if (DUP == 30) ph_s5_tables<0>(C); if (DUP == 31) ph_mod(C); if (DUP == 32) ph_wconv(C);
    GRID_BAR();
#pragma unroll 1
    for (int l0 = 0; l0 < 2; ++l0) {
        const int l = launder_s(l0);
        if (l == 0) { RUN(33, ph_s5_tables<1>(C)); }
        RUN(1, g_norm1(C, l));
        GRID_BAR();
        RUN(2, g_inproj(C, l)); ph_cache(C, l, C.G - C.G / 4);
        GRID_BAR();
        RUN(3, ph_gla_prep(C, l)); RUN(4, g_s5a(C, l));
        GRID_BAR();
        RUN(5, ph_gla_scan(C, l)); RUN(6, ph_s5_scan(C, l)); RUN(7, ph_attn(C, l, 256, 512)); if (DUP == 16) ph_attn(C, l, 0, 256); if (DUP == 17) ph_attn(C, l, 256, 512);
        if (DUP >= 21 && DUP <= 26) ph_attn<DUP - 20>(C, l, 256, 512);
        GRID_BAR();
        RUN(8, ph_gla_out(C, l)); RUN(9, g_s5c(C, l));
        if (C.G == 256) { __syncthreads(); ph_attn(C, l, 0, 256, 128); } else ph_attn(C, l, 0, 256);
        GRID_BAR();
        RUN(10, g_glu(C, l)); RUN(11, g_gates(C, l));
        GRID_BAR();
        RUN(12, g_branch(C, l));
        GRID_BAR();
        g_out(C, l);
        GRID_BAR();
        RUN(13, g_norm2(C, l));
        GRID_BAR();
        RUN(14, g_ffn(C, l));
        GRID_BAR();
        g_down(C, l);
        GRID_BAR();
        if (DUP == 15) { for (int q = 0; q < 10; ++q) GRID_BAR(); }
    }
}

extern "C" void kernel_launch(void* const* d_in, const int* in_sizes, int n_in, void* d_out, int out_size, void* d_ws, size_t ws_size, hipStream_t stream) {
    static int grid = 0;
    if (grid == 0) {
        if (n_in != 35 || ws_size < W_END) { fprintf(stderr, "kernel_launch: unexpected n_in %d / ws %zu\n", n_in, ws_size); grid = -1; return; }
        int dev = 0, cus = 0, per_cu = 0;
        if (hipGetDevice(&dev) != hipSuccess || hipDeviceGetAttribute(&cus, hipDeviceAttributeMultiprocessorCount, dev) != hipSuccess) { grid = -1; return; }
        if (hipFuncSetAttribute((const void*)mk_fwd, hipFuncAttributeMaxDynamicSharedMemorySize, LDS_BYTES) != hipSuccess) { fprintf(stderr, "kernel_launch: hipFuncSetAttribute failed\n"); grid = -1; return; }
        if (hipOccupancyMaxActiveBlocksPerMultiprocessor(&per_cu, (const void*)mk_fwd, NT, LDS_BYTES) != hipSuccess || per_cu < 1) { fprintf(stderr, "kernel_launch: occupancy query says %d\n", per_cu); per_cu = 1; }
        (void)hipGetLastError();
        grid = cus;
    }
    if (grid < 0) return;
    (void)hipMemsetAsync((char*)d_ws + W_CTL, 0, CTL_BYTES, stream);
    Params p{};
    for (int i = 0; i < 35; ++i) p.in[i] = (const float*)d_in[i];
    p.out = (float*)d_out; p.ws = (unsigned char*)d_ws;
    hipLaunchKernelGGL(mk_fwd, dim3(grid), dim3(NT), LDS_BYTES, stream, p);
}
```

```cpp
#include <hip/hip_runtime.h>
#include <stdint.h>
#include <cstdio>

typedef unsigned short bf16_t;
typedef short bf16x8 __attribute__((ext_vector_type(8)));
typedef float f32x4 __attribute__((ext_vector_type(4)));
#define LAS __attribute__((address_space(3)))

constexpr int D = 1024, NPROMPT = 8192, M = 16384;
constexpr int SEQ = 256, DSEQ = 2048;
constexpr int IN_DIM = 6688, FFN = 2816;
constexpr float EPS = 1e-6f;
constexpr int C_AQ = 0, C_AK = 512, C_AV = 1024, C_BQ = 1536, C_BK = 1792, C_BV = 2048, C_BG = 2560, C_BR = 3072, C_CU = 3104, C_GZ = 3616;
constexpr int N_MIX = 3616;
constexpr size_t O_YP = 0, O_YS = 8388608, O_NK = 16777216, O_NV = 25165824, O_NG = 33554432, O_NS = 37748736;

constexpr size_t MiB = 1u << 20;
constexpr size_t W_CTL = 0, CTL_BYTES = 65536;
constexpr size_t W_MOD = 65536;
constexpr size_t W_MISC = 65536 + 262144;
constexpr size_t W_XN = 1 * MiB;
constexpr size_t W_AQ = 33 * MiB;
constexpr size_t W_AK = 49 * MiB;
constexpr size_t W_AV = 66 * MiB;
constexpr size_t W_BQ = 83 * MiB;
constexpr size_t W_BK = 91 * MiB;
constexpr size_t W_BV = 99 * MiB;
constexpr size_t W_BG = 115 * MiB;
constexpr size_t W_BR = 131 * MiB;
constexpr size_t W_CU = 133 * MiB;
constexpr size_t W_GF = 149 * MiB;
constexpr size_t W_GB = 165 * MiB;
constexpr size_t W_YF = 181 * MiB;
constexpr size_t W_OA = 197 * MiB;
constexpr size_t W_OB = 213 * MiB;
constexpr size_t W_OC = 229 * MiB;
constexpr size_t W_GATES = 245 * MiB;
constexpr size_t W_GDS = 149 * MiB;
constexpr size_t W_GLA = 245 * MiB;
constexpr size_t W_MERGED = 341 * MiB;
constexpr size_t W_H = 373 * MiB;
constexpr size_t W_MF = W_H;
constexpr size_t W_WB = 461 * MiB;
constexpr size_t WB_LAYER = 36 * MiB;
constexpr size_t WB_WI = 0, WB_WZ = WB_WI + 3840 * 1024 * 2, WB_WG = WB_WZ + 3072 * 1024 * 2, WB_WR = WB_WG + 1024 * 512 * 2, WB_WO = WB_WR + 3 * 1024 * 512 * 2,
                 WB_WU = WB_WO + 1024 * 1024 * 2, WB_WD = WB_WU + 5632 * 1024 * 2;
static_assert(WB_WD + 1024 * 2816 * 2 == WB_LAYER, "weight copy map");
constexpr size_t W_TAB0 = 373 * MiB;
constexpr size_t W_UH = 405 * MiB;
constexpr size_t W_HLOC = 429 * MiB;
constexpr size_t W_TAB1 = 533 * MiB;
constexpr size_t W_ATAB = 524288;
constexpr size_t W_KG = 565 * MiB;
constexpr size_t W_KAUX = 569 * MiB;
constexpr size_t W_XB0 = 133 * MiB;
constexpr size_t W_XB1 = 565 * MiB;
constexpr size_t W_END = 581 * MiB;

constexpr int NT = 512, NWAVE = 8;
constexpr int LDS_BYTES = 163840;
constexpr int LDS_MISC = 163840 - 256;

__device__ __forceinline__ float bf2f(bf16_t h) { return __uint_as_float((unsigned)h << 16); }
typedef float f32x2_t __attribute__((ext_vector_type(2)));
typedef __bf16 bf16x2_t __attribute__((ext_vector_type(2)));
__device__ __forceinline__ unsigned pk2(float lo, float hi) { const f32x2_t v = {lo, hi}; return __builtin_bit_cast(unsigned, __builtin_convertvector(v, bf16x2_t)); }
__device__ __forceinline__ unsigned pk2_valu(float lo, float hi) { unsigned r; asm("v_cvt_pk_bf16_f32 %0, %1, %2" : "=v"(r) : "v"(lo), "v"(hi)); return r; }
__device__ __forceinline__ bf16_t f2bf(float f) { return (bf16_t)(pk2(f, 0.f) & 0xffffu); }
__device__ __forceinline__ float shx(float v, int k, int lane) { return __builtin_bit_cast(float, __builtin_amdgcn_ds_bpermute((lane ^ k) << 2, __builtin_bit_cast(int, v))); }
__device__ __forceinline__ float xsum32(float v) { const auto rr = __builtin_amdgcn_permlane32_swap(__float_as_uint(v), __float_as_uint(v), false, false); return __uint_as_float(rr[0]) + __uint_as_float(rr[1]); }
__device__ __forceinline__ float sigmoidf_(float x) { return 1.f / (1.f + __expf(-x)); }
__device__ __forceinline__ float siluf_(float x) { return x / (1.f + __expf(-x)); }
__device__ __forceinline__ float gelu_tanh(float x) { return 0.5f * x * (1.f + tanhf(0.7978845608028654f * (x + 0.044715f * x * x * x))); }
__device__ __forceinline__ int cond_row(int m) { return m < NPROMPT ? 0 : 1 + ((m - NPROMPT) >> 11); }
__device__ __forceinline__ int krow_of(int m) { return m < NPROMPT ? m : NPROMPT + ((m - NPROMPT) >> 11) * 2304 + 256 + ((m - NPROMPT) & 2047); }

#define XB_TMO      128
#define XB_XCNT(j)  (256  + 64 * (j))
#define XB_XSUB(j)  (1280 + 64 * (j))
#define XB_XGEN(j)  (2304 + 64 * (j))
#define XB_TOP      3328
#define XB_TOPGEN   3392
#define XCD_BAR_WORDS 3456
#define XB_SPIN_CAP (1u << 18)
__device__ __forceinline__ unsigned xb_ld(unsigned* p)              { return __hip_atomic_load(p, __ATOMIC_RELAXED, __HIP_MEMORY_SCOPE_AGENT); }
__device__ __forceinline__ unsigned xb_add(unsigned* p, unsigned v) { return __hip_atomic_fetch_add(p, v, __ATOMIC_RELAXED, __HIP_MEMORY_SCOPE_AGENT); }
__device__ __forceinline__ unsigned xb_xcc_id() { return (unsigned)__builtin_amdgcn_s_getreg((3 << 11) | 20) & 0xFu; }
#define XB_SPIN(cond, bar) do { unsigned _sp = 0; while (cond) { __builtin_amdgcn_s_sleep(1); \
    if ((++_sp & 255u) == 0u) { if (xb_ld(&(bar)[XB_TMO])) break; if (_sp > XB_SPIN_CAP) { atomicAdd(&(bar)[XB_TMO], 1u); break; } } } } while (0)
struct XcdBarrier { unsigned* bar; unsigned x; volatile LAS unsigned* st; };
__device__ __forceinline__ XcdBarrier xcd_barrier_post(unsigned* bar, volatile LAS unsigned* st) {
    XcdBarrier b; b.bar = bar; b.x = xb_xcc_id(); b.st = st;
    if (threadIdx.x == 0) (void)xb_add(&bar[XB_XCNT(b.x)], 1u);
    return b;
}
__device__ __forceinline__ void xcd_barrier_complete(unsigned* bar, unsigned x, unsigned& nloc, unsigned& nx) {
    const unsigned G = gridDim.x * gridDim.y * gridDim.z;
    unsigned sum, cnt, mine, sp = 0u;
    for (;;) {
        sum = 0u; cnt = 0u; mine = 0u;
#pragma unroll
        for (unsigned j = 0; j < 16; ++j) { const unsigned c = xb_ld(&bar[XB_XCNT(j)]); sum += c; cnt += (c > 0u) ? 1u : 0u; mine = (j == x) ? c : mine; }
        if (sum == G) break;
        __builtin_amdgcn_s_sleep(1);
        if ((++sp & 255u) == 0u) { if (xb_ld(&bar[XB_TMO])) break; if (sp > XB_SPIN_CAP) { atomicAdd(&bar[XB_TMO], 1u); break; } }
    }
    nloc = mine > 0u ? mine : 1u; nx = cnt > 0u ? cnt : 1u;
}
__device__ __forceinline__ void xcd_barrier(const XcdBarrier& b) {
    asm volatile("s_waitcnt vmcnt(0)" ::: "memory");
    __syncthreads();
    if (threadIdx.x == 0) {
        unsigned* bar = b.bar; asm volatile("" : "+s"(bar));
        unsigned bx = b.x; asm volatile("" : "+s"(bx));
        __builtin_amdgcn_s_waitcnt(0);
        unsigned nloc = b.st[0], nx = b.st[1];
        if (nloc == 0u) { xcd_barrier_complete(bar, bx, nloc, nx); b.st[0] = nloc; b.st[1] = nx; }
        const unsigned old = xb_add(&bar[XB_XSUB(bx)], 1u);
        const unsigned gen = old / nloc;
        if (old + 1u == (gen + 1u) * nloc) {
            __builtin_amdgcn_fence(__ATOMIC_RELEASE, "agent");
            asm volatile("s_waitcnt vmcnt(0)" ::: "memory");
            const unsigned og = xb_add(&bar[XB_TOP], 1u);
            const unsigned tg = og / nx;
            if (og + 1u == (tg + 1u) * nx) xb_add(&bar[XB_TOPGEN], 1u);
            else XB_SPIN(xb_ld(&bar[XB_TOPGEN]) == tg, bar);
            __builtin_amdgcn_fence(__ATOMIC_ACQUIRE, "agent");
            xb_add(&bar[XB_XGEN(bx)], 1u);
            asm volatile("s_waitcnt vmcnt(0)" ::: "memory");
        } else {
            XB_SPIN(xb_ld(&bar[XB_XGEN(bx)]) == gen, bar);
            __builtin_amdgcn_fence(__ATOMIC_ACQUIRE, "agent");
            asm volatile("s_waitcnt vmcnt(0)" ::: "memory");
        }
    }
    __syncthreads();
}

__device__ __forceinline__ int launder_v(int x) { asm volatile("" : "+v"(x)); return x; }
__device__ __forceinline__ int launder_s(int x) { asm volatile("" : "+s"(x)); return x; }
struct Params { const float* in[35]; float* out; unsigned char* ws; };
struct Ctx {
    unsigned char* lds;
    int tid, lane, wave, G, bid;
};
typedef const __attribute__((address_space(4))) Params* KArgPtr;
__device__ __forceinline__ KArgPtr kargs() { KArgPtr p = (KArgPtr)__builtin_amdgcn_kernarg_segment_ptr(); asm volatile("" : "+s"(p)); return p; }
#define PHASE_CTX(C0) KArgPtr Pk = kargs(); Ctx C = (C0); C.tid = launder_v(C0.tid); C.lane = C.tid & 63; C.wave = __builtin_amdgcn_readfirstlane(C.tid >> 6); C.bid = launder_s(C0.bid)
#define GAS __attribute__((address_space(1)))
#define IN_(i) ((const float*)(GAS const float*)(Pk->in[i]))
#define WS_ ((unsigned char*)(GAS unsigned char*)(Pk->ws))
#define OUT_ ((float*)(GAS float*)(Pk->out))
#define WSP(T, off) ((T*)(WS_ + (off)))
#define c_x_prompt IN_(0)
#define c_x_sample IN_(1)
#define c_cache_k IN_(2)
#define c_cache_v IN_(3)
#define c_state_gla IN_(4)
#define c_state_s5 IN_(5)
#define c_c IN_(6)
#define c_c_ctx IN_(7)
#define c_w_mod IN_(8)
#define c_b_mod IN_(9)
#define c_norm1_g IN_(10)
#define c_norm2_g IN_(11)
#define c_w_in IN_(12)
#define c_qn_g IN_(13)
#define c_kn_g IN_(14)
#define c_diff_lam IN_(15)
#define c_subln_g IN_(16)
#define c_gla_wa2 IN_(17)
#define c_gla_ba IN_(18)
#define c_gla_on_g IN_(19)
#define c_s5_lam_re IN_(20)
#define c_s5_lam_im IN_(21)
#define c_s5_log_dt IN_(22)
#define c_s5_b_re IN_(23)
#define c_s5_b_im IN_(24)
#define c_s5_c_re IN_(25)
#define c_s5_c_im IN_(26)
#define c_s5_d IN_(27)
#define c_s5_w_glu IN_(28)
#define c_s5_b_glu IN_(29)
#define c_w_branch IN_(30)
#define c_w_out IN_(31)
#define c_w_gate IN_(32)
#define c_w_up IN_(33)
#define c_w_down IN_(34)
#define c_out OUT_
#define c_X (OUT_ + O_YP)
#define c_MOD WSP(float, W_MOD)
#define c_MISC WSP(float, W_MISC)
#define c_XN WSP(bf16_t, W_XN)
#define c_AQ WSP(bf16_t, W_AQ)
#define c_AK WSP(bf16_t, W_AK)
#define c_AV WSP(bf16_t, W_AV)
#define c_BQ WSP(bf16_t, W_BQ)
#define c_BK WSP(bf16_t, W_BK)
#define c_BV WSP(bf16_t, W_BV)
#define c_BG WSP(bf16_t, W_BG)
#define c_BR WSP(float, W_BR)
#define c_CU WSP(bf16_t, W_CU)
#define c_GF WSP(bf16_t, W_GF)
#define c_GB WSP(bf16_t, W_GB)
#define c_YF WSP(bf16_t, W_YF)
#define c_OA WSP(bf16_t, W_OA)
#define c_OB WSP(bf16_t, W_OB)
#define c_OC WSP(bf16_t, W_OC)
#define c_GATES WSP(bf16_t, W_GATES)
#define c_MERGED WSP(bf16_t, W_MERGED)
#define c_H WSP(bf16_t, W_H)

__device__ __forceinline__ void ph_mod(const Ctx& C0) {
    PHASE_CTX(C0);
    float (*sc)[1024] = (float (*)[1024])C.lds;
    float (*red)[5][64] = (float (*)[5][64])(C.lds + 5 * 1024 * 4);
    for (int item = C.bid; item < 192; item += C.G) {
        const int l = item / 96, n0 = (item % 96) * 64, tid = C.tid;
        __syncthreads();
        for (int i = tid; i < 5 * 1024; i += NT) { const int r = i >> 10, k = i & 1023; const float v = r == 0 ? c_c_ctx[k] : c_c[(r - 1) * 1024 + k]; sc[r][k] = siluf_(v); }
        __syncthreads();
        const int cn = tid & 63, ks = tid >> 6;
        float acc[5] = {0.f, 0.f, 0.f, 0.f, 0.f};
        const float* w = c_w_mod + (size_t)l * 1024 * 6144 + n0 + cn;
        for (int k = ks * 128; k < ks * 128 + 128; ++k) { const float wv = w[(size_t)k * 6144];
#pragma unroll
            for (int r = 0; r < 5; ++r) acc[r] += sc[r][k] * wv; }
#pragma unroll
        for (int r = 0; r < 5; ++r) red[ks][r][cn] = acc[r];
        __syncthreads();
        if (tid < 320) { const int r = tid >> 6, cc = tid & 63; float s = 0.f;
#pragma unroll
            for (int k8 = 0; k8 < 8; ++k8) s += red[k8][r][cc];
            c_MOD[((size_t)l * 5 + r) * 6144 + n0 + cc] = s + c_b_mod[(size_t)l * 6144 + n0 + cc]; }
    }
}
__device__ __forceinline__ void ph_prep(const Ctx& C0) {
    PHASE_CTX(C0);
    if (C.bid != C.G - 1) return;
    const int tid = C.tid; float* misc = c_MISC;
    if (tid < 2) {
        const float* lv = c_diff_lam + tid * 256; float s01 = 0.f, s23 = 0.f;
        for (int i = 0; i < 64; ++i) { s01 += lv[i] * lv[64 + i]; s23 += lv[128 + i] * lv[192 + i]; }
        const float lam_init = 0.8f - 0.6f * expf(-0.3f * (float)tid);
        misc[tid] = expf(s01) - expf(s23) + lam_init;
    }
    for (int i = tid; i < 64 * 16; i += NT) {
        const int pos = i >> 4, f = i & 15;
        const float inv = powf(10000.f, -(float)(2 * f) / 32.f);
        const float ang = (float)pos * inv;
        misc[64 + i] = cosf(ang); misc[64 + 1024 + i] = sinf(ang);
    }
}
__device__ __forceinline__ void ph_cache(const Ctx& C0, int l, int wg0 = 0) {
    PHASE_CTX(C0);
    if (C.bid < wg0) return;
#pragma unroll 4
    for (int i = (C.bid - wg0) * NT + C.tid; i < 4 * 256 * 128; i += (C.G - wg0) * NT) {
        const int col = (i & 127) * 4, j = (i >> 7) & 255, b = i >> 15;
        const size_t src = ((size_t)(b * 2 + l) * 256 + j) * 512 + col;
        const size_t dst = (size_t)(NPROMPT + b * 2304 + j) * 512 + col;
        const f32x4 kx = *(const f32x4*)(c_cache_k + src), vx = *(const f32x4*)(c_cache_v + src);
        uint2 ko, vo; ko.x = pk2(kx[0], kx[1]); ko.y = pk2(kx[2], kx[3]); vo.x = pk2(vx[0], vx[1]); vo.y = pk2(vx[2], vx[3]);
        *(uint2*)(c_AK + dst) = ko; *(uint2*)(c_AV + dst) = vo;
    }
}
__device__ __forceinline__ void ph_norm(const Ctx& C0, const void* x0, const void* x1, bool in_bf16, const float* g, const float* MODl, int which) {
    PHASE_CTX(C0);
    const int lane = C.lane;
    for (int m = C.bid * NWAVE + C.wave; m < M; m += C.G * NWAVE) {
        const size_t ro = m < NPROMPT ? (size_t)m * D : (size_t)(m - NPROMPT) * D;
        const float* mod = MODl + (size_t)cond_row(m) * 6144 + which * 3072;
        float4 v[4]; float ss = 0.f;
        if (in_bf16) { const bf16_t* xr = (const bf16_t*)(m < NPROMPT ? x0 : x1) + ro;
#pragma unroll
            for (int j = 0; j < 4; ++j) { const uint2 w = *(const uint2*)(xr + j * 256 + lane * 4);
                v[j] = make_float4(__uint_as_float(w.x << 16), __uint_as_float(w.x & 0xffff0000u), __uint_as_float(w.y << 16), __uint_as_float(w.y & 0xffff0000u)); }
        } else { const float* xr = (const float*)(m < NPROMPT ? x0 : x1) + ro;
#pragma unroll
            for (int j = 0; j < 4; ++j) v[j] = *(const float4*)(xr + j * 256 + lane * 4); }
#pragma unroll
        for (int j = 0; j < 4; ++j) ss += v[j].x * v[j].x + v[j].y * v[j].y + v[j].z * v[j].z + v[j].w * v[j].w;
#pragma unroll
        for (int o = 1; o < 32; o <<= 1) ss += shx(ss, o, lane);
        ss = xsum32(ss);
        const float rs = rsqrtf(ss * (1.f / D) + EPS);
#pragma unroll
        for (int j = 0; j < 4; ++j) {
            const int c0 = j * 256 + lane * 4;
            const float4 gg = *(const float4*)(g + c0), sh = *(const float4*)(mod + c0), sc = *(const float4*)(mod + 1024 + c0);
            ushort4 o;
            o.x = f2bf(v[j].x * rs * gg.x * (1.f + sc.x) + sh.x); o.y = f2bf(v[j].y * rs * gg.y * (1.f + sc.y) + sh.y);
            o.z = f2bf(v[j].z * rs * gg.z * (1.f + sc.z) + sh.z); o.w = f2bf(v[j].w * rs * gg.w * (1.f + sc.w) + sh.w);
            *(ushort4*)(c_XN + (size_t)m * D + c0) = o;
        }
    }
}

typedef float f32x16 __attribute__((ext_vector_type(16)));
typedef short s16x4 __attribute__((ext_vector_type(4)));
typedef unsigned u32x4_t __attribute__((ext_vector_type(4)));
constexpr int AT_KROW = 72;
constexpr int AT_VROW = 68;
constexpr int AT_KBYTES = 2 * 64 * AT_KROW * 2, AT_VBYTES = 128 * AT_VROW * 2, AT_BUF = AT_KBYTES + AT_VBYTES;
__device__ __forceinline__ unsigned pk_bf16(float lo, float hi) { return pk2(lo, hi); }
template <int XM = 0>
__device__ __forceinline__ void ph_attn(const Ctx& C0, int l, int item_lo = 0, int item_hi = 512, int nwg = 0) {
    PHASE_CTX(C0);
    const int tid = C.tid, lane = C.lane, w = C.wave, map = w >> 2, qb = w & 3, r32 = lane & 31, hi = lane >> 5;
    unsigned char* lds = C.lds;
    const float* subg = c_subln_g + l * 128;
    const float lam = c_MISC[l];
    const bf16_t* AKp = c_AK; const bf16_t* AVp = c_AV;
    const int sk_key = tid >> 3, sk_ch = tid & 7;
    const int sv_kp = tid & 31, sv_ec = tid >> 5;
    constexpr int AT_NBUF = 3;
    constexpr float CS = 0.125f * 1.4426950408889634f;
    const int NW = nwg > 0 ? nwg : C.G;
    if (C.bid >= NW) return;
    const int vbid = (NW % 8 == 0) ? (C.bid & 7) * (NW / 8) + (C.bid >> 3) : C.bid;
    for (int item = item_lo + vbid; item < item_hi; item += NW) {
        int m0, kr0, Lk, h;
        if (item < 256) { const int b = item >> 3; h = (item >> 1) & 3; const int q2 = item & 1; m0 = b * 256 + q2 * 128; kr0 = b * 256; Lk = 256; }
        else { const int j = item - 256; const int b = j >> 6; h = (j >> 4) & 3; const int q2 = j & 15; m0 = NPROMPT + b * 2048 + q2 * 128; kr0 = NPROMPT + b * 2304; Lk = 2304; }
        const int NTL = Lk >> 6;
        bf16x8* sQ = (bf16x8*)(lds + AT_NBUF * AT_BUF) + (w * 4) * 64 + lane;
        f32x16 o[4];
#pragma unroll
        for (int eb = 0; eb < 4; ++eb)
#pragma unroll
            for (int r = 0; r < 16; ++r) o[eb][r] = 0.f;
        float mrun = -1e30f, lsum = 0.f, alpha = 1.f, mc = 0.f;
        uint4 kreg0, kreg1, vreg0, vreg1;
        unsigned pfw[16];
#define PF(ks_) __builtin_bit_cast(bf16x8, (u32x4_t){pfw[4 * (ks_)], pfw[4 * (ks_) + 1], pfw[4 * (ks_) + 2], pfw[4 * (ks_) + 3]})
        f32x16 pa0, pa1;
#define AT_LOAD(t_) do { const bf16_t* kp_ = AKp + (size_t)(kr0 + (t_) * 64 + sk_key) * 512 + h * 128 + sk_ch * 16; kreg0 = *(const uint4*)kp_; kreg1 = *(const uint4*)(kp_ + 8); \
            const bf16_t* vp_ = AVp + (size_t)(kr0 + (t_) * 64 + 2 * sv_kp) * 512 + h * 128 + sv_ec * 8; vreg0 = *(const uint4*)vp_; vreg1 = *(const uint4*)(vp_ + 512); } while (0)
#define AT_WRITE(t_) do { unsigned char* wb_ = lds + ((t_) % AT_NBUF) * AT_BUF; \
            bf16_t* kd_ = (bf16_t*)wb_ + ((sk_ch >> 2) * 64 + sk_key) * AT_KROW + (sk_ch & 3) * 16; *(uint4*)kd_ = kreg0; *(uint4*)(kd_ + 8) = kreg1; \
            bf16_t* vt_ = (bf16_t*)(wb_ + AT_KBYTES) + (sv_ec * 8) * AT_VROW + 2 * sv_kp; \
            const unsigned a_[4] = {vreg0.x, vreg0.y, vreg0.z, vreg0.w}, b_[4] = {vreg1.x, vreg1.y, vreg1.z, vreg1.w}; \
            _Pragma("unroll") for (int i = 0; i < 4; ++i) { *(unsigned*)(vt_ + (2 * i) * AT_VROW) = (a_[i] & 0xffffu) | (b_[i] << 16); *(unsigned*)(vt_ + (2 * i + 1) * AT_VROW) = (a_[i] >> 16) | (b_[i] & 0xffff0000u); } } while (0)
#define SB() __builtin_amdgcn_sched_barrier(0)
#define AT_M(P0, P1) do { asm volatile("s_nop 15\n\ts_nop 7" : "+v"(P0), "+v"(P1)); float mt_ = -1e30f; \
            _Pragma("unroll") for (int r = 0; r < 16; ++r) asm("v_max3_f32 %0, %1, %2, %3" : "=v"(mt_) : "v"(mt_), "v"(P0[r]), "v"(P1[r])); \
            { const auto rr_ = __builtin_amdgcn_permlane32_swap(__float_as_uint(mt_), __float_as_uint(mt_), false, false); asm("v_max_f32_e32 %0, %1, %2" : "=v"(mt_) : "v"(__uint_as_float(rr_[0])), "v"(__uint_as_float(rr_[1]))); } \
            float mn_; asm("v_max_f32_e32 %0, %1, %2" : "=v"(mn_) : "v"(mrun), "v"(mt_)); \
            alpha = __builtin_amdgcn_exp2f((mrun - mn_) * CS); mrun = mn_; mc = -mn_ * CS; } while (0)
#define AT_EXP2(P, i_) do { if (XM == 2) { P[i_] = __builtin_fmaf(P[i_], CS, mc); P[(i_) + 1] = __builtin_fmaf(P[(i_) + 1], CS, mc); } else { P[i_] = __builtin_amdgcn_exp2f(__builtin_fmaf(P[i_], CS, mc)); P[(i_) + 1] = __builtin_amdgcn_exp2f(__builtin_fmaf(P[(i_) + 1], CS, mc)); } \
            asm volatile("" : "+v"(P[i_]), "+v"(P[(i_) + 1])); } while (0)
#define AT_X(HASV, tv_, P0, P1) do { const bf16_t* sVt_ = (const bf16_t*)(lds + ((tv_) % AT_NBUF) * AT_BUF + AT_KBYTES) + r32 * AT_VROW + 4 * hi; \
            _Pragma("unroll") for (int eb = 0; eb < 4; ++eb) { s16x4 vl_[4], vh_[4]; \
                if (HASV) { _Pragma("unroll") for (int ks = 0; ks < 4; ++ks) { vl_[ks] = *(const s16x4*)(sVt_ + eb * 32 * AT_VROW + ks * 16); vh_[ks] = *(const s16x4*)(sVt_ + eb * 32 * AT_VROW + ks * 16 + 8); } SB(); } \
                _Pragma("unroll") for (int ks = 0; ks < 4; ++ks) { \
                    if (HASV) { const bf16x8 vf_ = __builtin_shufflevector(vl_[ks], vh_[ks], 0, 1, 2, 3, 4, 5, 6, 7); o[eb] = __builtin_amdgcn_mfma_f32_32x32x16_bf16(vf_, PF(ks), o[eb], 0, 0, 0); } \
                    if (eb < 2) AT_EXP2(P0, eb * 8 + ks * 2); else AT_EXP2(P1, (eb - 2) * 8 + ks * 2); SB(); } } } while (0)
#define AT_Q(t_, P0, P1) do { const bf16_t* sKm_ = (const bf16_t*)(lds + ((t_) % AT_NBUF) * AT_BUF) + (map * 64) * AT_KROW + r32 * AT_KROW + hi * 8; \
            bf16x8 kf0_[4], kf1_[4], qf_[4]; \
            _Pragma("unroll") for (int s4 = 0; s4 < 4; ++s4) { qf_[s4] = sQ[s4 * 64]; kf0_[s4] = *(const bf16x8*)(sKm_ + s4 * 16); kf1_[s4] = *(const bf16x8*)(sKm_ + 32 * AT_KROW + s4 * 16); } \
            _Pragma("unroll") for (int r = 0; r < 16; ++r) { P0[r] = 0.f; P1[r] = 0.f; } SB(); \
            _Pragma("unroll") for (int s4 = 0; s4 < 4; ++s4) { P0 = __builtin_amdgcn_mfma_f32_32x32x16_bf16(kf0_[s4], qf_[s4], P0, 0, 0, 0); P1 = __builtin_amdgcn_mfma_f32_32x32x16_bf16(kf1_[s4], qf_[s4], P1, 0, 0, 0); } } while (0)
#define AT_S(P0, P1) do { float ps_ = 0.f; \
            _Pragma("unroll") for (int c = 0; c < 4; ++c) { ps_ += (P0[4 * c] + P0[4 * c + 1]) + (P0[4 * c + 2] + P0[4 * c + 3]) + (P1[4 * c] + P1[4 * c + 1]) + (P1[4 * c + 2] + P1[4 * c + 3]); \
                pfw[4 * (c >> 1) + (c & 1) * 2] = pk2_valu(P0[4 * c], P0[4 * c + 1]); pfw[4 * (c >> 1) + (c & 1) * 2 + 1] = pk2_valu(P0[4 * c + 2], P0[4 * c + 3]); \
                pfw[8 + 4 * (c >> 1) + (c & 1) * 2] = pk2_valu(P1[4 * c], P1[4 * c + 1]); pfw[8 + 4 * (c >> 1) + (c & 1) * 2 + 1] = pk2_valu(P1[4 * c + 2], P1[4 * c + 3]); } \
            lsum += ps_; } while (0)
#define AT_RESCALE() do { if (__any(alpha != 1.f)) { lsum *= alpha; _Pragma("unroll") for (int eb = 0; eb < 4; ++eb) _Pragma("unroll") for (int r = 0; r < 16; ++r) o[eb][r] *= alpha; } } while (0)
#define AT_STEP(t_) do { \
            if (XM != 5) { AT_Q(t_, pa0, pa1); } AT_M(pa0, pa1); \
            if ((t_) > 0 && XM != 3) { AT_X(true, (t_) - 1, pa0, pa1); } else { AT_X(false, 0, pa0, pa1); } \
            AT_RESCALE(); AT_S(pa0, pa1); \
            if (XM != 6) __syncthreads();                        \
            if ((t_) + 2 < NTL && XM != 4) { AT_WRITE((t_) + 2); if ((t_) + 3 < NTL) AT_LOAD((t_) + 3); } } while (0)
        { const bf16_t* qp = c_AQ + (size_t)(m0 + qb * 32 + r32) * 512 + h * 128 + map * 64 + hi * 8;
#pragma unroll
          for (int s4 = 0; s4 < 4; ++s4) sQ[s4 * 64] = *(const bf16x8*)(qp + s4 * 16); }
        AT_LOAD(0);
        __syncthreads();
        AT_WRITE(0); AT_LOAD(1); AT_WRITE(1); AT_LOAD(2);
        __syncthreads();
        AT_STEP(0); alpha = 1.f;
#pragma unroll 1
        for (int t = 1; t < NTL; ++t) { AT_STEP(t); }
        { const bf16_t* sVt_ = (const bf16_t*)(lds + ((NTL - 1) % AT_NBUF) * AT_BUF + AT_KBYTES) + r32 * AT_VROW + 4 * hi;
#pragma unroll
          for (int eb = 0; eb < 4; ++eb)
#pragma unroll
              for (int ks = 0; ks < 4; ++ks) { const s16x4 lo = *(const s16x4*)(sVt_ + eb * 32 * AT_VROW + ks * 16), hv = *(const s16x4*)(sVt_ + eb * 32 * AT_VROW + ks * 16 + 8);
                  o[eb] = __builtin_amdgcn_mfma_f32_32x32x16_bf16(__builtin_shufflevector(lo, hv, 0, 1, 2, 3, 4, 5, 6, 7), PF(ks), o[eb], 0, 0, 0); } }
#undef PF
#undef AT_Q
#undef AT_S
#undef AT_LOAD
#undef AT_WRITE
#undef SB
#undef AT_M
#undef AT_EXP2
#undef AT_X
#undef AT_RESCALE
#undef AT_STEP
        lsum = xsum32(lsum);
        const float inv = 1.f / lsum;
        __syncthreads();
        float* xb = (float*)lds + (size_t)qb * (32 * 129);
        if (map == 1) {
#pragma unroll
            for (int eb = 0; eb < 4; ++eb)
#pragma unroll
                for (int r = 0; r < 16; ++r) xb[r32 * 129 + eb * 32 + (r & 3) + 8 * (r >> 2) + 4 * hi] = o[eb][r] * inv;
        }
        __syncthreads();
        if (map == 0 && (XM == 0 || lsum == 12345.678f)) {
            float ss = 0.f;
#pragma unroll
            for (int eb = 0; eb < 4; ++eb)
#pragma unroll
                for (int r = 0; r < 16; ++r) { const float d = o[eb][r] * inv - lam * xb[r32 * 129 + eb * 32 + (r & 3) + 8 * (r >> 2) + 4 * hi]; o[eb][r] = d; ss += d * d; }
            ss = xsum32(ss);
            const float lam_init = 0.8f - 0.6f * __expf(-0.3f * (float)l);
            const float rs = rsqrtf(ss * (1.f / 128.f) + EPS) * (1.f - lam_init);
            bf16_t* op = c_OA + (size_t)(m0 + qb * 32 + r32) * 512 + h * 128;
#pragma unroll
            for (int eb = 0; eb < 4; ++eb)
#pragma unroll
                for (int r4 = 0; r4 < 4; ++r4) {
                    const int e0 = eb * 32 + 8 * r4 + 4 * hi;
                    uint2 wv;
                    wv.x = pk_bf16(o[eb][4 * r4] * rs * subg[e0], o[eb][4 * r4 + 1] * rs * subg[e0 + 1]);
                    wv.y = pk_bf16(o[eb][4 * r4 + 2] * rs * subg[e0 + 2], o[eb][4 * r4 + 3] * rs * subg[e0 + 3]);
                    *(uint2*)(op + e0) = wv;
                }
        }
    }
}

constexpr int GT = 64;
constexpr size_t G_QK = 0;
constexpr size_t G_KDT = 48 * MiB;
constexpr size_t G_VT = 64 * MiB;
constexpr size_t G_SST = 80 * MiB;
constexpr size_t G_DEC = 112 * MiB;
constexpr size_t G_CQB = 112 * MiB + 524288;
__device__ __forceinline__ void ph_gla_prep(const Ctx& C0, int l) {
    PHASE_CTX(C0);
    const int tid = C.tid, dir = tid >> 8, h = (tid >> 6) & 3, kc = tid & 63, c = h * 64 + kc;
    float* sBR = (float*)C.lds;
    float* sPre = (float*)(C.lds + 8192);
    unsigned char* gb = WS_ + W_GLA;
    float wa[16];
#pragma unroll
    for (int r = 0; r < 16; ++r) wa[r] = c_gla_wa2[(((size_t)l * 2 + dir) * 16 + r) * 256 + c];
    const float bias = c_gla_ba[((size_t)l * 2 + dir) * 256 + c];
    bf16_t* QA = (bf16_t*)(gb + G_QK + (size_t)(dir * 3 + 0) * 8 * MiB); bf16_t* KA = (bf16_t*)(gb + G_QK + (size_t)(dir * 3 + 1) * 8 * MiB);
    for (int gc = C.bid; gc < 256; gc += C.G) {
        const int m0 = gc * GT;
        __syncthreads();
        { const float4* src = (const float4*)(c_BR + (size_t)m0 * 32); ((float4*)sBR)[tid] = src[tid]; }
        __syncthreads();
        float run = 0.f;
#pragma unroll 4
        for (int t = 0; t < 64; ++t) {
            float x = bias;
#pragma unroll
            for (int r = 0; r < 16; ++r) x += sBR[t * 32 + dir * 16 + r] * wa[r];
            const float ls = fminf(x, 0.f) - __logf(1.f + __expf(-fabsf(x)));
            run += ls * (1.f / 16.f); sPre[t * 512 + tid] = run;
        }
        const float p31 = sPre[31 * 512 + tid], p63 = run;
        const float cqb = __expf(dir == 0 ? p31 : p63 - p31), ckd = __expf(dir == 0 ? p63 - p31 : p31);
        bf16_t* KDT = (bf16_t*)(gb + G_KDT) + ((((size_t)gc * 4 + h) * 2 + dir) * 64 + kc) * 64;
        const bf16_t* BQp = c_BQ; const bf16_t* BKp = c_BK;
        bf16_t qn[8], kn[8];
#pragma unroll
        for (int tt = 0; tt < 8; ++tt) { const size_t idx = (size_t)(m0 + tt) * 256 + c; qn[tt] = BQp[idx]; kn[tt] = BKp[idx]; }
#pragma unroll 1
        for (int t8 = 0; t8 < 8; ++t8) {
            unsigned kdw[4];
            bf16_t qc[8], kc8[8];
#pragma unroll
            for (int tt = 0; tt < 8; ++tt) { qc[tt] = qn[tt]; kc8[tt] = kn[tt]; }
            { const int tn = t8 < 7 ? (t8 + 1) * 8 : 56;
#pragma unroll
              for (int tt = 0; tt < 8; ++tt) { const size_t idx = (size_t)(m0 + tn + tt) * 256 + c; qn[tt] = BQp[idx]; kn[tt] = BKp[idx]; } }
#pragma unroll
            for (int tt = 0; tt < 8; ++tt) {
                const int t = t8 * 8 + tt;
                const int te = dir == 0 ? t : t - 1;
                const float e = te < 0 ? 0.f : sPre[(te < 0 ? 0 : te) * 512 + tid];
                const float d = e - p31;
                const size_t idx = (size_t)(m0 + t) * 256 + c;
                const float qv = bf2f(qc[tt]), kv = bf2f(kc8[tt]);
                const float ed = __expf(dir == 0 ? d : -d), eid = __expf(dir == 0 ? -d : d);
                QA[idx] = f2bf(qv * ed); KA[idx] = f2bf(kv * eid);
                const float kd = kv * eid * ckd;
                if (tt & 1) kdw[tt >> 1] |= (unsigned)f2bf(kd) << 16; else kdw[tt >> 1] = (unsigned)f2bf(kd);
            }
            *(uint4*)(KDT + t8 * 8) = make_uint4(kdw[0], kdw[1], kdw[2], kdw[3]);
        }
        ((float*)(gb + G_DEC))[(((size_t)gc * 4 + h) * 2 + dir) * 64 + kc] = __expf(p63);
        ((float*)(gb + G_CQB))[(((size_t)gc * 4 + h) * 2 + dir) * 64 + kc] = cqb;
        { const int hv = tid >> 7, vv = tid & 127; const bf16_t* BVp = c_BV;
          bf16_t* VT = (bf16_t*)(gb + G_VT) + (((size_t)gc * 4 + hv) * 128 + vv) * 64;
#pragma unroll 4
          for (int t8 = 0; t8 < 8; ++t8) { unsigned w4[4];
#pragma unroll
              for (int tt = 0; tt < 8; ++tt) { const unsigned x = BVp[(size_t)(m0 + t8 * 8 + tt) * 512 + hv * 128 + vv]; if (tt & 1) w4[tt >> 1] |= x << 16; else w4[tt >> 1] = x; }
              *(uint4*)(VT + t8 * 8) = make_uint4(w4[0], w4[1], w4[2], w4[3]); } }
        __syncthreads();
        { const int lane = C.lane, wv = C.wave, hh = wv >> 1, dd_ = wv & 1, r32 = lane & 31, hi = lane >> 5;
          const size_t cu = ((size_t)gc * 4 + hh) * 2 + dd_;
          const bf16_t* vtb = (const bf16_t*)(gb + G_VT) + ((size_t)gc * 4 + hh) * 128 * 64;
          const bf16_t* kdb = (const bf16_t*)(gb + G_KDT) + cu * 64 * 64;
          bf16_t* DS = WSP(bf16_t, W_GDS) + cu * 128 * 64;
#pragma unroll 2
          for (int t = 0; t < 8; ++t) { const int vb = t & 3, kb = t >> 2;
              f32x16 acc;
#pragma unroll
              for (int r = 0; r < 16; ++r) acc[r] = 0.f;
              bf16x8 a4[4], b4[4];
#pragma unroll
              for (int s4 = 0; s4 < 4; ++s4) { a4[s4] = *(const bf16x8*)(vtb + (size_t)(vb * 32 + r32) * 64 + s4 * 16 + hi * 8); b4[s4] = *(const bf16x8*)(kdb + (size_t)(kb * 32 + r32) * 64 + s4 * 16 + hi * 8); }
#pragma unroll
              for (int s4 = 0; s4 < 4; ++s4) acc = __builtin_amdgcn_mfma_f32_32x32x16_bf16(a4[s4], b4[s4], acc, 0, 0, 0);
#pragma unroll
              for (int r = 0; r < 16; ++r) DS[(size_t)(vb * 32 + (r & 3) + 8 * (r >> 2) + 4 * hi) * 64 + kb * 32 + r32] = f2bf(acc[r]); } }
    }
}
__device__ __forceinline__ int crow16(int r, int hi) { return (r & 3) + 8 * (r >> 2) + 4 * hi; }
__device__ __forceinline__ void ph_gla_scan(const Ctx& C0, int l) {
    PHASE_CTX(C0);
    const int tid = C.tid;
    unsigned char* gb = WS_ + W_GLA;
    const bf16_t* DSb = WSP(bf16_t, W_GDS);
    for (int task = C.bid; task < 576; task += C.G) {
        const int it = task < 64 ? 287 - (task >> 1) : (task - 64) >> 1, part = task & 1;
        const int dir = it & 1, h = (it >> 1) & 3, s = it >> 3;
        const bool latent = s >= 32;
        const int nch = latent ? 32 : 4, gc0 = latent ? 128 + (s - 32) * 32 : s * 4;
        const int v = part * 64 + (tid >> 3), kc0 = (tid & 7) * 8;
        float S[8];
        if (latent) { const float* si = c_state_gla + ((((size_t)(s - 32) * 2 + l) * 2 + dir) * 4 + h) * 8192 + v;
#pragma unroll
            for (int e = 0; e < 8; ++e) S[e] = si[(size_t)(kc0 + e) * 128]; }
        else {
#pragma unroll
            for (int e = 0; e < 8; ++e) S[e] = 0.f; }
#pragma unroll 1
        for (int n0 = 0; n0 < nch; n0 += 4) {
            uint4 dsw[4]; f32x4 d0[4], d1[4], q0[4], q1[4];
#pragma unroll
            for (int b = 0; b < 4; ++b) {
                const int gc = gc0 + (dir == 0 ? n0 + b : nch - 1 - n0 - b);
                const size_t cu = ((size_t)gc * 4 + h) * 2 + dir;
                dsw[b] = *(const uint4*)(DSb + (cu * 128 + v) * 64 + kc0);
                d0[b] = *(const f32x4*)((const float*)(gb + G_DEC) + cu * 64 + kc0); d1[b] = *(const f32x4*)((const float*)(gb + G_DEC) + cu * 64 + kc0 + 4);
                q0[b] = *(const f32x4*)((const float*)(gb + G_CQB) + cu * 64 + kc0); q1[b] = *(const f32x4*)((const float*)(gb + G_CQB) + cu * 64 + kc0 + 4);
            }
#pragma unroll
            for (int b = 0; b < 4; ++b) {
                const int gc = gc0 + (dir == 0 ? n0 + b : nch - 1 - n0 - b);
                const size_t cu = ((size_t)gc * 4 + h) * 2 + dir;
                uint4 st; st.x = pk2(S[0] * q0[b][0], S[1] * q0[b][1]); st.y = pk2(S[2] * q0[b][2], S[3] * q0[b][3]); st.z = pk2(S[4] * q1[b][0], S[5] * q1[b][1]); st.w = pk2(S[6] * q1[b][2], S[7] * q1[b][3]);
                *(uint4*)((bf16_t*)(gb + G_SST) + (cu * 128 + v) * 64 + kc0) = st;
                const unsigned dw[4] = {dsw[b].x, dsw[b].y, dsw[b].z, dsw[b].w}; const float dc[8] = {d0[b][0], d0[b][1], d0[b][2], d0[b][3], d1[b][0], d1[b][1], d1[b][2], d1[b][3]};
#pragma unroll
                for (int q = 0; q < 4; ++q) { S[2 * q] = dc[2 * q] * S[2 * q] + __uint_as_float(dw[q] << 16); S[2 * q + 1] = dc[2 * q + 1] * S[2 * q + 1] + __uint_as_float(dw[q] & 0xffff0000u); }
            }
        }
        if (!latent) { float* so = c_out + O_NG + ((((size_t)s * 2 + l) * 2 + dir) * 4 + h) * 8192 + v;
#pragma unroll
            for (int e = 0; e < 8; ++e) so[(size_t)(kc0 + e) * 128] = S[e]; }
    }
}
__device__ __forceinline__ void ph_gla_out(const Ctx& C0, int l) {
    PHASE_CTX(C0);
    const int lane = C.lane, r32 = lane & 31, hi = lane >> 5;
    unsigned char* gb = WS_ + W_GLA;
    float* sO = (float*)C.lds + C.wave * (32 * 132);
    const float* ong = c_gla_on_g + l * 128;
    const bool bal = C.G == 256;
    const int nw = bal ? 1024 : C.G * NWAVE, wv = bal ? (C.bid - 128) * NWAVE + C.wave : C.bid * NWAVE + C.wave;
    if (bal && C.bid < 128) return;
    for (int task = wv; task < 2048; task += nw) {
        const int gc = task >> 3, h = (task >> 1) & 3, jb = task & 1, m0 = gc * GT;
        f32x16 o[4];
#pragma unroll
        for (int vq = 0; vq < 4; ++vq)
#pragma unroll
            for (int r = 0; r < 16; ++r) o[vq][r] = 0.f;
#pragma unroll
        for (int dir = 0; dir < 2; ++dir) {
            const bf16_t* QA = (const bf16_t*)(gb + G_QK + (size_t)(dir * 3 + 0) * 8 * MiB); const bf16_t* KA = (const bf16_t*)(gb + G_QK + (size_t)(dir * 3 + 1) * 8 * MiB);
            const size_t cu = ((size_t)gc * 4 + h) * 2 + dir;
            bf16x8 qf[4], kf[2][4];
            { const bf16_t* qp = QA + (size_t)(m0 + jb * 32 + r32) * 256 + h * 64 + hi * 8;
              const bf16_t* kp0 = KA + (size_t)(m0 + r32) * 256 + h * 64 + hi * 8; const bf16_t* kp1 = kp0 + (size_t)32 * 256;
#pragma unroll
              for (int s4 = 0; s4 < 4; ++s4) { qf[s4] = *(const bf16x8*)(qp + s4 * 16); kf[0][s4] = *(const bf16x8*)(kp0 + s4 * 16); kf[1][s4] = *(const bf16x8*)(kp1 + s4 * 16); } }
            const bf16_t* vtb = (const bf16_t*)(gb + G_VT) + (((size_t)gc * 4 + h) * 128 + r32) * 64 + 4 * hi;
            const bf16_t* stb = (const bf16_t*)(gb + G_SST) + (cu * 128 + r32) * 64 + hi * 8;
            s16x4 vlo[2][4], vhi[2][4]; bf16x8 sf[2][4];
#define GO_LOADV(b_, vq_) do { _Pragma("unroll") for (int s4 = 0; s4 < 4; ++s4) { vlo[b_][s4] = *(const s16x4*)(vtb + (size_t)(vq_) * 32 * 64 + s4 * 16); vhi[b_][s4] = *(const s16x4*)(vtb + (size_t)(vq_) * 32 * 64 + s4 * 16 + 8); sf[b_][s4] = *(const bf16x8*)(stb + (size_t)(vq_) * 32 * 64 + s4 * 16); } } while (0)
            GO_LOADV(0, 0);
            bf16x8 pf[4];
#pragma unroll
            for (int ib = 0; ib < 2; ++ib) {
                f32x16 p;
#pragma unroll
                for (int r = 0; r < 16; ++r) p[r] = 0.f;
#pragma unroll
                for (int s4 = 0; s4 < 4; ++s4) p = __builtin_amdgcn_mfma_f32_32x32x16_bf16(kf[ib][s4], qf[s4], p, 0, 0, 0);
                const int j = jb * 32 + r32;
#pragma unroll
                for (int r = 0; r < 16; ++r) { const int i = ib * 32 + crow16(r, hi); const bool keep = dir == 0 ? (i <= j) : (i >= j); if (!keep) p[r] = 0.f; }
#pragma unroll
                for (int s2 = 0; s2 < 2; ++s2) { union { bf16x8 v; unsigned u[4]; } a;
#pragma unroll
                    for (int q = 0; q < 4; ++q) a.u[q] = pk2(p[8 * s2 + 2 * q], p[8 * s2 + 2 * q + 1]);
                    pf[2 * ib + s2] = a.v; }
            }
#pragma unroll
            for (int vq = 0; vq < 4; ++vq) {
                if (vq < 3) GO_LOADV((vq + 1) & 1, vq + 1);
#pragma unroll
                for (int ks = 0; ks < 4; ++ks) { const bf16x8 vf = __builtin_shufflevector(vlo[vq & 1][ks], vhi[vq & 1][ks], 0, 1, 2, 3, 4, 5, 6, 7);
                    o[vq] = __builtin_amdgcn_mfma_f32_32x32x16_bf16(vf, pf[ks], o[vq], 0, 0, 0); }
#pragma unroll
                for (int s4 = 0; s4 < 4; ++s4) o[vq] = __builtin_amdgcn_mfma_f32_32x32x16_bf16(sf[vq & 1][s4], qf[s4], o[vq], 0, 0, 0);
            }
#undef GO_LOADV
        }
        float ss = 0.f;
#pragma unroll
        for (int vq = 0; vq < 4; ++vq)
#pragma unroll
            for (int r = 0; r < 16; ++r) ss += o[vq][r] * o[vq][r];
        ss = xsum32(ss);
        const float rs = rsqrtf(ss * (1.f / 128.f) + EPS);
#pragma unroll
        for (int vq = 0; vq < 4; ++vq)
#pragma unroll
            for (int q4 = 0; q4 < 4; ++q4) *(float4*)(sO + r32 * 132 + vq * 32 + 8 * q4 + 4 * hi) = make_float4(o[vq][4 * q4] * rs, o[vq][4 * q4 + 1] * rs, o[vq][4 * q4 + 2] * rs, o[vq][4 * q4 + 3] * rs);
        { const int j = lane >> 1, vc = (lane & 1) * 64; const float* row = sO + j * 132 + vc;
          const size_t off = (size_t)(m0 + jb * 32 + j) * 512 + h * 128 + vc;
          const bf16_t* BGp = c_BG + off; bf16_t* OBp = c_OB + off;
#pragma unroll
          for (int c8 = 0; c8 < 8; ++c8) {
              const float4 f0 = *(const float4*)(row + c8 * 8), f1 = *(const float4*)(row + c8 * 8 + 4);
              const uint4 gr = *(const uint4*)(BGp + c8 * 8); const float* og = ong + vc + c8 * 8;
              uint4 ow;
              ow.x = pk2(f0.x * og[0] * __uint_as_float(gr.x << 16), f0.y * og[1] * __uint_as_float(gr.x & 0xffff0000u));
              ow.y = pk2(f0.z * og[2] * __uint_as_float(gr.y << 16), f0.w * og[3] * __uint_as_float(gr.y & 0xffff0000u));
              ow.z = pk2(f1.x * og[4] * __uint_as_float(gr.z << 16), f1.y * og[5] * __uint_as_float(gr.z & 0xffff0000u));
              ow.w = pk2(f1.z * og[6] * __uint_as_float(gr.w << 16), f1.w * og[7] * __uint_as_float(gr.w & 0xffff0000u));
              *(uint4*)(OBp + c8 * 8) = ow; } }
    }
}

namespace pg8 {
#define PG8_LAS __attribute__((address_space(3)))
typedef unsigned short bf16_t;
typedef short bf16x8 __attribute__((ext_vector_type(8)));
typedef float f32x4 __attribute__((ext_vector_type(4)));
typedef unsigned u32x4 __attribute__((ext_vector_type(4)));
constexpr int BM = 256, BK = 64, HALF = 128, HTB = HALF * BK * 2  , STAGE_BYTES = 8 * HTB, NXCD = 8, WGM = 8;

__host__ __device__ __forceinline__ int lds_byte(int r, int c) { const int st = (r >> 4) * 2 + (c >> 5), rr = r & 15, cc = c & 31, ob = rr * 64 + cc * 2; return st * 1024 + (ob ^ (((ob >> 9) & 1) << 5)); }
__host__ __device__ __forceinline__ void stage_rc(int b, int& R, int& C) { const int st = b / 1024, sb = b % 1024, swz = sb ^ (((sb >> 9) & 1) << 5); R = (st >> 1) * 16 + swz / 64; C = (st & 1) * 32 + (swz % 64) / 2; }
__host__ __device__ __forceinline__ int perm32(int rho) { const int n = rho >> 4, i = rho & 15; return 8 * (i >> 2) + 4 * n + (i & 3); }

struct Unit { int pm, pn, z, h; };
struct Gemm { const bf16_t* A; const bf16_t* Bt; int M, N, K; size_t za, zb; int lda, ldb; };

struct StaticOrder {
    int nM, nN, nwg, G, c;
    __host__ __device__ void init(int M, int N, int G_, int c_) { nM = M / BM; nN = N / BM; nwg = nM * nN; G = G_; c = c_; }
    static constexpr bool HALF = false;
    __host__ __device__ void map(int L, Unit& u) const {
        int wgid = L; { const int q = nwg / NXCD, r = nwg % NXCD, xcd = wgid % NXCD, off = wgid / NXCD; wgid = (xcd < r ? xcd * (q + 1) : r * (q + 1) + (xcd - r) * q) + off; }
        const int nig = WGM * nN, gid = wgid / nig, fm = gid * WGM, gsz = (nM - fm) < WGM ? (nM - fm) : WGM;
        u.pm = fm + ((wgid % nig) % gsz); u.pn = (wgid % nig) / gsz; u.z = 0; u.h = 0;
    }
    __host__ __device__ bool next(int i, Unit& u) const {
        const long L = (long)i * G + c; if (L >= nwg) return false;
        map((int)L, u); return true;
    }
    __device__ __forceinline__ void a_ready(const Unit&) const {}
    __device__ __forceinline__ void done(const Unit&) const {}
};
__device__ __forceinline__ unsigned cvt_pk_bf16(float lo, float hi) { unsigned r; asm volatile("v_cvt_pk_bf16_f32 %0, %1, %2" : "=v"(r) : "v"(lo), "v"(hi)); return r; }
typedef float f32x2 __attribute__((ext_vector_type(2)));
template <class Epi, class Sched, bool ALIGN_EPI = false, bool SP2 = false>
__device__ __forceinline__ void gemm_phase(PG8_LAS unsigned char* lds, const Gemm g, const Sched& S, const Epi& E) {
    int tid_ = threadIdx.x; asm volatile("" : "+v"(tid_));
    const int tid = tid_, wid = __builtin_amdgcn_readfirstlane(tid >> 6), lane = tid & 63, wr = wid >> 2, wc = wid & 3, fr = lane & 15, fq = lane >> 4;
    const int K = g.K, nt = K / BK;
    unsigned voffA[2], voffB[2];
#pragma unroll
    for (int i = 0; i < 2; ++i) { int R, C; stage_rc(tid * 16 + i * 8192, R, C); const int Rb = Epi::PERM ? ((R & ~31) + perm32(R & 31)) : R;
        voffA[i] = (unsigned)(R * g.lda + C) * 2u; voffB[i] = (unsigned)(Rb * g.ldb + C) * 2u; }
    const size_t kstep = (size_t)(BK * 2);
    const size_t hstepA = (size_t)HALF * g.lda * 2, hstepB = (size_t)HALF * g.ldb * 2;
    const size_t tstepA = 2 * hstepA, tstepB = 2 * hstepB;
    const unsigned ldsw = (unsigned)wid * 1024u;
    const int aoff = lds_byte(wr * 64 + fr, fq * 8), boff = lds_byte(wc * 32 + fr, fq * 8);
#define PG8_SA(b, h) (((b) * 2 + (h)) * HTB)
#define PG8_SB(b, h) ((4 + (b) * 2 + (h)) * HTB)
#define PG8_STAGE(bufoff, gbase, voff) do { _Pragma("unroll") for (int _i = 0; _i < 2; ++_i) \
        __builtin_amdgcn_global_load_lds((const unsigned*)((const char*)(gbase) + (voff)[_i]), (PG8_LAS unsigned*)(lds + (bufoff) + ldsw + _i * 8192), 16, 0, 0); } while (0)
#define PG8_LDA(dst, b, h) do { _Pragma("unroll") for (int m = 0; m < 4; ++m) _Pragma("unroll") for (int k = 0; k < 2; ++k) dst[m][k] = *(const PG8_LAS bf16x8*)(lds + PG8_SA(b, h) + aoff + m * 2048 + k * 1024); } while (0)
#define PG8_LDB(dst, b, h) do { _Pragma("unroll") for (int n = 0; n < 2; ++n) _Pragma("unroll") for (int k = 0; k < 2; ++k) dst[n][k] = *(const PG8_LAS bf16x8*)(lds + PG8_SB(b, h) + boff + n * 2048 + k * 1024); } while (0)
#define PG8_MMA(ai, bj, At, Bt) do { __builtin_amdgcn_s_setprio(1); _Pragma("unroll") for (int m = 0; m < 4; ++m) _Pragma("unroll") for (int n = 0; n < 2; ++n) _Pragma("unroll") for (int k = 0; k < 2; ++k) \
        acc[ai][bj][m][n] = __builtin_amdgcn_mfma_f32_16x16x32_bf16(Bt[n][k], At[m][k], acc[ai][bj][m][n], 0, 0, 0); __builtin_amdgcn_s_setprio(0); } while (0)
#define PG8_WAIT_V(n) asm volatile("s_waitcnt vmcnt(" #n ")" ::: "memory")
#define PG8_WAIT_L(n) asm volatile("s_waitcnt lgkmcnt(" #n ")" ::: "memory")
#define PG8_BAR __builtin_amdgcn_s_barrier()
#define PG8_SCHED __builtin_amdgcn_sched_barrier(0)
    Unit cur, nxt; int ui = 0;
    if (!S.next(0, cur)) return;
    f32x4 acc[2][2][4][2];
#pragma unroll
    for (int a = 0; a < 2; ++a)
#pragma unroll
        for (int b = 0; b < 2; ++b)
#pragma unroll
            for (int m = 0; m < 4; ++m)
#pragma unroll
                for (int n = 0; n < 2; ++n) acc[a][b][m][n] = (f32x4){0.f, 0.f, 0.f, 0.f};
    bf16x8 At[4][2], B0[2][2], B1[2][2];
    const char* cA = (const char*)g.A + (size_t)cur.pm * tstepA + (size_t)cur.z * g.za; const char* cB = (const char*)g.Bt + (size_t)cur.pn * tstepB + (size_t)cur.z * g.zb;
    S.a_ready(cur);
    if constexpr (SP2) {
        PG8_STAGE(PG8_SB(0, 0), cB, voffB); PG8_STAGE(PG8_SB(0, 1), cB + hstepB, voffB); PG8_STAGE(PG8_SA(0, 0), cA, voffA); PG8_STAGE(PG8_SA(0, 1), cA + hstepA, voffA);
        if (wr == 1) PG8_BAR;
        PG8_WAIT_V(2); PG8_BAR;
        PG8_STAGE(PG8_SB(1, 0), cB + kstep, voffB); PG8_STAGE(PG8_SA(1, 0), cA + kstep, voffA); PG8_STAGE(PG8_SB(1, 1), cB + hstepB + kstep, voffB);
        PG8_WAIT_V(6); PG8_BAR;
    } else {
        PG8_STAGE(PG8_SB(0, 0), cB, voffB); PG8_STAGE(PG8_SA(0, 0), cA, voffA); PG8_STAGE(PG8_SB(0, 1), cB + hstepB, voffB); PG8_STAGE(PG8_SA(0, 1), cA + hstepA, voffA);
        if (wr == 1) PG8_BAR;
        PG8_WAIT_V(4); PG8_BAR;
        PG8_STAGE(PG8_SB(1, 0), cB + kstep, voffB); PG8_STAGE(PG8_SA(1, 0), cA + kstep, voffA); PG8_STAGE(PG8_SB(1, 1), cB + hstepB + kstep, voffB);
        PG8_WAIT_V(6); PG8_BAR;
    }
    for (;;) {
        const bool has_next = S.next(ui + 1, nxt);
        const char* nA = has_next ? (const char*)g.A + (size_t)nxt.pm * tstepA + (size_t)nxt.z * g.za : cA; const char* nB = has_next ? (const char*)g.Bt + (size_t)nxt.pn * tstepB + (size_t)nxt.z * g.zb : cB;
        for (int t = 0; t < nt; t += 2) {
            const bool last = (t == nt - 2);
            const char* a1 = cA + (size_t)(t + 1) * kstep;
            const char* a2 = last ? nA : cA + (size_t)(t + 2) * kstep; const char* b2 = last ? nB : cB + (size_t)(t + 2) * kstep;
            const char* a3 = a2 + kstep; const char* b3 = b2 + kstep;
            if (last && has_next) S.a_ready(nxt);
            if constexpr (SP2) {
            PG8_LDB(B0, 0, 0); PG8_LDB(B1, 0, 1); PG8_SCHED; PG8_LDA(At, 0, 0); PG8_STAGE(PG8_SA(1, 1), a1 + hstepA, voffA);
            PG8_WAIT_V(8); PG8_WAIT_L(0); PG8_BAR; if (!Sched::HALF || cur.h != 2) { PG8_MMA(0, 0, At, B0); PG8_MMA(0, 1, At, B1); } PG8_BAR; PG8_SCHED;
            PG8_LDA(At, 0, 1); PG8_STAGE(PG8_SB(0, 0), b2, voffB); PG8_STAGE(PG8_SB(0, 1), b2 + hstepB, voffB); PG8_STAGE(PG8_SA(0, 0), a2, voffA);
            PG8_WAIT_V(8); PG8_WAIT_L(0); PG8_BAR; if (!Sched::HALF || cur.h != 1) { PG8_MMA(1, 0, At, B0); PG8_MMA(1, 1, At, B1); } PG8_BAR; PG8_SCHED;
            PG8_LDB(B0, 1, 0); PG8_LDB(B1, 1, 1); PG8_SCHED; PG8_LDA(At, 1, 0); PG8_STAGE(PG8_SA(0, 1), a2 + hstepA, voffA);
            PG8_WAIT_V(8); PG8_WAIT_L(0); PG8_BAR; if (!Sched::HALF || cur.h != 2) { PG8_MMA(0, 0, At, B0); PG8_MMA(0, 1, At, B1); } PG8_BAR; PG8_SCHED;
            PG8_LDA(At, 1, 1); PG8_STAGE(PG8_SB(1, 0), b3, voffB); PG8_STAGE(PG8_SB(1, 1), b3 + hstepB, voffB); PG8_STAGE(PG8_SA(1, 0), a3, voffA);
            PG8_WAIT_V(8); PG8_WAIT_L(0); PG8_BAR; if (!Sched::HALF || cur.h != 1) { PG8_MMA(1, 0, At, B0); PG8_MMA(1, 1, At, B1); } PG8_BAR; PG8_SCHED;
            } else {
            PG8_LDB(B0, 0, 0); PG8_SCHED; PG8_LDA(At, 0, 0); PG8_STAGE(PG8_SA(1, 1), a1 + hstepA, voffA);
            PG8_WAIT_L(8); PG8_BAR; PG8_WAIT_L(0); PG8_MMA(0, 0, At, B0); PG8_BAR; PG8_SCHED;
            PG8_LDB(B1, 0, 1); PG8_STAGE(PG8_SB(0, 0), b2, voffB);
            PG8_BAR; PG8_WAIT_L(0); PG8_MMA(0, 1, At, B1); PG8_BAR;
            PG8_LDA(At, 0, 1); PG8_STAGE(PG8_SA(0, 0), a2, voffA);
            PG8_BAR; PG8_WAIT_L(0); PG8_MMA(1, 0, At, B0); PG8_BAR; PG8_SCHED;
            PG8_STAGE(PG8_SB(0, 1), b2 + hstepB, voffB);
            PG8_WAIT_V(6); PG8_BAR; PG8_MMA(1, 1, At, B1); PG8_BAR;
            PG8_LDB(B0, 1, 0); PG8_SCHED; PG8_LDA(At, 1, 0); PG8_STAGE(PG8_SA(0, 1), a2 + hstepA, voffA);
            PG8_WAIT_L(8); PG8_BAR; PG8_WAIT_L(0); PG8_MMA(0, 0, At, B0); PG8_BAR; PG8_SCHED;
            PG8_LDB(B1, 1, 1); PG8_STAGE(PG8_SB(1, 0), b3, voffB);
            PG8_BAR; PG8_WAIT_L(0); PG8_MMA(0, 1, At, B1); PG8_BAR;
            PG8_LDA(At, 1, 1); PG8_STAGE(PG8_SA(1, 0), a3, voffA);
            PG8_BAR; PG8_WAIT_L(0); PG8_MMA(1, 0, At, B0); PG8_BAR; PG8_SCHED;
            PG8_STAGE(PG8_SB(1, 1), b3 + hstepB, voffB);
            PG8_WAIT_V(6); PG8_BAR; PG8_MMA(1, 1, At, B1); PG8_BAR;
            }
        }
        if constexpr (ALIGN_EPI) { if (wr == 0) PG8_BAR; }
        if constexpr (!Epi::AFTER_DRAIN) { E(acc, cur, wr, wc, fr, fq); S.done(cur); }
        if (!has_next) break;
#pragma unroll
        for (int a = 0; a < 2; ++a)
#pragma unroll
            for (int b = 0; b < 2; ++b)
#pragma unroll
                for (int m = 0; m < 4; ++m)
#pragma unroll
                    for (int n = 0; n < 2; ++n) acc[a][b][m][n] = (f32x4){0.f, 0.f, 0.f, 0.f};
        cur = nxt; cA = nA; cB = nB; ++ui;
        if constexpr (ALIGN_EPI) { if (wr == 1) PG8_BAR; }
    }
    PG8_WAIT_V(0);
    if constexpr (!ALIGN_EPI) { if (wr == 0) PG8_BAR; }
    PG8_BAR;
    if constexpr (Epi::AFTER_DRAIN) { E.fused(acc, cur, wr, wc, fr, fq, lds, wid, lane); S.done(cur); }
#undef PG8_SA
#undef PG8_SB
#undef PG8_STAGE
#undef PG8_LDA
#undef PG8_LDB
#undef PG8_MMA
#undef PG8_WAIT_V
#undef PG8_WAIT_L
#undef PG8_BAR
#undef PG8_SCHED
}
}

__device__ __forceinline__ void wconv_item(const float* W, int ld, int col0, int k0, bf16_t* WT, int K, int drow0, LAS float* scr, int lane) {
    if (W == nullptr) {
#pragma unroll
        for (int j = 0; j < 4; ++j) { const int n = (lane >> 3) + 8 * j; *(uint4*)(WT + (size_t)(drow0 + n) * K + k0 + 8 * (lane & 7)) = make_uint4(0u, 0u, 0u, 0u); }
        return;
    }
    float wv[32];
#pragma unroll
    for (int i = 0; i < 32; ++i) { const int kk = 2 * i + (lane >> 5); wv[i] = W[(size_t)(k0 + kk) * ld + col0 + (lane & 31)]; }
#pragma unroll
    for (int i = 0; i < 32; ++i) { const int kk = 2 * i + (lane >> 5); scr[kk * 33 + (lane & 31)] = wv[i]; }
    asm volatile("s_waitcnt lgkmcnt(0)" ::: "memory");
    const int c = lane & 7;
#pragma unroll
    for (int j = 0; j < 4; ++j) { const int n = (lane >> 3) + 8 * j; const LAS float* s = scr + (8 * c) * 33 + n;
        uint4 o; o.x = pk2(s[0 * 33], s[1 * 33]); o.y = pk2(s[2 * 33], s[3 * 33]); o.z = pk2(s[4 * 33], s[5 * 33]); o.w = pk2(s[6 * 33], s[7 * 33]);
        *(uint4*)(WT + (size_t)(drow0 + n) * K + k0 + 8 * c) = o; }
    asm volatile("s_waitcnt lgkmcnt(0)" ::: "memory");
}
__device__ __forceinline__ void ph_wconv(const Ctx& C0) {
    PHASE_CTX(C0);
    LAS float* scr = (LAS float*)((LAS unsigned char*)C.lds + C.wave * 16384);
    const int lane = C.lane;
    __syncthreads();
    constexpr int I_WI = 120 * 16, I_WZ = 96 * 16, I_WG = 32 * 8, I_WR = 96 * 8, I_WO = 32 * 16, I_WU = 176 * 16, I_WD = 32 * 44;
    constexpr int I_LAYER = I_WI + I_WZ + I_WG + I_WR + I_WO + I_WU + I_WD;
    for (int it = C.bid * NWAVE + C.wave; it < 2 * I_LAYER; it += C.G * NWAVE) {
        const int l = it / I_LAYER; int r = it % I_LAYER;
        unsigned char* wb = WS_ + W_WB + (size_t)l * WB_LAYER;
        if (r < I_WI) { const int rb = r >> 4, kb = r & 15, pn = rb >> 3, tb = rb & 7; int col = -1;
            if (pn < 4) col = 256 * pn + 64 * (tb & 3) + 32 * (tb >> 2);
            else if (pn < 6) col = C_AV + 256 * (pn - 4) + 32 * tb;
            else if (pn == 6) col = C_BQ + 32 * tb; else if (pn == 7) col = C_BK + 32 * tb;
            else if (pn < 10) col = C_BV + 256 * (pn - 8) + 32 * tb; else if (pn < 12) col = C_BG + 256 * (pn - 10) + 32 * tb;
            else if (pn < 14) col = C_CU + 256 * (pn - 12) + 32 * tb; else if (tb == 0) col = C_BR;
            wconv_item(col < 0 ? nullptr : c_w_in + (size_t)l * 1024 * IN_DIM, IN_DIM, col, kb * 64, (bf16_t*)(wb + WB_WI), 1024, rb * 32, scr, lane); continue; }
        r -= I_WI;
        if (r < I_WZ) { const int rb = r >> 4, kb = r & 15; wconv_item(c_w_in + (size_t)l * 1024 * IN_DIM, IN_DIM, C_GZ + 32 * rb, kb * 64, (bf16_t*)(wb + WB_WZ), 1024, rb * 32, scr, lane); continue; }
        r -= I_WZ;
        if (r < I_WG) { const int rb = r >> 3, kb = r & 7, pn = rb >> 3, tb = rb & 7; wconv_item(c_s5_w_glu + (size_t)l * 512 * 1024, 1024, 512 * (tb >> 2) + 128 * pn + 32 * (tb & 3), kb * 64, (bf16_t*)(wb + WB_WG), 512, rb * 32, scr, lane); continue; }
        r -= I_WG;
        if (r < I_WR) { const int rb = r >> 3, kb = r & 7, br = rb >> 5, rbb = rb & 31; wconv_item(c_w_branch + ((size_t)l * 3 + br) * 512 * 1024, 1024, 32 * rbb, kb * 64, (bf16_t*)(wb + WB_WR), 512, rb * 32, scr, lane); continue; }
        r -= I_WR;
        if (r < I_WO) { const int rb = r >> 4, kb = r & 15; wconv_item(c_w_out + (size_t)l * 1024 * 1024, 1024, 32 * rb, kb * 64, (bf16_t*)(wb + WB_WO), 1024, rb * 32, scr, lane); continue; }
        r -= I_WO;
        if (r < I_WU) { const int rb = r >> 4, kb = r & 15, pn = rb >> 3, tb = rb & 7; const float* src = (tb >> 2) ? c_w_up : c_w_gate;
            wconv_item(src + (size_t)l * 1024 * FFN, FFN, 128 * pn + 32 * (tb & 3), kb * 64, (bf16_t*)(wb + WB_WU), 1024, rb * 32, scr, lane); continue; }
        r -= I_WU;
        { const int rb = r / 44, kb = r % 44; wconv_item(c_w_down + (size_t)l * FFN * 1024, 1024, 32 * rb, kb * 64, (bf16_t*)(wb + WB_WD), FFN, rb * 32, scr, lane); }
    }
}

__device__ __forceinline__ uint4 pack8(const f32x4& a, const f32x4& b) { uint4 w; w.x = pk2(a[0], a[1]); w.y = pk2(a[2], a[3]); w.z = pk2(b[0], b[1]); w.w = pk2(b[2], b[3]); return w; }
struct EpiIn {
    static constexpr bool PERM = true, AFTER_DRAIN = false;
    unsigned char* ws_; float* out_; const float* qg; const float* kg; int l; int pad_;
    __device__ __forceinline__ void operator()(const f32x4 (&acc)[2][2][4][2], const pg8::Unit& u, int wr, int wc, int fr_, int fq_) const {
        int fr = fr_, fq = fq_; asm volatile("" : "+v"(fr), "+v"(fq));
        KArgPtr Pk = kargs(); unsigned char* ws = Pk->ws; float* out = Pk->out;
        const int pn = u.pn, rowb = u.pm * 256 + wr * 64 + fr;
        if (pn < 4) {
            const bool isk = pn >= 2; const float* g = isk ? kg : qg;
            const bool latent = u.pm >= 32;
            const float* cosT = (const float*)(ws + W_MISC) + 64; const float* sinT = cosT + 1024;
            bf16_t* dstb = isk ? (bf16_t*)(ws + W_AK) : (bf16_t*)(ws + W_AQ);
            const int colb = (pn & 1) * 256 + 64 * wc + 8 * fq;
#pragma unroll
            for (int ai = 0; ai < 2; ++ai)
#pragma unroll
                for (int m = 0; m < 4; ++m) {
                    const int row = rowb + ai * 128 + m * 16;
                    f32x4 v[2][2]; float ss = 0.f;
#pragma unroll
                    for (int bj = 0; bj < 2; ++bj)
#pragma unroll
                        for (int n = 0; n < 2; ++n) { v[bj][n] = acc[ai][bj][m][n]; ss += v[bj][n][0] * v[bj][n][0] + v[bj][n][1] * v[bj][n][1] + v[bj][n][2] * v[bj][n][2] + v[bj][n][3] * v[bj][n][3]; }
                    ss += shx(ss, 16, fq * 16 + fr); ss = xsum32(ss);
                    const float rs = rsqrtf(ss * (1.f / 64.f) + EPS);
                    { const float* gp = (isk ? Pk->in[14] : Pk->in[13]) + l * 64 + launder_s(0);
#pragma unroll
                      for (int bj = 0; bj < 2; ++bj)
#pragma unroll
                        for (int n = 0; n < 2; ++n) v[bj][n] = v[bj][n] * rs * *(const f32x4*)(gp + 32 * bj + 8 * fq + 4 * n); }
                    if (isk && !latent) {
                        float* o = out + O_NK + ((size_t)((row >> 8) * 2 + l) * 256 + (row & 255)) * 512 + colb;
#pragma unroll
                        for (int bj = 0; bj < 2; ++bj) { *(f32x4*)(o + 32 * bj) = v[bj][0]; *(f32x4*)(o + 32 * bj + 4) = v[bj][1]; }
                    }
                    if (latent) {
                        const int t = (row - NPROMPT) & 2047;
#pragma unroll
                        for (int bj = 0; bj < 2; ++bj) {
                            const int pos = bj ? (t & 63) : (t >> 6);
#pragma unroll
                            for (int n = 0; n < 2; ++n) {
                                const f32x4 cc = *(const f32x4*)(cosT + pos * 16 + 8 * (fq & 1) + 4 * n), sn = *(const f32x4*)(sinT + pos * 16 + 8 * (fq & 1) + 4 * n);
                                f32x4 ot;
#pragma unroll
                                for (int e = 0; e < 4; ++e) ot[e] = shx(v[bj][n][e], 32, fq * 16 + fr);
                                v[bj][n] = (fq & 2) ? (v[bj][n] * cc + ot * sn) : (v[bj][n] * cc - ot * sn);
                            }
                        }
                    }
                    bf16_t* d = dstb + (size_t)(isk ? krow_of(row) : row) * 512 + colb;
#pragma unroll
                    for (int bj = 0; bj < 2; ++bj) *(uint4*)(d + 32 * bj) = pack8(v[bj][0], v[bj][1]);
                }
            return;
        }
        const int cb = 32 * wc + 8 * fq;
        if (pn < 6) {
            bf16_t* AV = (bf16_t*)(ws + W_AV);
#pragma unroll
            for (int ai = 0; ai < 2; ++ai)
#pragma unroll
                for (int m = 0; m < 4; ++m) { const int row = rowb + ai * 128 + m * 16;
#pragma unroll
                    for (int bj = 0; bj < 2; ++bj) { const int col = (pn - 4) * 256 + 128 * bj + cb;
                        *(uint4*)(AV + (size_t)krow_of(row) * 512 + col) = pack8(acc[ai][bj][m][0], acc[ai][bj][m][1]);
                        if (row < NPROMPT) { float* o = out + O_NV + ((size_t)((row >> 8) * 2 + l) * 256 + (row & 255)) * 512 + col; *(f32x4*)o = acc[ai][bj][m][0]; *(f32x4*)(o + 4) = acc[ai][bj][m][1]; } } }
            return;
        }
        if (pn == 14) {
            if (wc == 0) { float* BR = (float*)(ws + W_BR);
#pragma unroll
                for (int ai = 0; ai < 2; ++ai)
#pragma unroll
                    for (int m = 0; m < 4; ++m) { const int row = rowb + ai * 128 + m * 16; *(f32x4*)(BR + (size_t)row * 32 + 8 * fq) = acc[ai][0][m][0]; *(f32x4*)(BR + (size_t)row * 32 + 8 * fq + 4) = acc[ai][0][m][1]; } }
            return;
        }
        bf16_t* dst; int ldd, c0; int mode = 0;
        if (pn == 6) { dst = (bf16_t*)(ws + W_BQ); ldd = 256; c0 = 0; mode = 1; }
        else if (pn == 7) { dst = (bf16_t*)(ws + W_BK); ldd = 256; c0 = 0; }
        else if (pn < 10) { dst = (bf16_t*)(ws + W_BV); ldd = 512; c0 = (pn - 8) * 256; }
        else if (pn < 12) { dst = (bf16_t*)(ws + W_BG); ldd = 512; c0 = (pn - 10) * 256; mode = 2; }
        else {
            bf16_t* UH = (bf16_t*)(ws + W_UH);
#pragma unroll
            for (int ai = 0; ai < 2; ++ai)
#pragma unroll
                for (int m = 0; m < 4; ++m) { const int row = rowb + ai * 128 + m * 16;
#pragma unroll
                    for (int bj = 0; bj < 2; ++bj) { const int col = (pn - 12) * 256 + 128 * bj + cb, g = col >> 4, ch0 = col & 15;
                        *(uint4*)(UH + ((size_t)g * 512 + (row >> 5)) * 768 + (row & 31) * 16 + ch0) = pack8(acc[ai][bj][m][0], acc[ai][bj][m][1]); } }
            return;
        }
#pragma unroll
        for (int ai = 0; ai < 2; ++ai)
#pragma unroll
            for (int m = 0; m < 4; ++m) { const int row = rowb + ai * 128 + m * 16;
#pragma unroll
                for (int bj = 0; bj < 2; ++bj) { f32x4 a = acc[ai][bj][m][0], b = acc[ai][bj][m][1];
                    if (mode == 1) { a = a * 0.125f; b = b * 0.125f; }
                    if (mode == 2) {
#pragma unroll
                        for (int e = 0; e < 4; ++e) { a[e] = siluf_(a[e]); b[e] = siluf_(b[e]); } }
                    *(uint4*)(dst + (size_t)row * ldd + c0 + 128 * bj + cb) = pack8(a, b); } }
    }
};
struct EpiGate {
    static constexpr bool PERM = true, AFTER_DRAIN = false;
    bf16_t* G;
    __device__ __forceinline__ void operator()(const f32x4 (&acc)[2][2][4][2], const pg8::Unit& u, int wr, int wc, int fr_, int fq_) const {
        int fr = fr_, fq = fq_; asm volatile("" : "+v"(fr), "+v"(fq));
        const int rowb = u.pm * 256 + wr * 64 + fr, cb = u.pn * 256 + 32 * wc + 8 * fq;
#pragma unroll
        for (int ai = 0; ai < 2; ++ai)
#pragma unroll
            for (int m = 0; m < 4; ++m) { const int row = rowb + ai * 128 + m * 16;
#pragma unroll
                for (int bj = 0; bj < 2; ++bj) { f32x4 a = acc[ai][bj][m][0], b = acc[ai][bj][m][1];
#pragma unroll
                    for (int e = 0; e < 4; ++e) { a[e] = sigmoidf_(a[e]); b[e] = sigmoidf_(b[e]); }
                    *(uint4*)(G + (size_t)row * 3072 + cb + 128 * bj) = pack8(a, b); } }
    }
};
struct EpiGlu {
    static constexpr bool PERM = true, AFTER_DRAIN = false;
    bf16_t* OC; const float* bias;
    __device__ __forceinline__ void operator()(const f32x4 (&acc)[2][2][4][2], const pg8::Unit& u, int wr, int wc, int fr_, int fq_) const {
        int fr = fr_, fq = fq_; asm volatile("" : "+v"(fr), "+v"(fq));
        const int rowb = u.pm * 256 + wr * 64 + fr, col = u.pn * 128 + 32 * wc + 8 * fq;
        const f32x4 ba0 = *(const f32x4*)(bias + col), ba1 = *(const f32x4*)(bias + col + 4), bb0 = *(const f32x4*)(bias + 512 + col), bb1 = *(const f32x4*)(bias + 512 + col + 4);
#pragma unroll
        for (int ai = 0; ai < 2; ++ai)
#pragma unroll
            for (int m = 0; m < 4; ++m) { const int row = rowb + ai * 128 + m * 16;
                f32x4 a0 = acc[ai][0][m][0] + ba0, a1 = acc[ai][0][m][1] + ba1, b0 = acc[ai][1][m][0] + bb0, b1 = acc[ai][1][m][1] + bb1;
#pragma unroll
                for (int e = 0; e < 4; ++e) { a0[e] *= sigmoidf_(b0[e]); a1[e] *= sigmoidf_(b1[e]); }
                *(uint4*)(OC + (size_t)row * 512 + col) = pack8(a0, a1); }
    }
};
struct EpiBranch {
    static constexpr bool PERM = true, AFTER_DRAIN = false;
    const bf16_t* G; bf16_t* MG;
    __device__ __forceinline__ void operator()(const f32x4 (&acc)[2][2][4][2], const pg8::Unit& u, int wr, int wc, int fr_, int fq_) const {
        int fr = fr_, fq = fq_; asm volatile("" : "+v"(fr), "+v"(fq));
        const int rowb = u.pm * 256 + wr * 64 + fr, cb = u.pn * 256 + 32 * wc + 8 * fq, r = u.z;
#pragma unroll
        for (int ai = 0; ai < 2; ++ai)
#pragma unroll
            for (int m = 0; m < 4; ++m) { const int row = rowb + ai * 128 + m * 16;
#pragma unroll
                for (int bj = 0; bj < 2; ++bj) { const int col = cb + 128 * bj;
                    const uint4 gr = *(const uint4*)(G + (size_t)row * 3072 + r * 1024 + col);
                    f32x4 g0, g1;
                    g0[0] = __uint_as_float(gr.x << 16); g0[1] = __uint_as_float(gr.x & 0xffff0000u); g0[2] = __uint_as_float(gr.y << 16); g0[3] = __uint_as_float(gr.y & 0xffff0000u);
                    g1[0] = __uint_as_float(gr.z << 16); g1[1] = __uint_as_float(gr.z & 0xffff0000u); g1[2] = __uint_as_float(gr.w << 16); g1[3] = __uint_as_float(gr.w & 0xffff0000u);
                    f32x4 a = acc[ai][bj][m][0] * g0, b = acc[ai][bj][m][1] * g1;
                    bf16_t* mp = MG + (size_t)row * 1024 + col;
                    if (r > 0) { const uint4 pr = *(const uint4*)mp;
                        a[0] += __uint_as_float(pr.x << 16); a[1] += __uint_as_float(pr.x & 0xffff0000u); a[2] += __uint_as_float(pr.y << 16); a[3] += __uint_as_float(pr.y & 0xffff0000u);
                        b[0] += __uint_as_float(pr.z << 16); b[1] += __uint_as_float(pr.z & 0xffff0000u); b[2] += __uint_as_float(pr.w << 16); b[3] += __uint_as_float(pr.w & 0xffff0000u); }
                    *(uint4*)mp = pack8(a, b); } }
    }
};
struct EpiRes {
    static constexpr bool PERM = true, AFTER_DRAIN = false;
    const void* x0; const void* x1; void* o0; void* o1; const float* MODg; int in_bf16, out_bf16;
    __device__ __forceinline__ void operator()(const f32x4 (&acc)[2][2][4][2], const pg8::Unit& u, int wr, int wc, int fr_, int fq_) const {
        int fr = fr_, fq = fq_; asm volatile("" : "+v"(fr), "+v"(fq));
        const int rowb = u.pm * 256 + wr * 64 + fr, cb = u.pn * 256 + 32 * wc + 8 * fq;
        const float* mg = MODg + (size_t)cond_row(u.pm * 256) * 6144;
        const bool ctx = u.pm < NPROMPT / 256;
        const void* xi0 = ctx ? x0 : x1; void* xo0 = ctx ? o0 : o1;
#pragma unroll
        for (int bj = 0; bj < 2; ++bj) { const int col = cb + 128 * bj;
            const f32x4 m0 = *(const f32x4*)(mg + col), m1 = *(const f32x4*)(mg + col + 4);
#pragma unroll
            for (int ai = 0; ai < 2; ++ai)
#pragma unroll
                for (int m = 0; m < 4; ++m) { const int row = rowb + ai * 128 + m * 16;
                    const size_t off = (size_t)(ctx ? row : row - NPROMPT) * D + col;
                    f32x4 a, b;
                    if (in_bf16) { const uint4 w = *(const uint4*)((const bf16_t*)xi0 + off);
                        a[0] = __uint_as_float(w.x << 16); a[1] = __uint_as_float(w.x & 0xffff0000u); a[2] = __uint_as_float(w.y << 16); a[3] = __uint_as_float(w.y & 0xffff0000u);
                        b[0] = __uint_as_float(w.z << 16); b[1] = __uint_as_float(w.z & 0xffff0000u); b[2] = __uint_as_float(w.w << 16); b[3] = __uint_as_float(w.w & 0xffff0000u); }
                    else { a = *(const f32x4*)((const float*)xi0 + off); b = *(const f32x4*)((const float*)xi0 + off + 4); }
                    a += m0 * acc[ai][bj][m][0]; b += m1 * acc[ai][bj][m][1];
                    if (out_bf16) *(uint4*)((bf16_t*)xo0 + off) = pack8(a, b);
                    else { *(f32x4*)((float*)xo0 + off) = a; *(f32x4*)((float*)xo0 + off + 4) = b; } } }
    }
};
struct EpiFfn {
    static constexpr bool PERM = true, AFTER_DRAIN = false;
    bf16_t* H;
    __device__ __forceinline__ void operator()(const f32x4 (&acc)[2][2][4][2], const pg8::Unit& u, int wr, int wc, int fr_, int fq_) const {
        int fr = fr_, fq = fq_; asm volatile("" : "+v"(fr), "+v"(fq));
        const int rowb = u.pm * 256 + wr * 64 + fr, col = u.pn * 128 + 32 * wc + 8 * fq;
#pragma unroll
        for (int ai = 0; ai < 2; ++ai) {
            if (u.h != 0 && u.h != ai + 1) continue;
#pragma unroll
            for (int m = 0; m < 4; ++m) { const int row = rowb + ai * 128 + m * 16;
                f32x4 a0 = acc[ai][0][m][0], a1 = acc[ai][0][m][1];
#pragma unroll
                for (int e = 0; e < 4; ++e) { a0[e] = siluf_(a0[e]) * acc[ai][1][m][0][e]; a1[e] = siluf_(a1[e]) * acc[ai][1][m][1][e]; }
                *(uint4*)(H + (size_t)row * FFN + col) = pack8(a0, a1); } }
    }
};
struct FfnOrder {
    pg8::StaticOrder S;
    static constexpr bool HALF = true;
    __device__ bool next(int i, pg8::Unit& u) const {
        if (S.G != 256 || S.nwg != 1408) return S.next(i, u);
        if (i < 5) { S.map(i * 256 + S.c, u); return true; }
        if (i > 5) return false;
        S.map(1280 + ((S.c >> 4) << 3) + (S.c & 7), u); u.h = 1 + ((S.c >> 3) & 1); return true;
    }
    __device__ __forceinline__ void a_ready(const pg8::Unit&) const {}
    __device__ __forceinline__ void done(const pg8::Unit&) const {}
};
struct BranchOrder {
    pg8::StaticOrder S;
    static constexpr bool HALF = false;
    __device__ bool next(int i, pg8::Unit& u) const { if (i >= 3) return false; if (!S.next(0, u)) return false; u.z = i; return true; }
    __device__ __forceinline__ void a_ready(const pg8::Unit&) const {}
    __device__ __forceinline__ void done(const pg8::Unit&) const {}
};
constexpr int S5T = 32;
constexpr size_t TE_BYTES = 256 * 512 * 2, TC_BYTES = 512 * 768 * 2, TAB_TE = 0, TAB_TC = 32 * TE_BYTES;
__device__ __forceinline__ unsigned char* s5_tab(unsigned char* ws, int l) { return ws + (l == 0 ? W_TAB0 : W_TAB1); }
template <int MODE>
__device__ __forceinline__ void ph_s5_tables(const Ctx& C0) {
    PHASE_CTX(C0);
    float* sApr = (float*)C.lds;
    float* sApi = sApr + 2 * 33 * 64;
    float* sBr = sApi + 2 * 33 * 64;
    float* sBi = sBr + 2 * 64 * 16;
    float* sCr = sBi + 2 * 64 * 16;
    float* sCi = sCr + 2 * 16 * 64;
    float* sK = sCi + 2 * 16 * 64;
    float* sD = sK + 2 * 32 * 260;
    const int tid = C.tid;
    for (int item0 = (MODE == 0 ? C.G - 1 - C.bid : C.bid); item0 < (MODE == 0 ? 64 : 256); item0 += C.G) {
        const int item = MODE == 0 ? item0 * 4 : item0;
        const int l = item >> 7, g = (item >> 2) & 31, sub = item & 3;
        __syncthreads();
        constexpr int AUXF = 2 * 2 * 33 * 64 + 2 * 2 * 64 * 16 + 2 * 2 * 16 * 64;
        float* aux = WSP(float, W_KAUX) + ((size_t)l * 32 + g) * (AUXF + 16);
        if (MODE == 1) {
            f32x4 av[9];
#pragma unroll
            for (int q = 0; q < 9; ++q) { const int i = tid + q * NT; av[q] = i < AUXF / 4 ? ((const f32x4*)aux)[i] : (f32x4){0.f, 0.f, 0.f, 0.f}; }
            const float dv = tid < 16 ? aux[AUXF + tid] : 0.f;
#pragma unroll
            for (int q = 0; q < 9; ++q) { const int i = tid + q * NT; if (i < AUXF / 4) ((f32x4*)sApr)[i] = av[q]; }
            if (tid < 16) sD[tid] = dv;
        }
        if (MODE == 0) {
        for (int i = tid; i < 2 * 33 * 64; i += NT) {
            const int dir = i / (33 * 64), t = (i / 64) % 33, p = i & 63; const size_t ld = (size_t)l * 2 + dir;
            const float lr = c_s5_lam_re[(ld * 32 + g) * 64 + p], li = c_s5_lam_im[(ld * 32 + g) * 64 + p], dt = expf(c_s5_log_dt[ld * 32 + g]);
            const float mag = expf(lr * dt * (float)t); float sn, cs; sincosf(li * dt * (float)t, &sn, &cs);
            sApr[(dir * 33 + t) * 64 + p] = mag * cs; sApi[(dir * 33 + t) * 64 + p] = mag * sn; }
        if (tid < 128) {
            const int dir = tid >> 6, p = tid & 63; const size_t ld = (size_t)l * 2 + dir;
            const float lr = c_s5_lam_re[(ld * 32 + g) * 64 + p], li = c_s5_lam_im[(ld * 32 + g) * 64 + p], dt = expf(c_s5_log_dt[ld * 32 + g]);
            const float mag = expf(lr * dt); const float ar = mag * cosf(li * dt), ai = mag * sinf(li * dt), den = lr * lr + li * li;
            const float fr = ((ar - 1.f) * lr + ai * li) / den, fi = (ai * lr - (ar - 1.f) * li) / den;
            for (int c = 0; c < 16; ++c) { const float br_ = c_s5_b_re[((ld * 32 + g) * 64 + p) * 16 + c], bi_ = c_s5_b_im[((ld * 32 + g) * 64 + p) * 16 + c];
                sBr[(dir * 64 + p) * 16 + c] = fr * br_ - fi * bi_; sBi[(dir * 64 + p) * 16 + c] = fr * bi_ + fi * br_; }
            for (int o = 0; o < 16; ++o) { sCr[(dir * 16 + o) * 64 + p] = c_s5_c_re[((ld * 32 + g) * 16 + o) * 64 + p]; sCi[(dir * 16 + o) * 64 + p] = c_s5_c_im[((ld * 32 + g) * 16 + o) * 64 + p]; }
        }
        if (tid >= 128 && tid < 144) sD[tid - 128] = c_s5_d[(size_t)l * 512 + g * 16 + (tid - 128)];
        }
        __syncthreads();
        if (MODE == 0) {
            for (int i = tid; i < AUXF / 4; i += NT) ((f32x4*)aux)[i] = ((const f32x4*)sApr)[i];
            if (tid < 16) aux[AUXF + tid] = sD[tid];
        }
        if (tid < 128 && MODE == 0) {
            const int dir = tid >> 6, p = tid & 63; float* at = WSP(float, W_ATAB) + ((((size_t)l * 32 + g) * 2 + dir) * 64 + p) * 2;
            at[0] = sApr[(dir * 33 + 32) * 64 + p]; at[1] = sApi[(dir * 33 + 32) * 64 + p];
        }
        float* Kg = WSP(float, W_KG) + ((size_t)l * 32 + g) * 16384;
        if (MODE == 1) { f32x4 kv[8];
#pragma unroll
            for (int q = 0; q < 8; ++q) kv[q] = ((const f32x4*)Kg)[tid + q * NT];
#pragma unroll
            for (int q = 0; q < 8; ++q) { const int i = tid + q * NT; ((f32x4*)sK)[(i >> 6) * 65 + (i & 63)] = kv[q]; } }
        if (MODE == 0) for (int combo = tid; combo < 1024; combo += NT) {
            const int dir = combo >> 9, tau = (combo >> 4) & 31, o = combo & 15;
            float acc[16];
#pragma unroll
            for (int c = 0; c < 16; ++c) acc[c] = 0.f;
            for (int p = 0; p < 64; ++p) {
                const float cr = sCr[(dir * 16 + o) * 64 + p], ci = sCi[(dir * 16 + o) * 64 + p], ar = sApr[(dir * 33 + tau) * 64 + p], ai = sApi[(dir * 33 + tau) * 64 + p];
                const float wr = cr * ar - ci * ai, wi = cr * ai + ci * ar;
#pragma unroll
                for (int c = 0; c < 16; ++c) acc[c] += wr * sBr[(dir * 64 + p) * 16 + c] - wi * sBi[(dir * 64 + p) * 16 + c];
            }
#pragma unroll
            for (int c = 0; c < 16; ++c) Kg[((dir * 32 + tau) * 16 + o) * 16 + c] = acc[c];
        }
        if (MODE == 0) continue;
        __syncthreads();
        unsigned char* tab = s5_tab(WS_, l);
        bf16_t* TC = (bf16_t*)(tab + TAB_TC + (size_t)g * TC_BYTES);
        bf16_t* TE = (bf16_t*)(tab + TAB_TE + (size_t)g * TE_BYTES);
        for (int ch = tid; ch < 128 * 64; ch += NT) {
            const int n = sub * 128 + (ch >> 6), kc = ch & 63, j = n >> 4, o = n & 15, i = kc >> 1, c0 = (kc & 1) * 8;
            const float* src = sK + (i <= j ? j - i : 32 + i - j) * 260 + o * 16 + c0;
            f32x4 a = *(const f32x4*)src, b = *(const f32x4*)(src + 4);
            if (i == j) { const float* s1 = sK + 32 * 260 + o * 16 + c0; a += *(const f32x4*)s1; b += *(const f32x4*)(s1 + 4); const float dv = sD[o];
#pragma unroll
                for (int e = 0; e < 4; ++e) { a[e] += (o == c0 + e) ? dv : 0.f; b[e] += (o == c0 + 4 + e) ? dv : 0.f; } }
            *(uint4*)(TC + (size_t)n * 768 + kc * 8) = pack8(a, b);
        }
        for (int ch = tid; ch < 128 * 32; ch += NT) {
            const int n = sub * 128 + (ch >> 5), kq = ch & 31, j = n >> 4, o = n & 15;
            const int kk = kq * 8, dir = kk >> 7, ri = (kk >> 6) & 1, p0 = kk & 63; const int tau = dir == 0 ? j + 1 : S5T - j;
            const float* pc = sCr + (dir * 16 + o) * 64 + p0; const float* pa = sApr + (dir * 33 + tau) * 64 + p0;
            const f32x4 cr0 = *(const f32x4*)pc, cr1 = *(const f32x4*)(pc + 4), ci0 = *(const f32x4*)(pc + 2 * 16 * 64), ci1 = *(const f32x4*)(pc + 2 * 16 * 64 + 4);
            const f32x4 ar0 = *(const f32x4*)pa, ar1 = *(const f32x4*)(pa + 4), ai0 = *(const f32x4*)(pa + 2 * 33 * 64), ai1 = *(const f32x4*)(pa + 2 * 33 * 64 + 4);
            const f32x4 v0 = ri == 0 ? (cr0 * ar0 - ci0 * ai0) : -(cr0 * ai0 + ci0 * ar0), v1 = ri == 0 ? (cr1 * ar1 - ci1 * ai1) : -(cr1 * ai1 + ci1 * ar1);
            *(uint4*)(TC + (size_t)n * 768 + 512 + kq * 8) = pack8(v0, v1);
        }
        for (int ch = tid; ch < 64 * 64; ch += NT) {
            const int n = sub * 64 + (ch >> 6), kc = ch & 63, dir = n >> 7, ri = (n >> 6) & 1, p = n & 63, i = kc >> 1, c0 = (kc & 1) * 8;
            const int tau = dir == 0 ? S5T - 1 - i : i;
            const float ar = sApr[(dir * 33 + tau) * 64 + p], ai = sApi[(dir * 33 + tau) * 64 + p];
            float v[8];
#pragma unroll
            for (int e = 0; e < 8; ++e) { const float br_ = sBr[(dir * 64 + p) * 16 + c0 + e], bi_ = sBi[(dir * 64 + p) * 16 + c0 + e];
                v[e] = ri == 0 ? (ar * br_ - ai * bi_) : (ar * bi_ + ai * br_); }
            uint4 w; w.x = pk2(v[0], v[1]); w.y = pk2(v[2], v[3]); w.z = pk2(v[4], v[5]); w.w = pk2(v[6], v[7]);
            *(uint4*)(TE + (size_t)n * 512 + kc * 8) = w;
        }
    }
}
__device__ __forceinline__ void ph_s5_scan(const Ctx& C0, int l) {
    PHASE_CTX(C0);
    const int lane = C.lane;
    const float* HL = WSP(float, W_HLOC); bf16_t* UH = WSP(bf16_t, W_UH);
    for (int w0 = C.bid * NWAVE + C.wave; w0 < 36 * 64; w0 += C.G * NWAVE) {
        const int w = (w0 + 36 * 64 - 512) % (36 * 64);
        const int dir = w & 1, g = (w >> 1) & 31, s = 35 - (w >> 6);
        const bool latent = s >= 32;
        const int nch = latent ? 64 : 8, ch0 = latent ? 256 + (s - 32) * 64 : s * 8;
        const float* at = WSP(float, W_ATAB) + ((((size_t)l * 32 + g) * 2 + dir) * 64 + lane) * 2;
        const float ar = at[0], ai = at[1];
        float hr = 0.f, hi = 0.f;
        if (latent) { const float* si = c_state_s5 + ((((size_t)(s - 32) * 2 + l) * 2 + dir) * 2) * 2048 + g * 64 + lane; hr = si[0]; hi = si[2048]; }
#pragma unroll 1
        for (int n0 = 0; n0 < nch; n0 += 8) {
            float lr_[8], li_[8];
#pragma unroll
            for (int b = 0; b < 8; ++b) { const int ch = ch0 + (dir == 0 ? n0 + b : nch - 1 - n0 - b);
                const float* hl = HL + ((size_t)g * 512 + ch) * 256 + dir * 128 + lane; lr_[b] = hl[0]; li_[b] = hl[64]; }
#pragma unroll
            for (int b = 0; b < 8; ++b) { const int ch = ch0 + (dir == 0 ? n0 + b : nch - 1 - n0 - b);
                bf16_t* uh = UH + ((size_t)g * 512 + ch) * 768 + 512 + dir * 128 + lane;
                uh[0] = f2bf(hr); uh[64] = f2bf(hi);
                const float nr = ar * hr - ai * hi + lr_[b], ni = ar * hi + ai * hr + li_[b];
                hr = nr; hi = ni; }
        }
        if (!latent) { float* so = c_out + O_NS + ((((size_t)s * 2 + l) * 2 + dir) * 2) * 2048 + g * 64 + lane; so[0] = hr; so[2048] = hi; }
    }
}
struct ZOrder {
    int nz, nM, nN, G, c;
    static constexpr bool HALF = false;
    __device__ bool next(int i, pg8::Unit& u) const { const int L = i * G + c; if (c >= G || L >= nz * nM * nN) return false; u.h = 0; u.z = L / (nM * nN); const int r = L % (nM * nN); u.pm = r % nM; u.pn = r / nM; return true; }
    __device__ __forceinline__ void a_ready(const pg8::Unit&) const {}
    __device__ __forceinline__ void done(const pg8::Unit&) const {}
};
struct EpiHloc {
    static constexpr bool PERM = true, AFTER_DRAIN = false;
    float* HL;
    __device__ __forceinline__ void operator()(const f32x4 (&acc)[2][2][4][2], const pg8::Unit& u, int wr, int wc, int fr_, int fq_) const {
        int fr = fr_, fq = fq_; asm volatile("" : "+v"(fr), "+v"(fq));
        const int rowb = u.pm * 256 + wr * 64 + fr, cb = 32 * wc + 8 * fq;
#pragma unroll
        for (int ai = 0; ai < 2; ++ai)
#pragma unroll
            for (int m = 0; m < 4; ++m) { const int row = rowb + ai * 128 + m * 16;
#pragma unroll
                for (int bj = 0; bj < 2; ++bj) { float* o = HL + ((size_t)u.z * 512 + row) * 256 + 128 * bj + cb; *(f32x4*)o = acc[ai][bj][m][0]; *(f32x4*)(o + 4) = acc[ai][bj][m][1]; } }
    }
};
struct EpiS5Y {
    static constexpr bool PERM = true, AFTER_DRAIN = false;
    bf16_t* YC;
    __device__ __forceinline__ void operator()(const f32x4 (&acc)[2][2][4][2], const pg8::Unit& u, int wr, int wc, int fr_, int fq_) const {
        int fr = fr_, fq = fq_; asm volatile("" : "+v"(fr), "+v"(fq));
        const int rowb = u.pm * 256 + wr * 64 + fr, g = u.z;
#pragma unroll
        for (int ai = 0; ai < 2; ++ai)
#pragma unroll
            for (int m = 0; m < 4; ++m) { const int chunk = rowb + ai * 128 + m * 16;
#pragma unroll
                for (int bj = 0; bj < 2; ++bj) { const int n = u.pn * 256 + 128 * bj + 32 * wc + 8 * fq, j = n >> 4, o0 = n & 15;
                    f32x4 a = acc[ai][bj][m][0], b = acc[ai][bj][m][1];
#pragma unroll
                    for (int e = 0; e < 4; ++e) { a[e] = gelu_tanh(a[e]); b[e] = gelu_tanh(b[e]); }
                    *(uint4*)(YC + ((size_t)chunk * 32 + j) * 512 + g * 16 + o0) = pack8(a, b); } }
    }
};
template <class Epi, class Sched>
__device__ __forceinline__ void run_gemm(const Ctx& C, const bf16_t* A, const bf16_t* Bt, int N, int K, size_t za, size_t zb, const Sched& S, const Epi& E, int lda = 0, int ldb = 0) {
    __syncthreads();
    pg8::Gemm g{A, Bt, M, N, K, za, zb, lda ? lda : K, ldb ? ldb : K};
    pg8::gemm_phase<Epi, Sched, true, true>((LAS unsigned char*)C.lds, g, S, E);
}

#define LAYER_PTRS() const float* MODl = c_MOD + (size_t)l * 5 * 6144; const float* xin0 = l == 0 ? c_x_prompt : c_X; const float* xin1 = l == 0 ? c_x_sample : c_X + (size_t)NPROMPT * D; \
    unsigned char* wb = WS_ + W_WB + (size_t)l * WB_LAYER; (void)MODl; (void)xin0; (void)xin1; (void)wb
__device__ __forceinline__ void g_norm1(const Ctx& C0, int l) { PHASE_CTX(C0); LAYER_PTRS(); if (l == 0) ph_norm(C, c_x_prompt, c_x_sample, false, c_norm1_g + l * 1024, MODl, 0); else ph_norm(C, WSP(bf16_t, W_XB0), WSP(bf16_t, W_XB1), true, c_norm1_g + l * 1024, MODl, 0); }
__device__ __forceinline__ void g_norm2(const Ctx& C0, int l) { PHASE_CTX(C0); LAYER_PTRS(); ph_norm(C, WSP(bf16_t, W_XB0), WSP(bf16_t, W_XB1), true, c_norm2_g + l * 1024, MODl, 1); }
__device__ __forceinline__ void g_inproj(const Ctx& C0, int l) { PHASE_CTX(C0); LAYER_PTRS();
    EpiIn e{WS_, OUT_, c_qn_g + l * 64, c_kn_g + l * 64, l, 0}; pg8::StaticOrder S; S.init(M, 3840, C.G, C.bid);
    run_gemm(C, c_XN, (const bf16_t*)(wb + WB_WI), 3840, 1024, 0, 0, S, e); }
__device__ __forceinline__ void g_s5a(const Ctx& C0, int l) { PHASE_CTX(C0);
    EpiHloc e{WSP(float, W_HLOC)}; ZOrder S{32, 2, 1, C.G, C.bid};
    run_gemm(C, WSP(bf16_t, W_UH), (const bf16_t*)(s5_tab(WS_, l) + TAB_TE), 256, 512, (size_t)512 * 768 * 2, TE_BYTES, S, e, 768, 512); }
__device__ __forceinline__ void g_s5c(const Ctx& C0, int l) { PHASE_CTX(C0);
    EpiS5Y e{c_YF}; ZOrder S{32, 2, 2, C.G, C.bid};
    run_gemm(C, WSP(bf16_t, W_UH), (const bf16_t*)(s5_tab(WS_, l) + TAB_TC), 512, 768, (size_t)512 * 768 * 2, TC_BYTES, S, e, 768, 768); }
__device__ __forceinline__ void g_glu(const Ctx& C0, int l) { PHASE_CTX(C0); LAYER_PTRS();
    EpiGlu e{c_OC, c_s5_b_glu + (size_t)l * 1024}; pg8::StaticOrder S; S.init(M, 1024, C.G, C.bid);
    run_gemm(C, c_YF, (const bf16_t*)(wb + WB_WG), 1024, 512, 0, 0, S, e); }
__device__ __forceinline__ void g_gates(const Ctx& C0, int l) { PHASE_CTX(C0); LAYER_PTRS();
    EpiGate e{c_GATES}; pg8::StaticOrder S; S.init(M, 3072, C.G, C.bid);
    run_gemm(C, c_XN, (const bf16_t*)(wb + WB_WZ), 3072, 1024, 0, 0, S, e); }
__device__ __forceinline__ void g_branch(const Ctx& C0, int l) { PHASE_CTX(C0); LAYER_PTRS();
    EpiBranch e{c_GATES, c_MERGED}; BranchOrder S; S.S.init(M, 1024, C.G, C.bid);
    run_gemm(C, c_OA, (const bf16_t*)(wb + WB_WR), 1024, 512, (size_t)M * 512 * 2, (size_t)1024 * 512 * 2, S, e); }
__device__ __forceinline__ void g_out(const Ctx& C0, int l) { PHASE_CTX(C0); LAYER_PTRS();
    EpiRes e{WSP(bf16_t, W_XB0), WSP(bf16_t, W_XB1), WSP(bf16_t, W_XB0), WSP(bf16_t, W_XB1), MODl + 2048, 1, 1};
    if (l == 0) { e.x0 = c_x_prompt; e.x1 = c_x_sample; e.in_bf16 = 0; }
    pg8::StaticOrder S; S.init(M, 1024, C.G, C.bid);
    run_gemm(C, c_MERGED, (const bf16_t*)(wb + WB_WO), 1024, 1024, 0, 0, S, e); }
__device__ __forceinline__ void g_ffn(const Ctx& C0, int l) { PHASE_CTX(C0); LAYER_PTRS();
    EpiFfn e{c_H}; FfnOrder S; S.S.init(M, 5632, C.G, C.bid);
    run_gemm(C, c_XN, (const bf16_t*)(wb + WB_WU), 5632, 1024, 0, 0, S, e); }
__device__ __forceinline__ void g_down(const Ctx& C0, int l) { PHASE_CTX(C0); LAYER_PTRS();
    EpiRes e{WSP(bf16_t, W_XB0), WSP(bf16_t, W_XB1), WSP(bf16_t, W_XB0), WSP(bf16_t, W_XB1), MODl + 5120, 1, 1};
    if (l == 1) { e.o0 = c_X; e.o1 = c_X + (size_t)NPROMPT * D; e.out_bf16 = 0; }
    pg8::StaticOrder S; S.init(M, 1024, C.G, C.bid);
    run_gemm(C, c_H, (const bf16_t*)(wb + WB_WD), 1024, FFN, 0, 0, S, e); }

__global__ void __launch_bounds__(NT, 2) mk_fwd(Params P_unused) {
    extern __shared__ __attribute__((aligned(16))) unsigned char lds[];
    Ctx C;
    C.lds = lds; C.tid = threadIdx.x; C.lane = C.tid & 63; C.wave = __builtin_amdgcn_readfirstlane(C.tid >> 6); C.G = gridDim.x; C.bid = blockIdx.x;
    volatile LAS unsigned* MISCL = (volatile LAS unsigned*)((LAS unsigned char*)lds + LDS_MISC);
    if (C.tid < 64) MISCL[C.tid] = 0u;
    __syncthreads();
    XcdBarrier bar;
    { KArgPtr Pk = kargs(); bar = xcd_barrier_post((unsigned*)(WS_ + W_CTL) + 1024, MISCL + 8); }
#define GRID_BAR() xcd_barrier(bar)

#ifndef DUP
#define DUP -1
#endif
#define RUN(id, stmt) do { stmt; if (DUP == (id)) { stmt; } } while (0)
    RUN(0, ph_s5_tables<0>(C); ph_mod(C); ph_prep(C); ph_wconv(C));
    if (DUP == 30) ph_s5_tables<0>(C); if (DUP == 31) ph_mod(C); if (DUP == 32) ph_wconv(C);
    GRID_BAR();
#pragma unroll 1
    for (int l0 = 0; l0 < 2; ++l0) {
        const int l = launder_s(l0);
        if (l == 0) { RUN(33, ph_s5_tables<1>(C)); }
        RUN(1, g_norm1(C, l));
        GRID_BAR();
        RUN(2, g_inproj(C, l)); ph_cache(C, l, C.G - C.G / 4);
        GRID_BAR();
        RUN(3, ph_gla_prep(C, l)); RUN(4, g_s5a(C, l));
        GRID_BAR();
        RUN(5, ph_gla_scan(C, l)); RUN(6, ph_s5_scan(C, l)); RUN(7, ph_attn(C, l, 256, 512)); if (DUP == 16) ph_attn(C, l, 0, 256); if (DUP == 17) ph_attn(C, l, 256, 512);
        if (DUP >= 21 && DUP <= 26) ph_attn<DUP - 20>(C, l, 256, 512);
        GRID_BAR();
        RUN(8, ph_gla_out(C, l)); RUN(9, g_s5c(C, l));
        if (C.G == 256) { __syncthreads(); ph_attn(C, l, 0, 256, 128); } else ph_attn(C, l, 0, 256);
        GRID_BAR();
        RUN(10, g_glu(C, l)); RUN(11, g_gates(C, l));
        GRID_BAR();
        RUN(12, g_branch(C, l));
        GRID_BAR();
        g_out(C, l);
        GRID_BAR();
        RUN(13, g_norm2(C, l));
        GRID_BAR();
        RUN(14, g_ffn(C, l));
        GRID_BAR();
        g_down(C, l);
        GRID_BAR();
        if (DUP == 15) { for (int q = 0; q < 10; ++q) GRID_BAR(); }
    }
}

extern "C" void kernel_launch(void* const* d_in, const int* in_sizes, int n_in, void* d_out, int out_size, void* d_ws, size_t ws_size, hipStream_t stream) {
    static int grid = 0;
    if (grid == 0) {
        if (n_in != 35 || ws_size < W_END) { fprintf(stderr, "kernel_launch: unexpected n_in %d / ws %zu\n", n_in, ws_size); grid = -1; return; }
        int dev = 0, cus = 0, per_cu = 0;
        if (hipGetDevice(&dev) != hipSuccess || hipDeviceGetAttribute(&cus, hipDeviceAttributeMultiprocessorCount, dev) != hipSuccess) { grid = -1; return; }
        if (hipFuncSetAttribute((const void*)mk_fwd, hipFuncAttributeMaxDynamicSharedMemorySize, LDS_BYTES) != hipSuccess) { fprintf(stderr, "kernel_launch: hipFuncSetAttribute failed\n"); grid = -1; return; }
        if (hipOccupancyMaxActiveBlocksPerMultiprocessor(&per_cu, (const void*)mk_fwd, NT, LDS_BYTES) != hipSuccess || per_cu < 1) { fprintf(stderr, "kernel_launch: occupancy query says %d\n", per_cu); per_cu = 1; }
        (void)hipGetLastError();
        grid = cus;
    }
    if (grid < 0) return;
    (void)hipMemsetAsync((char*)d_ws + W_CTL, 0, CTL_BYTES, stream);
    Params p{};
    for (int i = 0; i < 35; ++i) p.in[i] = (const float*)d_in[i];
    p.out = (float*)d_out; p.ws = (unsigned char*)d_ws;
    hipLaunchKernelGGL(mk_fwd, dim3(grid), dim3(NT), LDS_BYTES, stream, p);
}
```

```cpp
#include <hip/hip_runtime.h>
#include <stdint.h>
#include <cstdio>

typedef unsigned short bf16_t;
typedef short bf16x8 __attribute__((ext_vector_type(8)));
typedef float f32x4 __attribute__((ext_vector_type(4)));
#define LAS __attribute__((address_space(3)))

constexpr int D = 1024, NPROMPT = 8192, M = 16384;
constexpr int SEQ = 256, DSEQ = 2048;
constexpr int IN_DIM = 6688, FFN = 2816;
constexpr float EPS = 1e-6f;
constexpr int C_AQ = 0, C_AK = 512, C_AV = 1024, C_BQ = 1536, C_BK = 1792, C_BV = 2048, C_BG = 2560, C_BR = 3072, C_CU = 3104, C_GZ = 3616;
constexpr int N_MIX = 3616;
constexpr size_t O_YP = 0, O_YS = 8388608, O_NK = 16777216, O_NV = 25165824, O_NG = 33554432, O_NS = 37748736;

constexpr size_t MiB = 1u << 20;
constexpr size_t W_CTL = 0, CTL_BYTES = 65536;
constexpr size_t W_MOD = 65536;
constexpr size_t W_MISC = 65536 + 262144;
constexpr size_t W_XN = 1 * MiB;
constexpr size_t W_AQ = 33 * MiB;
constexpr size_t W_AK = 49 * MiB;
constexpr size_t W_AV = 66 * MiB;
constexpr size_t W_BQ = 83 * MiB;
constexpr size_t W_BK = 91 * MiB;
constexpr size_t W_BV = 99 * MiB;
constexpr size_t W_BG = 115 * MiB;
constexpr size_t W_BR = 131 * MiB;
constexpr size_t W_CU = 133 * MiB;
constexpr size_t W_GF = 149 * MiB;
constexpr size_t W_GB = 165 * MiB;
constexpr size_t W_YF = 181 * MiB;
constexpr size_t W_OA = 197 * MiB;
constexpr size_t W_OB = 213 * MiB;
constexpr size_t W_OC = 229 * MiB;
constexpr size_t W_GATES = 245 * MiB;
constexpr size_t W_GDS = 149 * MiB;
constexpr size_t W_GLA = 245 * MiB;
constexpr size_t W_MERGED = 341 * MiB;
constexpr size_t W_H = 373 * MiB;
constexpr size_t W_MF = W_H;
constexpr size_t W_WB = 461 * MiB;
constexpr size_t WB_LAYER = 36 * MiB;
constexpr size_t WB_WI = 0, WB_WZ = WB_WI + 3840 * 1024 * 2, WB_WG = WB_WZ + 3072 * 1024 * 2, WB_WR = WB_WG + 1024 * 512 * 2, WB_WO = WB_WR + 3 * 1024 * 512 * 2,
                 WB_WU = WB_WO + 1024 * 1024 * 2, WB_WD = WB_WU + 5632 * 1024 * 2;
static_assert(WB_WD + 1024 * 2816 * 2 == WB_LAYER, "weight copy map");
constexpr size_t W_TAB0 = 373 * MiB;
constexpr size_t W_UH = 405 * MiB;
constexpr size_t W_HLOC = 429 * MiB;
constexpr size_t W_TAB1 = 533 * MiB;
constexpr size_t W_ATAB = 524288;
constexpr size_t W_KG = 565 * MiB;
constexpr size_t W_KAUX = 569 * MiB;
constexpr size_t W_XB0 = 133 * MiB;
constexpr size_t W_XB1 = 565 * MiB;
constexpr size_t W_END = 581 * MiB;

constexpr int NT = 512, NWAVE = 8;
constexpr int LDS_BYTES = 163840;
constexpr int LDS_MISC = 163840 - 256;

__device__ __forceinline__ float bf2f(bf16_t h) { return __uint_as_float((unsigned)h << 16); }
typedef float f32x2_t __attribute__((ext_vector_type(2)));
typedef __bf16 bf16x2_t __attribute__((ext_vector_type(2)));
__device__ __forceinline__ unsigned pk2(float lo, float hi) { const f32x2_t v = {lo, hi}; return __builtin_bit_cast(unsigned, __builtin_convertvector(v, bf16x2_t)); }
__device__ __forceinline__ unsigned pk2_valu(float lo, float hi) { unsigned r; asm("v_cvt_pk_bf16_f32 %0, %1, %2" : "=v"(r) : "v"(lo), "v"(hi)); return r; }
__device__ __forceinline__ bf16_t f2bf(float f) { return (bf16_t)(pk2(f, 0.f) & 0xffffu); }
__device__ __forceinline__ float shx(float v, int k, int lane) { return __builtin_bit_cast(float, __builtin_amdgcn_ds_bpermute((lane ^ k) << 2, __builtin_bit_cast(int, v))); }
__device__ __forceinline__ float xsum32(float v) { const auto rr = __builtin_amdgcn_permlane32_swap(__float_as_uint(v), __float_as_uint(v), false, false); return __uint_as_float(rr[0]) + __uint_as_float(rr[1]); }
__device__ __forceinline__ float sigmoidf_(float x) { return 1.f / (1.f + __expf(-x)); }
__device__ __forceinline__ float siluf_(float x) { return x / (1.f + __expf(-x)); }
__device__ __forceinline__ float gelu_tanh(float x) { return 0.5f * x * (1.f + tanhf(0.7978845608028654f * (x + 0.044715f * x * x * x))); }
__device__ __forceinline__ int cond_row(int m) { return m < NPROMPT ? 0 : 1 + ((m - NPROMPT) >> 11); }
__device__ __forceinline__ int krow_of(int m) { return m < NPROMPT ? m : NPROMPT + ((m - NPROMPT) >> 11) * 2304 + 256 + ((m - NPROMPT) & 2047); }

#define XB_TMO      128
#define XB_XCNT(j)  (256  + 64 * (j))
#define XB_XSUB(j)  (1280 + 64 * (j))
#define XB_XGEN(j)  (2304 + 64 * (j))
#define XB_TOP      3328
#define XB_TOPGEN   3392
#define XCD_BAR_WORDS 3456
#define XB_SPIN_CAP (1u << 18)
__device__ __forceinline__ unsigned xb_ld(unsigned* p)              { return __hip_atomic_load(p, __ATOMIC_RELAXED, __HIP_MEMORY_SCOPE_AGENT); }
__device__ __forceinline__ unsigned xb_add(unsigned* p, unsigned v) { return __hip_atomic_fetch_add(p, v, __ATOMIC_RELAXED, __HIP_MEMORY_SCOPE_AGENT); }
__device__ __forceinline__ unsigned xb_xcc_id() { return (unsigned)__builtin_amdgcn_s_getreg((3 << 11) | 20) & 0xFu; }
#define XB_SPIN(cond, bar) do { unsigned _sp = 0; while (cond) { __builtin_amdgcn_s_sleep(1); \
    if ((++_sp & 255u) == 0u) { if (xb_ld(&(bar)[XB_TMO])) break; if (_sp > XB_SPIN_CAP) { atomicAdd(&(bar)[XB_TMO], 1u); break; } } } } while (0)
struct XcdBarrier { unsigned* bar; unsigned x; volatile LAS unsigned* st; };
__device__ __forceinline__ XcdBarrier xcd_barrier_post(unsigned* bar, volatile LAS unsigned* st) {
    XcdBarrier b; b.bar = bar; b.x = xb_xcc_id(); b.st = st;
    if (threadIdx.x == 0) (void)xb_add(&bar[XB_XCNT(b.x)], 1u);
    return b;
}
__device__ __forceinline__ void xcd_barrier_complete(unsigned* bar, unsigned x, unsigned& nloc, unsigned& nx) {
    const unsigned G = gridDim.x * gridDim.y * gridDim.z;
    unsigned sum, cnt, mine, sp = 0u;
    for (;;) {
        sum = 0u; cnt = 0u; mine = 0u;
#pragma unroll
        for (unsigned j = 0; j < 16; ++j) { const unsigned c = xb_ld(&bar[XB_XCNT(j)]); sum += c; cnt += (c > 0u) ? 1u : 0u; mine = (j == x) ? c : mine; }
        if (sum == G) break;
        __builtin_amdgcn_s_sleep(1);
        if ((++sp & 255u) == 0u) { if (xb_ld(&bar[XB_TMO])) break; if (sp > XB_SPIN_CAP) { atomicAdd(&bar[XB_TMO], 1u); break; } }
    }
    nloc = mine > 0u ? mine : 1u; nx = cnt > 0u ? cnt : 1u;
}
__device__ __forceinline__ void xcd_barrier(const XcdBarrier& b) {
    asm volatile("s_waitcnt vmcnt(0)" ::: "memory");
    __syncthreads();
    if (threadIdx.x == 0) {
        unsigned* bar = b.bar; asm volatile("" : "+s"(bar));
        unsigned bx = b.x; asm volatile("" : "+s"(bx));
        __builtin_amdgcn_s_waitcnt(0);
        unsigned nloc = b.st[0], nx = b.st[1];
        if (nloc == 0u) { xcd_barrier_complete(bar, bx, nloc, nx); b.st[0] = nloc; b.st[1] = nx; }
        const unsigned old = xb_add(&bar[XB_XSUB(bx)], 1u);
        const unsigned gen = old / nloc;
        if (old + 1u == (gen + 1u) * nloc) {
            __builtin_amdgcn_fence(__ATOMIC_RELEASE, "agent");
            asm volatile("s_waitcnt vmcnt(0)" ::: "memory");
            const unsigned og = xb_add(&bar[XB_TOP], 1u);
            const unsigned tg = og / nx;
            if (og + 1u == (tg + 1u) * nx) xb_add(&bar[XB_TOPGEN], 1u);
            else XB_SPIN(xb_ld(&bar[XB_TOPGEN]) == tg, bar);
            __builtin_amdgcn_fence(__ATOMIC_ACQUIRE, "agent");
            xb_add(&bar[XB_XGEN(bx)], 1u);
            asm volatile("s_waitcnt vmcnt(0)" ::: "memory");
        } else {
            XB_SPIN(xb_ld(&bar[XB_XGEN(bx)]) == gen, bar);
            __builtin_amdgcn_fence(__ATOMIC_ACQUIRE, "agent");
            asm volatile("s_waitcnt vmcnt(0)" ::: "memory");
        }
    }
    __syncthreads();
}

__device__ __forceinline__ int launder_v(int x) { asm volatile("" : "+v"(x)); return x; }
__device__ __forceinline__ int launder_s(int x) { asm volatile("" : "+s"(x)); return x; }
struct Params { const float* in[35]; float* out; unsigned char* ws; };
struct Ctx {
    unsigned char* lds;
    int tid, lane, wave, G, bid;
};
typedef const __attribute__((address_space(4))) Params* KArgPtr;
__device__ __forceinline__ KArgPtr kargs() { KArgPtr p = (KArgPtr)__builtin_amdgcn_kernarg_segment_ptr(); asm volatile("" : "+s"(p)); return p; }
#define PHASE_CTX(C0) KArgPtr Pk = kargs(); Ctx C = (C0); C.tid = launder_v(C0.tid); C.lane = C.tid & 63; C.wave = __builtin_amdgcn_readfirstlane(C.tid >> 6); C.bid = launder_s(C0.bid)
#define GAS __attribute__((address_space(1)))
#define IN_(i) ((const float*)(GAS const float*)(Pk->in[i]))
#define WS_ ((unsigned char*)(GAS unsigned char*)(Pk->ws))
#define OUT_ ((float*)(GAS float*)(Pk->out))
#define WSP(T, off) ((T*)(WS_ + (off)))
#define c_x_prompt IN_(0)
#define c_x_sample IN_(1)
#define c_cache_k IN_(2)
#define c_cache_v IN_(3)
#define c_state_gla IN_(4)
#define c_state_s5 IN_(5)
#define c_c IN_(6)
#define c_c_ctx IN_(7)
#define c_w_mod IN_(8)
#define c_b_mod IN_(9)
#define c_norm1_g IN_(10)
#define c_norm2_g IN_(11)
#define c_w_in IN_(12)
#define c_qn_g IN_(13)
#define c_kn_g IN_(14)
#define c_diff_lam IN_(15)
#define c_subln_g IN_(16)
#define c_gla_wa2 IN_(17)
#define c_gla_ba IN_(18)
#define c_gla_on_g IN_(19)
#define c_s5_lam_re IN_(20)
#define c_s5_lam_im IN_(21)
#define c_s5_log_dt IN_(22)
#define c_s5_b_re IN_(23)
#define c_s5_b_im IN_(24)
#define c_s5_c_re IN_(25)
#define c_s5_c_im IN_(26)
#define c_s5_d IN_(27)
#define c_s5_w_glu IN_(28)
#define c_s5_b_glu IN_(29)
#define c_w_branch IN_(30)
#define c_w_out IN_(31)
#define c_w_gate IN_(32)
#define c_w_up IN_(33)
#define c_w_down IN_(34)
#define c_out OUT_
#define c_X (OUT_ + O_YP)
#define c_MOD WSP(float, W_MOD)
#define c_MISC WSP(float, W_MISC)
#define c_XN WSP(bf16_t, W_XN)
#define c_AQ WSP(bf16_t, W_AQ)
#define c_AK WSP(bf16_t, W_AK)
#define c_AV WSP(bf16_t, W_AV)
#define c_BQ WSP(bf16_t, W_BQ)
#define c_BK WSP(bf16_t, W_BK)
#define c_BV WSP(bf16_t, W_BV)
#define c_BG WSP(bf16_t, W_BG)
#define c_BR WSP(float, W_BR)
#define c_CU WSP(bf16_t, W_CU)
#define c_GF WSP(bf16_t, W_GF)
#define c_GB WSP(bf16_t, W_GB)
#define c_YF WSP(bf16_t, W_YF)
#define c_OA WSP(bf16_t, W_OA)
#define c_OB WSP(bf16_t, W_OB)
#define c_OC WSP(bf16_t, W_OC)
#define c_GATES WSP(bf16_t, W_GATES)
#define c_MERGED WSP(bf16_t, W_MERGED)
#define c_H WSP(bf16_t, W_H)

__device__ __forceinline__ void ph_mod(const Ctx& C0) {
    PHASE_CTX(C0);
    float (*sc)[1024] = (float (*)[1024])C.lds;
    float (*red)[5][64] = (float (*)[5][64])(C.lds + 5 * 1024 * 4);
    for (int item = C.bid; item < 192; item += C.G) {
        const int l = item / 96, n0 = (item % 96) * 64, tid = C.tid;
        __syncthreads();
        for (int i = tid; i < 5 * 1024; i += NT) { const int r = i >> 10, k = i & 1023; const float v = r == 0 ? c_c_ctx[k] : c_c[(r - 1) * 1024 + k]; sc[r][k] = siluf_(v); }
        __syncthreads();
        const int cn = tid & 63, ks = tid >> 6;
        float acc[5] = {0.f, 0.f, 0.f, 0.f, 0.f};
        const float* w = c_w_mod + (size_t)l * 1024 * 6144 + n0 + cn;
        for (int k = ks * 128; k < ks * 128 + 128; ++k) { const float wv = w[(size_t)k * 6144];
#pragma unroll
            for (int r = 0; r < 5; ++r) acc[r] += sc[r][k] * wv; }
#pragma unroll
        for (int r = 0; r < 5; ++r) red[ks][r][cn] = acc[r];
        __syncthreads();
        if (tid < 320) { const int r = tid >> 6, cc = tid & 63; float s = 0.f;
#pragma unroll
            for (int k8 = 0; k8 < 8; ++k8) s += red[k8][r][cc];
            c_MOD[((size_t)l * 5 + r) * 6144 + n0 + cc] = s + c_b_mod[(size_t)l * 6144 + n0 + cc]; }
    }
}
__device__ __forceinline__ void ph_prep(const Ctx& C0) {
    PHASE_CTX(C0);
    if (C.bid != C.G - 1) return;
    const int tid = C.tid; float* misc = c_MISC;
    if (tid < 2) {
        const float* lv = c_diff_lam + tid * 256; float s01 = 0.f, s23 = 0.f;
        for (int i = 0; i < 64; ++i) { s01 += lv[i] * lv[64 + i]; s23 += lv[128 + i] * lv[192 + i]; }
        const float lam_init = 0.8f - 0.6f * expf(-0.3f * (float)tid);
        misc[tid] = expf(s01) - expf(s23) + lam_init;
    }
    for (int i = tid; i < 64 * 16; i += NT) {
        const int pos = i >> 4, f = i & 15;
        const float inv = powf(10000.f, -(float)(2 * f) / 32.f);
        const float ang = (float)pos * inv;
        misc[64 + i] = cosf(ang); misc[64 + 1024 + i] = sinf(ang);
    }
}
__device__ __forceinline__ void ph_cache(const Ctx& C0, int l, int wg0 = 0) {
    PHASE_CTX(C0);
    if (C.bid < wg0) return;
#pragma unroll 4
    for (int i = (C.bid - wg0) * NT + C.tid; i < 4 * 256 * 128; i += (C.G - wg0) * NT) {
        const int col = (i & 127) * 4, j = (i >> 7) & 255, b = i >> 15;
        const size_t src = ((size_t)(b * 2 + l) * 256 + j) * 512 + col;
        const size_t dst = (size_t)(NPROMPT + b * 2304 + j) * 512 + col;
        const f32x4 kx = *(const f32x4*)(c_cache_k + src), vx = *(const f32x4*)(c_cache_v + src);
        uint2 ko, vo; ko.x = pk2(kx[0], kx[1]); ko.y = pk2(kx[2], kx[3]); vo.x = pk2(vx[0], vx[1]); vo.y = pk2(vx[2], vx[3]);
        *(uint2*)(c_AK + dst) = ko; *(uint2*)(c_AV + dst) = vo;
    }
}
__device__ __forceinline__ void ph_norm(const Ctx& C0, const void* x0, const void* x1, bool in_bf16, const float* g, const float* MODl, int which) {
    PHASE_CTX(C0);
    const int lane = C.lane;
    for (int m = C.bid * NWAVE + C.wave; m < M; m += C.G * NWAVE) {
        const size_t ro = m < NPROMPT ? (size_t)m * D : (size_t)(m - NPROMPT) * D;
        const float* mod = MODl + (size_t)cond_row(m) * 6144 + which * 3072;
        float4 v[4]; float ss = 0.f;
        if (in_bf16) { const bf16_t* xr = (const bf16_t*)(m < NPROMPT ? x0 : x1) + ro;
#pragma unroll
            for (int j = 0; j < 4; ++j) { const uint2 w = *(const uint2*)(xr + j * 256 + lane * 4);
                v[j] = make_float4(__uint_as_float(w.x << 16), __uint_as_float(w.x & 0xffff0000u), __uint_as_float(w.y << 16), __uint_as_float(w.y & 0xffff0000u)); }
        } else { const float* xr = (const float*)(m < NPROMPT ? x0 : x1) + ro;
#pragma unroll
            for (int j = 0; j < 4; ++j) v[j] = *(const float4*)(xr + j * 256 + lane * 4); }
#pragma unroll
        for (int j = 0; j < 4; ++j) ss += v[j].x * v[j].x + v[j].y * v[j].y + v[j].z * v[j].z + v[j].w * v[j].w;
#pragma unroll
        for (int o = 1; o < 32; o <<= 1) ss += shx(ss, o, lane);
        ss = xsum32(ss);
        const float rs = rsqrtf(ss * (1.f / D) + EPS);
#pragma unroll
        for (int j = 0; j < 4; ++j) {
            const int c0 = j * 256 + lane * 4;
            const float4 gg = *(const float4*)(g + c0), sh = *(const float4*)(mod + c0), sc = *(const float4*)(mod + 1024 + c0);
            ushort4 o;
            o.x = f2bf(v[j].x * rs * gg.x * (1.f + sc.x) + sh.x); o.y = f2bf(v[j].y * rs * gg.y * (1.f + sc.y) + sh.y);
            o.z = f2bf(v[j].z * rs * gg.z * (1.f + sc.z) + sh.z); o.w = f2bf(v[j].w * rs * gg.w * (1.f + sc.w) + sh.w);
            *(ushort4*)(c_XN + (size_t)m * D + c0) = o;
        }
    }
}

typedef float f32x16 __attribute__((ext_vector_type(16)));
typedef short s16x4 __attribute__((ext_vector_type(4)));
typedef unsigned u32x4_t __attribute__((ext_vector_type(4)));
constexpr int AT_KROW = 72;
constexpr int AT_VROW = 68;
constexpr int AT_KBYTES = 2 * 64 * AT_KROW * 2, AT_VBYTES = 128 * AT_VROW * 2, AT_BUF = AT_KBYTES + AT_VBYTES;
__device__ __forceinline__ unsigned pk_bf16(float lo, float hi) { return pk2(lo, hi); }
template <int XM = 0>
__device__ __forceinline__ void ph_attn(const Ctx& C0, int l, int item_lo = 0, int item_hi = 512, int nwg = 0) {
    PHASE_CTX(C0);
    const int tid = C.tid, lane = C.lane, w = C.wave, map = w >> 2, qb = w & 3, r32 = lane & 31, hi = lane >> 5;
    unsigned char* lds = C.lds;
    const float* subg = c_subln_g + l * 128;
    const float lam = c_MISC[l];
    const bf16_t* AKp = c_AK; const bf16_t* AVp = c_AV;
    const int sk_key = tid >> 3, sk_ch = tid & 7;
    const int sv_kp = tid & 31, sv_ec = tid >> 5;
    constexpr int AT_NBUF = 3;
    constexpr float CS = 0.125f * 1.4426950408889634f;
    const int NW = nwg > 0 ? nwg : C.G;
    if (C.bid >= NW) return;
    const int vbid = (NW % 8 == 0) ? (C.bid & 7) * (NW / 8) + (C.bid >> 3) : C.bid;
    for (int item = item_lo + vbid; item < item_hi; item += NW) {
        int m0, kr0, Lk, h;
        if (item < 256) { const int b = item >> 3; h = (item >> 1) & 3; const int q2 = item & 1; m0 = b * 256 + q2 * 128; kr0 = b * 256; Lk = 256; }
        else { const int j = item - 256; const int b = j >> 6; h = (j >> 4) & 3; const int q2 = j & 15; m0 = NPROMPT + b * 2048 + q2 * 128; kr0 = NPROMPT + b * 2304; Lk = 2304; }
        const int NTL = Lk >> 6;
        bf16x8* sQ = (bf16x8*)(lds + AT_NBUF * AT_BUF) + (w * 4) * 64 + lane;
        f32x16 o[4];
#pragma unroll
        for (int eb = 0; eb < 4; ++eb)
#pragma unroll
            for (int r = 0; r < 16; ++r) o[eb][r] = 0.f;
        float mrun = -1e30f, lsum = 0.f, alpha = 1.f, mc = 0.f;
        uint4 kreg0, kreg1, vreg0, vreg1;
        unsigned pfw[16];
#define PF(ks_) __builtin_bit_cast(bf16x8, (u32x4_t){pfw[4 * (ks_)], pfw[4 * (ks_) + 1], pfw[4 * (ks_) + 2], pfw[4 * (ks_) + 3]})
        f32x16 pa0, pa1;
#define AT_LOAD(t_) do { const bf16_t* kp_ = AKp + (size_t)(kr0 + (t_) * 64 + sk_key) * 512 + h * 128 + sk_ch * 16; kreg0 = *(const uint4*)kp_; kreg1 = *(const uint4*)(kp_ + 8); \
            const bf16_t* vp_ = AVp + (size_t)(kr0 + (t_) * 64 + 2 * sv_kp) * 512 + h * 128 + sv_ec * 8; vreg0 = *(const uint4*)vp_; vreg1 = *(const uint4*)(vp_ + 512); } while (0)
#define AT_WRITE(t_) do { unsigned char* wb_ = lds + ((t_) % AT_NBUF) * AT_BUF; \
            bf16_t* kd_ = (bf16_t*)wb_ + ((sk_ch >> 2) * 64 + sk_key) * AT_KROW + (sk_ch & 3) * 16; *(uint4*)kd_ = kreg0; *(uint4*)(kd_ + 8) = kreg1; \
            bf16_t* vt_ = (bf16_t*)(wb_ + AT_KBYTES) + (sv_ec * 8) * AT_VROW + 2 * sv_kp; \
            const unsigned a_[4] = {vreg0.x, vreg0.y, vreg0.z, vreg0.w}, b_[4] = {vreg1.x, vreg1.y, vreg1.z, vreg1.w}; \
            _Pragma("unroll") for (int i = 0; i < 4; ++i) { *(unsigned*)(vt_ + (2 * i) * AT_VROW) = (a_[i] & 0xffffu) | (b_[i] << 16); *(unsigned*)(vt_ + (2 * i + 1) * AT_VROW) = (a_[i] >> 16) | (b_[i] & 0xffff0000u); } } while (0)
#define SB() __builtin_amdgcn_sched_barrier(0)
#define AT_M(P0, P1) do { asm volatile("s_nop 15\n\ts_nop 7" : "+v"(P0), "+v"(P1)); float mt_ = -1e30f; \
            _Pragma("unroll") for (int r = 0; r < 16; ++r) asm("v_max3_f32 %0, %1, %2, %3" : "=v"(mt_) : "v"(mt_), "v"(P0[r]), "v"(P1[r])); \
            { const auto rr_ = __builtin_amdgcn_permlane32_swap(__float_as_uint(mt_), __float_as_uint(mt_), false, false); asm("v_max_f32_e32 %0, %1, %2" : "=v"(mt_) : "v"(__uint_as_float(rr_[0])), "v"(__uint_as_float(rr_[1]))); } \
            float mn_; asm("v_max_f32_e32 %0, %1, %2" : "=v"(mn_) : "v"(mrun), "v"(mt_)); \
            alpha = __builtin_amdgcn_exp2f((mrun - mn_) * CS); mrun = mn_; mc = -mn_ * CS; } while (0)
#define AT_EXP2(P, i_) do { if (XM == 2) { P[i_] = __builtin_fmaf(P[i_], CS, mc); P[(i_) + 1] = __builtin_fmaf(P[(i_) + 1], CS, mc); } else { P[i_] = __builtin_amdgcn_exp2f(__builtin_fmaf(P[i_], CS, mc)); P[(i_) + 1] = __builtin_amdgcn_exp2f(__builtin_fmaf(P[(i_) + 1], CS, mc)); } \
            asm volatile("" : "+v"(P[i_]), "+v"(P[(i_) + 1])); } while (0)
#define AT_X(HASV, tv_, P0, P1) do { const bf16_t* sVt_ = (const bf16_t*)(lds + ((tv_) % AT_NBUF) * AT_BUF + AT_KBYTES) + r32 * AT_VROW + 4 * hi; \
            _Pragma("unroll") for (int eb = 0; eb < 4; ++eb) { s16x4 vl_[4], vh_[4]; \
                if (HASV) { _Pragma("unroll") for (int ks = 0; ks < 4; ++ks) { vl_[ks] = *(const s16x4*)(sVt_ + eb * 32 * AT_VROW + ks * 16); vh_[ks] = *(const s16x4*)(sVt_ + eb * 32 * AT_VROW + ks * 16 + 8); } SB(); } \
                _Pragma("unroll") for (int ks = 0; ks < 4; ++ks) { \
                    if (HASV) { const bf16x8 vf_ = __builtin_shufflevector(vl_[ks], vh_[ks], 0, 1, 2, 3, 4, 5, 6, 7); o[eb] = __builtin_amdgcn_mfma_f32_32x32x16_bf16(vf_, PF(ks), o[eb], 0, 0, 0); } \
                    if (eb < 2) AT_EXP2(P0, eb * 8 + ks * 2); else AT_EXP2(P1, (eb - 2) * 8 + ks * 2); SB(); } } } while (0)
#define AT_Q(t_, P0, P1) do { const bf16_t* sKm_ = (const bf16_t*)(lds + ((t_) % AT_NBUF) * AT_BUF) + (map * 64) * AT_KROW + r32 * AT_KROW + hi * 8; \
            bf16x8 kf0_[4], kf1_[4], qf_[4]; \
            _Pragma("unroll") for (int s4 = 0; s4 < 4; ++s4) { qf_[s4] = sQ[s4 * 64]; kf0_[s4] = *(const bf16x8*)(sKm_ + s4 * 16); kf1_[s4] = *(const bf16x8*)(sKm_ + 32 * AT_KROW + s4 * 16); } \
            _Pragma("unroll") for (int r = 0; r < 16; ++r) { P0[r] = 0.f; P1[r] = 0.f; } SB(); \
            _Pragma("unroll") for (int s4 = 0; s4 < 4; ++s4) { P0 = __builtin_amdgcn_mfma_f32_32x32x16_bf16(kf0_[s4], qf_[s4], P0, 0, 0, 0); P1 = __builtin_amdgcn_mfma_f32_32x32x16_bf16(kf1_[s4], qf_[s4], P1, 0, 0, 0); } } while (0)
#define AT_S(P0, P1) do { float ps_ = 0.f; \
            _Pragma("unroll") for (int c = 0; c < 4; ++c) { ps_ += (P0[4 * c] + P0[4 * c + 1]) + (P0[4 * c + 2] + P0[4 * c + 3]) + (P1[4 * c] + P1[4 * c + 1]) + (P1[4 * c + 2] + P1[4 * c + 3]); \
                pfw[4 * (c >> 1) + (c & 1) * 2] = pk2_valu(P0[4 * c], P0[4 * c + 1]); pfw[4 * (c >> 1) + (c & 1) * 2 + 1] = pk2_valu(P0[4 * c + 2], P0[4 * c + 3]); \
                pfw[8 + 4 * (c >> 1) + (c & 1) * 2] = pk2_valu(P1[4 * c], P1[4 * c + 1]); pfw[8 + 4 * (c >> 1) + (c & 1) * 2 + 1] = pk2_valu(P1[4 * c + 2], P1[4 * c + 3]); } \
            lsum += ps_; } while (0)
#define AT_RESCALE() do { if (__any(alpha != 1.f)) { lsum *= alpha; _Pragma("unroll") for (int eb = 0; eb < 4; ++eb) _Pragma("unroll") for (int r = 0; r < 16; ++r) o[eb][r] *= alpha; } } while (0)
#define AT_STEP(t_) do { \
            if (XM != 5) { AT_Q(t_, pa0, pa1); } AT_M(pa0, pa1); \
            if ((t_) > 0 && XM != 3) { AT_X(true, (t_) - 1, pa0, pa1); } else { AT_X(false, 0, pa0, pa1); } \
            AT_RESCALE(); AT_S(pa0, pa1); \
            if (XM != 6) __syncthreads();                        \
            if ((t_) + 2 < NTL && XM != 4) { AT_WRITE((t_) + 2); if ((t_) + 3 < NTL) AT_LOAD((t_) + 3); } } while (0)
        { const bf16_t* qp = c_AQ + (size_t)(m0 + qb * 32 + r32) * 512 + h * 128 + map * 64 + hi * 8;
#pragma unroll
          for (int s4 = 0; s4 < 4; ++s4) sQ[s4 * 64] = *(const bf16x8*)(qp + s4 * 16); }
        AT_LOAD(0);
        __syncthreads();
        AT_WRITE(0); AT_LOAD(1); AT_WRITE(1); AT_LOAD(2);
        __syncthreads();
        AT_STEP(0); alpha = 1.f;
#pragma unroll 1
        for (int t = 1; t < NTL; ++t) { AT_STEP(t); }
        { const bf16_t* sVt_ = (const bf16_t*)(lds + ((NTL - 1) % AT_NBUF) * AT_BUF + AT_KBYTES) + r32 * AT_VROW + 4 * hi;
#pragma unroll
          for (int eb = 0; eb < 4; ++eb)
#pragma unroll
              for (int ks = 0; ks < 4; ++ks) { const s16x4 lo = *(const s16x4*)(sVt_ + eb * 32 * AT_VROW + ks * 16), hv = *(const s16x4*)(sVt_ + eb * 32 * AT_VROW + ks * 16 + 8);
                  o[eb] = __builtin_amdgcn_mfma_f32_32x32x16_bf16(__builtin_shufflevector(lo, hv, 0, 1, 2, 3, 4, 5, 6, 7), PF(ks), o[eb], 0, 0, 0); } }
#undef PF
#undef AT_Q
#undef AT_S
#undef AT_LOAD
#undef AT_WRITE
#undef SB
#undef AT_M
#undef AT_EXP2
#undef AT_X
#undef AT_RESCALE
#undef AT_STEP
        lsum = xsum32(lsum);
        const float inv = 1.f / lsum;
        __syncthreads();
        float* xb = (float*)lds + (size_t)qb * (32 * 129);
        if (map == 1) {
#pragma unroll
            for (int eb = 0; eb < 4; ++eb)
#pragma unroll
                for (int r = 0; r < 16; ++r) xb[r32 * 129 + eb * 32 + (r & 3) + 8 * (r >> 2) + 4 * hi] = o[eb][r] * inv;
        }
        __syncthreads();
        if (map == 0 && (XM == 0 || lsum == 12345.678f)) {
            float ss = 0.f;
#pragma unroll
            for (int eb = 0; eb < 4; ++eb)
#pragma unroll
                for (int r = 0; r < 16; ++r) { const float d = o[eb][r] * inv - lam * xb[r32 * 129 + eb * 32 + (r & 3) + 8 * (r >> 2) + 4 * hi]; o[eb][r] = d; ss += d * d; }
            ss = xsum32(ss);
            const float lam_init = 0.8f - 0.6f * __expf(-0.3f * (float)l);
            const float rs = rsqrtf(ss * (1.f / 128.f) + EPS) * (1.f - lam_init);
            bf16_t* op = c_OA + (size_t)(m0 + qb * 32 + r32) * 512 + h * 128;
#pragma unroll
            for (int eb = 0; eb < 4; ++eb)
#pragma unroll
                for (int r4 = 0; r4 < 4; ++r4) {
                    const int e0 = eb * 32 + 8 * r4 + 4 * hi;
                    uint2 wv;
                    wv.x = pk_bf16(o[eb][4 * r4] * rs * subg[e0], o[eb][4 * r4 + 1] * rs * subg[e0 + 1]);
                    wv.y = pk_bf16(o[eb][4 * r4 + 2] * rs * subg[e0 + 2], o[eb][4 * r4 + 3] * rs * subg[e0 + 3]);
                    *(uint2*)(op + e0) = wv;
                }
        }
    }
}

constexpr int GT = 64;
constexpr size_t G_QK = 0;
constexpr size_t G_KDT = 48 * MiB;
constexpr size_t G_VT = 64 * MiB;
constexpr size_t G_SST = 80 * MiB;
constexpr size_t G_DEC = 112 * MiB;
constexpr size_t G_CQB = 112 * MiB + 524288;
__device__ __forceinline__ void ph_gla_prep(const Ctx& C0, int l) {
    PHASE_CTX(C0);
    const int tid = C.tid, dir = tid >> 8, h = (tid >> 6) & 3, kc = tid & 63, c = h * 64 + kc;
    float* sBR = (float*)C.lds;
    float* sPre = (float*)(C.lds + 8192);
    unsigned char* gb = WS_ + W_GLA;
    float wa[16];
#pragma unroll
    for (int r = 0; r < 16; ++r) wa[r] = c_gla_wa2[(((size_t)l * 2 + dir) * 16 + r) * 256 + c];
    const float bias = c_gla_ba[((size_t)l * 2 + dir) * 256 + c];
    bf16_t* QA = (bf16_t*)(gb + G_QK + (size_t)(dir * 3 + 0) * 8 * MiB); bf16_t* KA = (bf16_t*)(gb + G_QK + (size_t)(dir * 3 + 1) * 8 * MiB);
    for (int gc = C.bid; gc < 256; gc += C.G) {
        const int m0 = gc * GT;
        __syncthreads();
        { const float4* src = (const float4*)(c_BR + (size_t)m0 * 32); ((float4*)sBR)[tid] = src[tid]; }
        __syncthreads();
        float run = 0.f;
#pragma unroll 4
        for (int t = 0; t < 64; ++t) {
            float x = bias;
#pragma unroll
            for (int r = 0; r < 16; ++r) x += sBR[t * 32 + dir * 16 + r] * wa[r];
            const float ls = fminf(x, 0.f) - __logf(1.f + __expf(-fabsf(x)));
            run += ls * (1.f / 16.f); sPre[t * 512 + tid] = run;
        }
        const float p31 = sPre[31 * 512 + tid], p63 = run;
        const float cqb = __expf(dir == 0 ? p31 : p63 - p31), ckd = __expf(dir == 0 ? p63 - p31 : p31);
        bf16_t* KDT = (bf16_t*)(gb + G_KDT) + ((((size_t)gc * 4 + h) * 2 + dir) * 64 + kc) * 64;
        const bf16_t* BQp = c_BQ; const bf16_t* BKp = c_BK;
        bf16_t qn[8], kn[8];
#pragma unroll
        for (int tt = 0; tt < 8; ++tt) { const size_t idx = (size_t)(m0 + tt) * 256 + c; qn[tt] = BQp[idx]; kn[tt] = BKp[idx]; }
#pragma unroll 1
        for (int t8 = 0; t8 < 8; ++t8) {
            unsigned kdw[4];
            bf16_t qc[8], kc8[8];
#pragma unroll
            for (int tt = 0; tt < 8; ++tt) { qc[tt] = qn[tt]; kc8[tt] = kn[tt]; }
            { const int tn = t8 < 7 ? (t8 + 1) * 8 : 56;
#pragma unroll
              for (int tt = 0; tt < 8; ++tt) { const size_t idx = (size_t)(m0 + tn + tt) * 256 + c; qn[tt] = BQp[idx]; kn[tt] = BKp[idx]; } }
#pragma unroll
            for (int tt = 0; tt < 8; ++tt) {
                const int t = t8 * 8 + tt;
                const int te = dir == 0 ? t : t - 1;
                const float e = te < 0 ? 0.f : sPre[(te < 0 ? 0 : te) * 512 + tid];
                const float d = e - p31;
                const size_t idx = (size_t)(m0 + t) * 256 + c;
                const float qv = bf2f(qc[tt]), kv = bf2f(kc8[tt]);
                const float ed = __expf(dir == 0 ? d : -d), eid = __expf(dir == 0 ? -d : d);
                QA[idx] = f2bf(qv * ed); KA[idx] = f2bf(kv * eid);
                const float kd = kv * eid * ckd;
                if (tt & 1) kdw[tt >> 1] |= (unsigned)f2bf(kd) << 16; else kdw[tt >> 1] = (unsigned)f2bf(kd);
            }
            *(uint4*)(KDT + t8 * 8) = make_uint4(kdw[0], kdw[1], kdw[2], kdw[3]);
        }
        ((float*)(gb + G_DEC))[(((size_t)gc * 4 + h) * 2 + dir) * 64 + kc] = __expf(p63);
        ((float*)(gb + G_CQB))[(((size_t)gc * 4 + h) * 2 + dir) * 64 + kc] = cqb;
        { const int hv = tid >> 7, vv = tid & 127; const bf16_t* BVp = c_BV;
          bf16_t* VT = (bf16_t*)(gb + G_VT) + (((size_t)gc * 4 + hv) * 128 + vv) * 64;
#pragma unroll 4
          for (int t8 = 0; t8 < 8; ++t8) { unsigned w4[4];
#pragma unroll
              for (int tt = 0; tt < 8; ++tt) { const unsigned x = BVp[(size_t)(m0 + t8 * 8 + tt) * 512 + hv * 128 + vv]; if (tt & 1) w4[tt >> 1] |= x << 16; else w4[tt >> 1] = x; }
              *(uint4*)(VT + t8 * 8) = make_uint4(w4[0], w4[1], w4[2], w4[3]); } }
        __syncthreads();
        { const int lane = C.lane, wv = C.wave, hh = wv >> 1, dd_ = wv & 1, r32 = lane & 31, hi = lane >> 5;
          const size_t cu = ((size_t)gc * 4 + hh) * 2 + dd_;
          const bf16_t* vtb = (const bf16_t*)(gb + G_VT) + ((size_t)gc * 4 + hh) * 128 * 64;
          const bf16_t* kdb = (const bf16_t*)(gb + G_KDT) + cu * 64 * 64;
          bf16_t* DS = WSP(bf16_t, W_GDS) + cu * 128 * 64;
#pragma unroll 2
          for (int t = 0; t < 8; ++t) { const int vb = t & 3, kb = t >> 2;
              f32x16 acc;
#pragma unroll
              for (int r = 0; r < 16; ++r) acc[r] = 0.f;
              bf16x8 a4[4], b4[4];
#pragma unroll
              for (int s4 = 0; s4 < 4; ++s4) { a4[s4] = *(const bf16x8*)(vtb + (size_t)(vb * 32 + r32) * 64 + s4 * 16 + hi * 8); b4[s4] = *(const bf16x8*)(kdb + (size_t)(kb * 32 + r32) * 64 + s4 * 16 + hi * 8); }
#pragma unroll
              for (int s4 = 0; s4 < 4; ++s4) acc = __builtin_amdgcn_mfma_f32_32x32x16_bf16(a4[s4], b4[s4], acc, 0, 0, 0);
#pragma unroll
              for (int r = 0; r < 16; ++r) DS[(size_t)(vb * 32 + (r & 3) + 8 * (r >> 2) + 4 * hi) * 64 + kb * 32 + r32] = f2bf(acc[r]); } }
    }
}
__device__ __forceinline__ int crow16(int r, int hi) { return (r & 3) + 8 * (r >> 2) + 4 * hi; }
__device__ __forceinline__ void ph_gla_scan(const Ctx& C0, int l) {
    PHASE_CTX(C0);
    const int tid = C.tid;
    unsigned char* gb = WS_ + W_GLA;
    const bf16_t* DSb = WSP(bf16_t, W_GDS);
    for (int task = C.bid; task < 576; task += C.G) {
        const int it = task < 64 ? 287 - (task >> 1) : (task - 64) >> 1, part = task & 1;
        const int dir = it & 1, h = (it >> 1) & 3, s = it >> 3;
        const bool latent = s >= 32;
        const int nch = latent ? 32 : 4, gc0 = latent ? 128 + (s - 32) * 32 : s * 4;
        const int v = part * 64 + (tid >> 3), kc0 = (tid & 7) * 8;
        float* sDec = (float*)C.lds; float* sCqb = sDec + 32 * 64;
        __syncthreads();
        for (int i = tid; i < nch * 64; i += NT) { const int n = i >> 6, kc = i & 63, gc = gc0 + (dir == 0 ? n : nch - 1 - n); const size_t cu = ((size_t)gc * 4 + h) * 2 + dir;
            sDec[i] = ((const float*)(gb + G_DEC))[cu * 64 + kc]; sCqb[i] = ((const float*)(gb + G_CQB))[cu * 64 + kc]; }
        float S[8];
        if (latent) { const float* si = c_state_gla + ((((size_t)(s - 32) * 2 + l) * 2 + dir) * 4 + h) * 8192 + v;
#pragma unroll
            for (int e = 0; e < 8; ++e) S[e] = si[(size_t)(kc0 + e) * 128]; }
        else {
#pragma unroll
            for (int e = 0; e < 8; ++e) S[e] = 0.f; }
        __syncthreads();
        const int nb = latent ? 16 : 4;
#pragma unroll 1
        for (int n0 = 0; n0 < nch; n0 += nb) {
            uint4 dsw[16];
#pragma unroll
            for (int b = 0; b < 16; ++b) if (b < nb) {
                const int gc = gc0 + (dir == 0 ? n0 + b : nch - 1 - n0 - b);
                const size_t cu = ((size_t)gc * 4 + h) * 2 + dir;
                dsw[b] = *(const uint4*)(DSb + (cu * 128 + v) * 64 + kc0); }
#pragma unroll
            for (int b = 0; b < 16; ++b) if (b < nb) {
                const int gc = gc0 + (dir == 0 ? n0 + b : nch - 1 - n0 - b);
                const size_t cu = ((size_t)gc * 4 + h) * 2 + dir;
                const f32x4 q0 = *(const f32x4*)(sCqb + (n0 + b) * 64 + kc0), q1 = *(const f32x4*)(sCqb + (n0 + b) * 64 + kc0 + 4), d0 = *(const f32x4*)(sDec + (n0 + b) * 64 + kc0), d1 = *(const f32x4*)(sDec + (n0 + b) * 64 + kc0 + 4);
                uint4 st; st.x = pk2(S[0] * q0[0], S[1] * q0[1]); st.y = pk2(S[2] * q0[2], S[3] * q0[3]); st.z = pk2(S[4] * q1[0], S[5] * q1[1]); st.w = pk2(S[6] * q1[2], S[7] * q1[3]);
                *(uint4*)((bf16_t*)(gb + G_SST) + (cu * 128 + v) * 64 + kc0) = st;
                const unsigned dw[4] = {dsw[b].x, dsw[b].y, dsw[b].z, dsw[b].w}; const float dc[8] = {d0[0], d0[1], d0[2], d0[3], d1[0], d1[1], d1[2], d1[3]};
#pragma unroll
                for (int q = 0; q < 4; ++q) { S[2 * q] = dc[2 * q] * S[2 * q] + __uint_as_float(dw[q] << 16); S[2 * q + 1] = dc[2 * q + 1] * S[2 * q + 1] + __uint_as_float(dw[q] & 0xffff0000u); }
            }
        }
        if (!latent) { float* so = c_out + O_NG + ((((size_t)s * 2 + l) * 2 + dir) * 4 + h) * 8192 + v;
#pragma unroll
            for (int e = 0; e < 8; ++e) so[(size_t)(kc0 + e) * 128] = S[e]; }
    }
}
__device__ __forceinline__ void ph_gla_out(const Ctx& C0, int l) {
    PHASE_CTX(C0);
    const int lane = C.lane, r32 = lane & 31, hi = lane >> 5;
    unsigned char* gb = WS_ + W_GLA;
    float* sO = (float*)C.lds + C.wave * (32 * 132);
    const float* ong = c_gla_on_g + l * 128;
    const bool bal = C.G == 256;
    const int nw = bal ? 1024 : C.G * NWAVE, wv = bal ? (C.bid - 128) * NWAVE + C.wave : C.bid * NWAVE + C.wave;
    if (bal && C.bid < 128) return;
    for (int task = wv; task < 2048; task += nw) {
        const int gc = task >> 3, h = (task >> 1) & 3, jb = task & 1, m0 = gc * GT;
        f32x16 o[4];
#pragma unroll
        for (int vq = 0; vq < 4; ++vq)
#pragma unroll
            for (int r = 0; r < 16; ++r) o[vq][r] = 0.f;
#pragma unroll
        for (int dir = 0; dir < 2; ++dir) {
            const bf16_t* QA = (const bf16_t*)(gb + G_QK + (size_t)(dir * 3 + 0) * 8 * MiB); const bf16_t* KA = (const bf16_t*)(gb + G_QK + (size_t)(dir * 3 + 1) * 8 * MiB);
            const size_t cu = ((size_t)gc * 4 + h) * 2 + dir;
            bf16x8 qf[4], kf[2][4];
            { const bf16_t* qp = QA + (size_t)(m0 + jb * 32 + r32) * 256 + h * 64 + hi * 8;
              const bf16_t* kp0 = KA + (size_t)(m0 + r32) * 256 + h * 64 + hi * 8; const bf16_t* kp1 = kp0 + (size_t)32 * 256;
#pragma unroll
              for (int s4 = 0; s4 < 4; ++s4) { qf[s4] = *(const bf16x8*)(qp + s4 * 16); kf[0][s4] = *(const bf16x8*)(kp0 + s4 * 16); kf[1][s4] = *(const bf16x8*)(kp1 + s4 * 16); } }
            const bf16_t* vtb = (const bf16_t*)(gb + G_VT) + (((size_t)gc * 4 + h) * 128 + r32) * 64 + 4 * hi;
            const bf16_t* stb = (const bf16_t*)(gb + G_SST) + (cu * 128 + r32) * 64 + hi * 8;
            s16x4 vlo[2][4], vhi[2][4]; bf16x8 sf[2][4];
#define GO_LOADV(b_, vq_) do { _Pragma("unroll") for (int s4 = 0; s4 < 4; ++s4) { vlo[b_][s4] = *(const s16x4*)(vtb + (size_t)(vq_) * 32 * 64 + s4 * 16); vhi[b_][s4] = *(const s16x4*)(vtb + (size_t)(vq_) * 32 * 64 + s4 * 16 + 8); sf[b_][s4] = *(const bf16x8*)(stb + (size_t)(vq_) * 32 * 64 + s4 * 16); } } while (0)
            GO_LOADV(0, 0);
            bf16x8 pf[4];
#pragma unroll
            for (int ib = 0; ib < 2; ++ib) {
                f32x16 p;
#pragma unroll
                for (int r = 0; r < 16; ++r) p[r] = 0.f;
#pragma unroll
                for (int s4 = 0; s4 < 4; ++s4) p = __builtin_amdgcn_mfma_f32_32x32x16_bf16(kf[ib][s4], qf[s4], p, 0, 0, 0);
                const int j = jb * 32 + r32;
#pragma unroll
                for (int r = 0; r < 16; ++r) { const int i = ib * 32 + crow16(r, hi); const bool keep = dir == 0 ? (i <= j) : (i >= j); if (!keep) p[r] = 0.f; }
#pragma unroll
                for (int s2 = 0; s2 < 2; ++s2) { union { bf16x8 v; unsigned u[4]; } a;
#pragma unroll
                    for (int q = 0; q < 4; ++q) a.u[q] = pk2(p[8 * s2 + 2 * q], p[8 * s2 + 2 * q + 1]);
                    pf[2 * ib + s2] = a.v; }
            }
#pragma unroll
            for (int vq = 0; vq < 4; ++vq) {
                if (vq < 3) GO_LOADV((vq + 1) & 1, vq + 1);
#pragma unroll
                for (int ks = 0; ks < 4; ++ks) { const bf16x8 vf = __builtin_shufflevector(vlo[vq & 1][ks], vhi[vq & 1][ks], 0, 1, 2, 3, 4, 5, 6, 7);
                    o[vq] = __builtin_amdgcn_mfma_f32_32x32x16_bf16(vf, pf[ks], o[vq], 0, 0, 0); }
#pragma unroll
                for (int s4 = 0; s4 < 4; ++s4) o[vq] = __builtin_amdgcn_mfma_f32_32x32x16_bf16(sf[vq & 1][s4], qf[s4], o[vq], 0, 0, 0);
            }
#undef GO_LOADV
        }
        float ss = 0.f;
#pragma unroll
        for (int vq = 0; vq < 4; ++vq)
#pragma unroll
            for (int r = 0; r < 16; ++r) ss += o[vq][r] * o[vq][r];
        ss = xsum32(ss);
        const float rs = rsqrtf(ss * (1.f / 128.f) + EPS);
#pragma unroll
        for (int vq = 0; vq < 4; ++vq)
#pragma unroll
            for (int q4 = 0; q4 < 4; ++q4) *(float4*)(sO + r32 * 132 + vq * 32 + 8 * q4 + 4 * hi) = make_float4(o[vq][4 * q4] * rs, o[vq][4 * q4 + 1] * rs, o[vq][4 * q4 + 2] * rs, o[vq][4 * q4 + 3] * rs);
        { const int j = lane >> 1, vc = (lane & 1) * 64; const float* row = sO + j * 132 + vc;
          const size_t off = (size_t)(m0 + jb * 32 + j) * 512 + h * 128 + vc;
          const bf16_t* BGp = c_BG + off; bf16_t* OBp = c_OB + off;
#pragma unroll
          for (int c8 = 0; c8 < 8; ++c8) {
              const float4 f0 = *(const float4*)(row + c8 * 8), f1 = *(const float4*)(row + c8 * 8 + 4);
              const uint4 gr = *(const uint4*)(BGp + c8 * 8); const float* og = ong + vc + c8 * 8;
              uint4 ow;
              ow.x = pk2(f0.x * og[0] * __uint_as_float(gr.x << 16), f0.y * og[1] * __uint_as_float(gr.x & 0xffff0000u));
              ow.y = pk2(f0.z * og[2] * __uint_as_float(gr.y << 16), f0.w * og[3] * __uint_as_float(gr.y & 0xffff0000u));
              ow.z = pk2(f1.x * og[4] * __uint_as_float(gr.z << 16), f1.y * og[5] * __uint_as_float(gr.z & 0xffff0000u));
              ow.w = pk2(f1.z * og[6] * __uint_as_float(gr.w << 16), f1.w * og[7] * __uint_as_float(gr.w & 0xffff0000u));
              *(uint4*)(OBp + c8 * 8) = ow; } }
    }
}

namespace pg8 {
#define PG8_LAS __attribute__((address_space(3)))
typedef unsigned short bf16_t;
typedef short bf16x8 __attribute__((ext_vector_type(8)));
typedef float f32x4 __attribute__((ext_vector_type(4)));
typedef unsigned u32x4 __attribute__((ext_vector_type(4)));
constexpr int BM = 256, BK = 64, HALF = 128, HTB = HALF * BK * 2  , STAGE_BYTES = 8 * HTB, NXCD = 8, WGM = 8;

__host__ __device__ __forceinline__ int lds_byte(int r, int c) { const int st = (r >> 4) * 2 + (c >> 5), rr = r & 15, cc = c & 31, ob = rr * 64 + cc * 2; return st * 1024 + (ob ^ (((ob >> 9) & 1) << 5)); }
__host__ __device__ __forceinline__ void stage_rc(int b, int& R, int& C) { const int st = b / 1024, sb = b % 1024, swz = sb ^ (((sb >> 9) & 1) << 5); R = (st >> 1) * 16 + swz / 64; C = (st & 1) * 32 + (swz % 64) / 2; }
__host__ __device__ __forceinline__ int perm32(int rho) { const int n = rho >> 4, i = rho & 15; return 8 * (i >> 2) + 4 * n + (i & 3); }

struct Unit { int pm, pn, z, h; };
struct Gemm { const bf16_t* A; const bf16_t* Bt; int M, N, K; size_t za, zb; int lda, ldb; };

struct StaticOrder {
    int nM, nN, nwg, G, c;
    __host__ __device__ void init(int M, int N, int G_, int c_) { nM = M / BM; nN = N / BM; nwg = nM * nN; G = G_; c = c_; }
    static constexpr bool HALF = false;
    __host__ __device__ void map(int L, Unit& u) const {
        int wgid = L; { const int q = nwg / NXCD, r = nwg % NXCD, xcd = wgid % NXCD, off = wgid / NXCD; wgid = (xcd < r ? xcd * (q + 1) : r * (q + 1) + (xcd - r) * q) + off; }
        const int nig = WGM * nN, gid = wgid / nig, fm = gid * WGM, gsz = (nM - fm) < WGM ? (nM - fm) : WGM;
        u.pm = fm + ((wgid % nig) % gsz); u.pn = (wgid % nig) / gsz; u.z = 0; u.h = 0;
    }
    __host__ __device__ bool next(int i, Unit& u) const {
        const long L = (long)i * G + c; if (L >= nwg) return false;
        map((int)L, u); return true;
    }
    __device__ __forceinline__ void a_ready(const Unit&) const {}
    __device__ __forceinline__ void done(const Unit&) const {}
};
__device__ __forceinline__ unsigned cvt_pk_bf16(float lo, float hi) { unsigned r; asm volatile("v_cvt_pk_bf16_f32 %0, %1, %2" : "=v"(r) : "v"(lo), "v"(hi)); return r; }
typedef float f32x2 __attribute__((ext_vector_type(2)));
template <class Epi, class Sched, bool ALIGN_EPI = false, bool SP2 = false>
__device__ __forceinline__ void gemm_phase(PG8_LAS unsigned char* lds, const Gemm g, const Sched& S, const Epi& E) {
    int tid_ = threadIdx.x; asm volatile("" : "+v"(tid_));
    const int tid = tid_, wid = __builtin_amdgcn_readfirstlane(tid >> 6), lane = tid & 63, wr = wid >> 2, wc = wid & 3, fr = lane & 15, fq = lane >> 4;
    const int K = g.K, nt = K / BK;
    unsigned voffA[2], voffB[2];
#pragma unroll
    for (int i = 0; i < 2; ++i) { int R, C; stage_rc(tid * 16 + i * 8192, R, C); const int Rb = Epi::PERM ? ((R & ~31) + perm32(R & 31)) : R;
        voffA[i] = (unsigned)(R * g.lda + C) * 2u; voffB[i] = (unsigned)(Rb * g.ldb + C) * 2u; }
    const size_t kstep = (size_t)(BK * 2);
    const size_t hstepA = (size_t)HALF * g.lda * 2, hstepB = (size_t)HALF * g.ldb * 2;
    const size_t tstepA = 2 * hstepA, tstepB = 2 * hstepB;
    const unsigned ldsw = (unsigned)wid * 1024u;
    const int aoff = lds_byte(wr * 64 + fr, fq * 8), boff = lds_byte(wc * 32 + fr, fq * 8);
#define PG8_SA(b, h) (((b) * 2 + (h)) * HTB)
#define PG8_SB(b, h) ((4 + (b) * 2 + (h)) * HTB)
#define PG8_STAGE(bufoff, gbase, voff) do { _Pragma("unroll") for (int _i = 0; _i < 2; ++_i) \
        __builtin_amdgcn_global_load_lds((const unsigned*)((const char*)(gbase) + (voff)[_i]), (PG8_LAS unsigned*)(lds + (bufoff) + ldsw + _i * 8192), 16, 0, 0); } while (0)
#define PG8_LDA(dst, b, h) do { _Pragma("unroll") for (int m = 0; m < 4; ++m) _Pragma("unroll") for (int k = 0; k < 2; ++k) dst[m][k] = *(const PG8_LAS bf16x8*)(lds + PG8_SA(b, h) + aoff + m * 2048 + k * 1024); } while (0)
#define PG8_LDB(dst, b, h) do { _Pragma("unroll") for (int n = 0; n < 2; ++n) _Pragma("unroll") for (int k = 0; k < 2; ++k) dst[n][k] = *(const PG8_LAS bf16x8*)(lds + PG8_SB(b, h) + boff + n * 2048 + k * 1024); } while (0)
#define PG8_MMA(ai, bj, At, Bt) do { __builtin_amdgcn_s_setprio(1); _Pragma("unroll") for (int m = 0; m < 4; ++m) _Pragma("unroll") for (int n = 0; n < 2; ++n) _Pragma("unroll") for (int k = 0; k < 2; ++k) \
        acc[ai][bj][m][n] = __builtin_amdgcn_mfma_f32_16x16x32_bf16(Bt[n][k], At[m][k], acc[ai][bj][m][n], 0, 0, 0); __builtin_amdgcn_s_setprio(0); } while (0)
#define PG8_WAIT_V(n) asm volatile("s_waitcnt vmcnt(" #n ")" ::: "memory")
#define PG8_WAIT_L(n) asm volatile("s_waitcnt lgkmcnt(" #n ")" ::: "memory")
#define PG8_BAR __builtin_amdgcn_s_barrier()
#define PG8_SCHED __builtin_amdgcn_sched_barrier(0)
    Unit cur, nxt; int ui = 0;
    if (!S.next(0, cur)) return;
    f32x4 acc[2][2][4][2];
#pragma unroll
    for (int a = 0; a < 2; ++a)
#pragma unroll
        for (int b = 0; b < 2; ++b)
#pragma unroll
            for (int m = 0; m < 4; ++m)
#pragma unroll
                for (int n = 0; n < 2; ++n) acc[a][b][m][n] = (f32x4){0.f, 0.f, 0.f, 0.f};
    bf16x8 At[4][2], B0[2][2], B1[2][2];
    const char* cA = (const char*)g.A + (size_t)cur.pm * tstepA + (size_t)cur.z * g.za; const char* cB = (const char*)g.Bt + (size_t)cur.pn * tstepB + (size_t)cur.z * g.zb;
    S.a_ready(cur);
    if constexpr (SP2) {
        PG8_STAGE(PG8_SB(0, 0), cB, voffB); PG8_STAGE(PG8_SB(0, 1), cB + hstepB, voffB); PG8_STAGE(PG8_SA(0, 0), cA, voffA); PG8_STAGE(PG8_SA(0, 1), cA + hstepA, voffA);
        if (wr == 1) PG8_BAR;
        PG8_WAIT_V(2); PG8_BAR;
        PG8_STAGE(PG8_SB(1, 0), cB + kstep, voffB); PG8_STAGE(PG8_SA(1, 0), cA + kstep, voffA); PG8_STAGE(PG8_SB(1, 1), cB + hstepB + kstep, voffB);
        PG8_WAIT_V(6); PG8_BAR;
    } else {
        PG8_STAGE(PG8_SB(0, 0), cB, voffB); PG8_STAGE(PG8_SA(0, 0), cA, voffA); PG8_STAGE(PG8_SB(0, 1), cB + hstepB, voffB); PG8_STAGE(PG8_SA(0, 1), cA + hstepA, voffA);
        if (wr == 1) PG8_BAR;
        PG8_WAIT_V(4); PG8_BAR;
        PG8_STAGE(PG8_SB(1, 0), cB + kstep, voffB); PG8_STAGE(PG8_SA(1, 0), cA + kstep, voffA); PG8_STAGE(PG8_SB(1, 1), cB + hstepB + kstep, voffB);
        PG8_WAIT_V(6); PG8_BAR;
    }
    for (;;) {
        const bool has_next = S.next(ui + 1, nxt);
        const char* nA = has_next ? (const char*)g.A + (size_t)nxt.pm * tstepA + (size_t)nxt.z * g.za : cA; const char* nB = has_next ? (const char*)g.Bt + (size_t)nxt.pn * tstepB + (size_t)nxt.z * g.zb : cB;
        for (int t = 0; t < nt; t += 2) {
            const bool last = (t == nt - 2);
            const char* a1 = cA + (size_t)(t + 1) * kstep;
            const char* a2 = last ? nA : cA + (size_t)(t + 2) * kstep; const char* b2 = last ? nB : cB + (size_t)(t + 2) * kstep;
            const char* a3 = a2 + kstep; const char* b3 = b2 + kstep;
            if (last && has_next) S.a_ready(nxt);
            if constexpr (SP2) {
            PG8_LDB(B0, 0, 0); PG8_LDB(B1, 0, 1); PG8_SCHED; PG8_LDA(At, 0, 0); PG8_STAGE(PG8_SA(1, 1), a1 + hstepA, voffA);
            PG8_WAIT_V(8); PG8_WAIT_L(0); PG8_BAR; if (!Sched::HALF || cur.h != 2) { PG8_MMA(0, 0, At, B0); PG8_MMA(0, 1, At, B1); } PG8_BAR; PG8_SCHED;
            PG8_LDA(At, 0, 1); PG8_STAGE(PG8_SB(0, 0), b2, voffB); PG8_STAGE(PG8_SB(0, 1), b2 + hstepB, voffB); PG8_STAGE(PG8_SA(0, 0), a2, voffA);
            PG8_WAIT_V(8); PG8_WAIT_L(0); PG8_BAR; if (!Sched::HALF || cur.h != 1) { PG8_MMA(1, 0, At, B0); PG8_MMA(1, 1, At, B1); } PG8_BAR; PG8_SCHED;
            PG8_LDB(B0, 1, 0); PG8_LDB(B1, 1, 1); PG8_SCHED; PG8_LDA(At, 1, 0); PG8_STAGE(PG8_SA(0, 1), a2 + hstepA, voffA);
            PG8_WAIT_V(8); PG8_WAIT_L(0); PG8_BAR; if (!Sched::HALF || cur.h != 2) { PG8_MMA(0, 0, At, B0); PG8_MMA(0, 1, At, B1); } PG8_BAR; PG8_SCHED;
            PG8_LDA(At, 1, 1); PG8_STAGE(PG8_SB(1, 0), b3, voffB); PG8_STAGE(PG8_SB(1, 1), b3 + hstepB, voffB); PG8_STAGE(PG8_SA(1, 0), a3, voffA);
            PG8_WAIT_V(8); PG8_WAIT_L(0); PG8_BAR; if (!Sched::HALF || cur.h != 1) { PG8_MMA(1, 0, At, B0); PG8_MMA(1, 1, At, B1); } PG8_BAR; PG8_SCHED;
            } else {
            PG8_LDB(B0, 0, 0); PG8_SCHED; PG8_LDA(At, 0, 0); PG8_STAGE(PG8_SA(1, 1), a1 + hstepA, voffA);
            PG8_WAIT_L(8); PG8_BAR; PG8_WAIT_L(0); PG8_MMA(0, 0, At, B0); PG8_BAR; PG8_SCHED;
            PG8_LDB(B1, 0, 1); PG8_STAGE(PG8_SB(0, 0), b2, voffB);
            PG8_BAR; PG8_WAIT_L(0); PG8_MMA(0, 1, At, B1); PG8_BAR;
            PG8_LDA(At, 0, 1); PG8_STAGE(PG8_SA(0, 0), a2, voffA);
            PG8_BAR; PG8_WAIT_L(0); PG8_MMA(1, 0, At, B0); PG8_BAR; PG8_SCHED;
            PG8_STAGE(PG8_SB(0, 1), b2 + hstepB, voffB);
            PG8_WAIT_V(6); PG8_BAR; PG8_MMA(1, 1, At, B1); PG8_BAR;
            PG8_LDB(B0, 1, 0); PG8_SCHED; PG8_LDA(At, 1, 0); PG8_STAGE(PG8_SA(0, 1), a2 + hstepA, voffA);
            PG8_WAIT_L(8); PG8_BAR; PG8_WAIT_L(0); PG8_MMA(0, 0, At, B0); PG8_BAR; PG8_SCHED;
            PG8_LDB(B1, 1, 1); PG8_STAGE(PG8_SB(1, 0), b3, voffB);
            PG8_BAR; PG8_WAIT_L(0); PG8_MMA(0, 1, At, B1); PG8_BAR;
            PG8_LDA(At, 1, 1); PG8_STAGE(PG8_SA(1, 0), a3, voffA);
            PG8_BAR; PG8_WAIT_L(0); PG8_MMA(1, 0, At, B0); PG8_BAR; PG8_SCHED;
            PG8_STAGE(PG8_SB(1, 1), b3 + hstepB, voffB);
            PG8_WAIT_V(6); PG8_BAR; PG8_MMA(1, 1, At, B1); PG8_BAR;
            }
        }
        if constexpr (ALIGN_EPI) { if (wr == 0) PG8_BAR; }
        if constexpr (!Epi::AFTER_DRAIN) { E(acc, cur, wr, wc, fr, fq); S.done(cur); }
        if (!has_next) break;
#pragma unroll
        for (int a = 0; a < 2; ++a)
#pragma unroll
            for (int b = 0; b < 2; ++b)
#pragma unroll
                for (int m = 0; m < 4; ++m)
#pragma unroll
                    for (int n = 0; n < 2; ++n) acc[a][b][m][n] = (f32x4){0.f, 0.f, 0.f, 0.f};
        cur = nxt; cA = nA; cB = nB; ++ui;
        if constexpr (ALIGN_EPI) { if (wr == 1) PG8_BAR; }
    }
    PG8_WAIT_V(0);
    if constexpr (!ALIGN_EPI) { if (wr == 0) PG8_BAR; }
    PG8_BAR;
    if constexpr (Epi::AFTER_DRAIN) { E.fused(acc, cur, wr, wc, fr, fq, lds, wid, lane); S.done(cur); }
#undef PG8_SA
#undef PG8_SB
#undef PG8_STAGE
#undef PG8_LDA
#undef PG8_LDB
#undef PG8_MMA
#undef PG8_WAIT_V
#undef PG8_WAIT_L
#undef PG8_BAR
#undef PG8_SCHED
}
}

__device__ __forceinline__ void wconv_item(const float* W, int ld, int col0, int k0, bf16_t* WT, int K, int drow0, LAS float* scr, int lane) {
    if (W == nullptr) {
#pragma unroll
        for (int j = 0; j < 4; ++j) { const int n = (lane >> 3) + 8 * j; *(uint4*)(WT + (size_t)(drow0 + n) * K + k0 + 8 * (lane & 7)) = make_uint4(0u, 0u, 0u, 0u); }
        return;
    }
    float wv[32];
#pragma unroll
    for (int i = 0; i < 32; ++i) { const int kk = 2 * i + (lane >> 5); wv[i] = W[(size_t)(k0 + kk) * ld + col0 + (lane & 31)]; }
#pragma unroll
    for (int i = 0; i < 32; ++i) { const int kk = 2 * i + (lane >> 5); scr[kk * 33 + (lane & 31)] = wv[i]; }
    asm volatile("s_waitcnt lgkmcnt(0)" ::: "memory");
    const int c = lane & 7;
#pragma unroll
    for (int j = 0; j < 4; ++j) { const int n = (lane >> 3) + 8 * j; const LAS float* s = scr + (8 * c) * 33 + n;
        uint4 o; o.x = pk2(s[0 * 33], s[1 * 33]); o.y = pk2(s[2 * 33], s[3 * 33]); o.z = pk2(s[4 * 33], s[5 * 33]); o.w = pk2(s[6 * 33], s[7 * 33]);
        *(uint4*)(WT + (size_t)(drow0 + n) * K + k0 + 8 * c) = o; }
    asm volatile("s_waitcnt lgkmcnt(0)" ::: "memory");
}
__device__ __forceinline__ void ph_wconv(const Ctx& C0) {
    PHASE_CTX(C0);
    LAS float* scr = (LAS float*)((LAS unsigned char*)C.lds + C.wave * 16384);
    const int lane = C.lane;
    __syncthreads();
    constexpr int I_WI = 120 * 16, I_WZ = 96 * 16, I_WG = 32 * 8, I_WR = 96 * 8, I_WO = 32 * 16, I_WU = 176 * 16, I_WD = 32 * 44;
    constexpr int I_LAYER = I_WI + I_WZ + I_WG + I_WR + I_WO + I_WU + I_WD;
    for (int it = C.bid * NWAVE + C.wave; it < 2 * I_LAYER; it += C.G * NWAVE) {
        const int l = it / I_LAYER; int r = it % I_LAYER;
        unsigned char* wb = WS_ + W_WB + (size_t)l * WB_LAYER;
        if (r < I_WI) { const int rb = r >> 4, kb = r & 15, pn = rb >> 3, tb = rb & 7; int col = -1;
            if (pn < 4) col = 256 * pn + 64 * (tb & 3) + 32 * (tb >> 2);
            else if (pn < 6) col = C_AV + 256 * (pn - 4) + 32 * tb;
            else if (pn == 6) col = C_BQ + 32 * tb; else if (pn == 7) col = C_BK + 32 * tb;
            else if (pn < 10) col = C_BV + 256 * (pn - 8) + 32 * tb; else if (pn < 12) col = C_BG + 256 * (pn - 10) + 32 * tb;
            else if (pn < 14) col = C_CU + 256 * (pn - 12) + 32 * tb; else if (tb == 0) col = C_BR;
            wconv_item(col < 0 ? nullptr : c_w_in + (size_t)l * 1024 * IN_DIM, IN_DIM, col, kb * 64, (bf16_t*)(wb + WB_WI), 1024, rb * 32, scr, lane); continue; }
        r -= I_WI;
        if (r < I_WZ) { const int rb = r >> 4, kb = r & 15; wconv_item(c_w_in + (size_t)l * 1024 * IN_DIM, IN_DIM, C_GZ + 32 * rb, kb * 64, (bf16_t*)(wb + WB_WZ), 1024, rb * 32, scr, lane); continue; }
        r -= I_WZ;
        if (r < I_WG) { const int rb = r >> 3, kb = r & 7, pn = rb >> 3, tb = rb & 7; wconv_item(c_s5_w_glu + (size_t)l * 512 * 1024, 1024, 512 * (tb >> 2) + 128 * pn + 32 * (tb & 3), kb * 64, (bf16_t*)(wb + WB_WG), 512, rb * 32, scr, lane); continue; }
        r -= I_WG;
        if (r < I_WR) { const int rb = r >> 3, kb = r & 7, br = rb >> 5, rbb = rb & 31; wconv_item(c_w_branch + ((size_t)l * 3 + br) * 512 * 1024, 1024, 32 * rbb, kb * 64, (bf16_t*)(wb + WB_WR), 512, rb * 32, scr, lane); continue; }
        r -= I_WR;
        if (r < I_WO) { const int rb = r >> 4, kb = r & 15; wconv_item(c_w_out + (size_t)l * 1024 * 1024, 1024, 32 * rb, kb * 64, (bf16_t*)(wb + WB_WO), 1024, rb * 32, scr, lane); continue; }
        r -= I_WO;
        if (r < I_WU) { const int rb = r >> 4, kb = r & 15, pn = rb >> 3, tb = rb & 7; const float* src = (tb >> 2) ? c_w_up : c_w_gate;
            wconv_item(src + (size_t)l * 1024 * FFN, FFN, 128 * pn + 32 * (tb & 3), kb * 64, (bf16_t*)(wb + WB_WU), 1024, rb * 32, scr, lane); continue; }
        r -= I_WU;
        { const int rb = r / 44, kb = r % 44; wconv_item(c_w_down + (size_t)l * FFN * 1024, 1024, 32 * rb, kb * 64, (bf16_t*)(wb + WB_WD), FFN, rb * 32, scr, lane); }
    }
}

__device__ __forceinline__ uint4 pack8(const f32x4& a, const f32x4& b) { uint4 w; w.x = pk2(a[0], a[1]); w.y = pk2(a[2], a[3]); w.z = pk2(b[0], b[1]); w.w = pk2(b[2], b[3]); return w; }
struct EpiIn {
    static constexpr bool PERM = true, AFTER_DRAIN = false;
    unsigned char* ws_; float* out_; const float* qg; const float* kg; int l; int pad_;
    __device__ __forceinline__ void operator()(const f32x4 (&acc)[2][2][4][2], const pg8::Unit& u, int wr, int wc, int fr_, int fq_) const {
        int fr = fr_, fq = fq_; asm volatile("" : "+v"(fr), "+v"(fq));
        KArgPtr Pk = kargs(); unsigned char* ws = Pk->ws; float* out = Pk->out;
        const int pn = u.pn, rowb = u.pm * 256 + wr * 64 + fr;
        if (pn < 4) {
            const bool isk = pn >= 2; const float* g = isk ? kg : qg;
            const bool latent = u.pm >= 32;
            const float* cosT = (const float*)(ws + W_MISC) + 64; const float* sinT = cosT + 1024;
            bf16_t* dstb = isk ? (bf16_t*)(ws + W_AK) : (bf16_t*)(ws + W_AQ);
            const int colb = (pn & 1) * 256 + 64 * wc + 8 * fq;
#pragma unroll
            for (int ai = 0; ai < 2; ++ai)
#pragma unroll
                for (int m = 0; m < 4; ++m) {
                    const int row = rowb + ai * 128 + m * 16;
                    f32x4 v[2][2]; float ss = 0.f;
#pragma unroll
                    for (int bj = 0; bj < 2; ++bj)
#pragma unroll
                        for (int n = 0; n < 2; ++n) { v[bj][n] = acc[ai][bj][m][n]; ss += v[bj][n][0] * v[bj][n][0] + v[bj][n][1] * v[bj][n][1] + v[bj][n][2] * v[bj][n][2] + v[bj][n][3] * v[bj][n][3]; }
                    ss += shx(ss, 16, fq * 16 + fr); ss = xsum32(ss);
                    const float rs = rsqrtf(ss * (1.f / 64.f) + EPS);
                    { const float* gp = (isk ? Pk->in[14] : Pk->in[13]) + l * 64 + launder_s(0);
#pragma unroll
                      for (int bj = 0; bj < 2; ++bj)
#pragma unroll
                        for (int n = 0; n < 2; ++n) v[bj][n] = v[bj][n] * rs * *(const f32x4*)(gp + 32 * bj + 8 * fq + 4 * n); }
                    if (isk && !latent) {
                        float* o = out + O_NK + ((size_t)((row >> 8) * 2 + l) * 256 + (row & 255)) * 512 + colb;
#pragma unroll
                        for (int bj = 0; bj < 2; ++bj) { *(f32x4*)(o + 32 * bj) = v[bj][0]; *(f32x4*)(o + 32 * bj + 4) = v[bj][1]; }
                    }
                    if (latent) {
                        const int t = (row - NPROMPT) & 2047;
#pragma unroll
                        for (int bj = 0; bj < 2; ++bj) {
                            const int pos = bj ? (t & 63) : (t >> 6);
#pragma unroll
                            for (int n = 0; n < 2; ++n) {
                                const f32x4 cc = *(const f32x4*)(cosT + pos * 16 + 8 * (fq & 1) + 4 * n), sn = *(const f32x4*)(sinT + pos * 16 + 8 * (fq & 1) + 4 * n);
                                f32x4 ot;
#pragma unroll
                                for (int e = 0; e < 4; ++e) ot[e] = shx(v[bj][n][e], 32, fq * 16 + fr);
                                v[bj][n] = (fq & 2) ? (v[bj][n] * cc + ot * sn) : (v[bj][n] * cc - ot * sn);
                            }
                        }
                    }
                    bf16_t* d = dstb + (size_t)(isk ? krow_of(row) : row) * 512 + colb;
#pragma unroll
                    for (int bj = 0; bj < 2; ++bj) *(uint4*)(d + 32 * bj) = pack8(v[bj][0], v[bj][1]);
                }
            return;
        }
        const int cb = 32 * wc + 8 * fq;
        if (pn < 6) {
            bf16_t* AV = (bf16_t*)(ws + W_AV);
#pragma unroll
            for (int ai = 0; ai < 2; ++ai)
#pragma unroll
                for (int m = 0; m < 4; ++m) { const int row = rowb + ai * 128 + m * 16;
#pragma unroll
                    for (int bj = 0; bj < 2; ++bj) { const int col = (pn - 4) * 256 + 128 * bj + cb;
                        *(uint4*)(AV + (size_t)krow_of(row) * 512 + col) = pack8(acc[ai][bj][m][0], acc[ai][bj][m][1]);
                        if (row < NPROMPT) { float* o = out + O_NV + ((size_t)((row >> 8) * 2 + l) * 256 + (row & 255)) * 512 + col; *(f32x4*)o = acc[ai][bj][m][0]; *(f32x4*)(o + 4) = acc[ai][bj][m][1]; } } }
            return;
        }
        if (pn == 14) {
            if (wc == 0) { float* BR = (float*)(ws + W_BR);
#pragma unroll
                for (int ai = 0; ai < 2; ++ai)
#pragma unroll
                    for (int m = 0; m < 4; ++m) { const int row = rowb + ai * 128 + m * 16; *(f32x4*)(BR + (size_t)row * 32 + 8 * fq) = acc[ai][0][m][0]; *(f32x4*)(BR + (size_t)row * 32 + 8 * fq + 4) = acc[ai][0][m][1]; } }
            return;
        }
        bf16_t* dst; int ldd, c0; int mode = 0;
        if (pn == 6) { dst = (bf16_t*)(ws + W_BQ); ldd = 256; c0 = 0; mode = 1; }
        else if (pn == 7) { dst = (bf16_t*)(ws + W_BK); ldd = 256; c0 = 0; }
        else if (pn < 10) { dst = (bf16_t*)(ws + W_BV); ldd = 512; c0 = (pn - 8) * 256; }
        else if (pn < 12) { dst = (bf16_t*)(ws + W_BG); ldd = 512; c0 = (pn - 10) * 256; mode = 2; }
        else {
            bf16_t* UH = (bf16_t*)(ws + W_UH);
#pragma unroll
            for (int ai = 0; ai < 2; ++ai)
#pragma unroll
                for (int m = 0; m < 4; ++m) { const int row = rowb + ai * 128 + m * 16;
#pragma unroll
                    for (int bj = 0; bj < 2; ++bj) { const int col = (pn - 12) * 256 + 128 * bj + cb, g = col >> 4, ch0 = col & 15;
                        *(uint4*)(UH + ((size_t)g * 512 + (row >> 5)) * 768 + (row & 31) * 16 + ch0) = pack8(acc[ai][bj][m][0], acc[ai][bj][m][1]); } }
            return;
        }
#pragma unroll
        for (int ai = 0; ai < 2; ++ai)
#pragma unroll
            for (int m = 0; m < 4; ++m) { const int row = rowb + ai * 128 + m * 16;
#pragma unroll
                for (int bj = 0; bj < 2; ++bj) { f32x4 a = acc[ai][bj][m][0], b = acc[ai][bj][m][1];
                    if (mode == 1) { a = a * 0.125f; b = b * 0.125f; }
                    if (mode == 2) {
#pragma unroll
                        for (int e = 0; e < 4; ++e) { a[e] = siluf_(a[e]); b[e] = siluf_(b[e]); } }
                    *(uint4*)(dst + (size_t)row * ldd + c0 + 128 * bj + cb) = pack8(a, b); } }
    }
};
struct EpiGate {
    static constexpr bool PERM = true, AFTER_DRAIN = false;
    bf16_t* G;
    __device__ __forceinline__ void operator()(const f32x4 (&acc)[2][2][4][2], const pg8::Unit& u, int wr, int wc, int fr_, int fq_) const {
        int fr = fr_, fq = fq_; asm volatile("" : "+v"(fr), "+v"(fq));
        const int rowb = u.pm * 256 + wr * 64 + fr, cb = u.pn * 256 + 32 * wc + 8 * fq;
#pragma unroll
        for (int ai = 0; ai < 2; ++ai)
#pragma unroll
            for (int m = 0; m < 4; ++m) { const int row = rowb + ai * 128 + m * 16;
#pragma unroll
                for (int bj = 0; bj < 2; ++bj) { f32x4 a = acc[ai][bj][m][0], b = acc[ai][bj][m][1];
#pragma unroll
                    for (int e = 0; e < 4; ++e) { a[e] = sigmoidf_(a[e]); b[e] = sigmoidf_(b[e]); }
                    *(uint4*)(G + (size_t)row * 3072 + cb + 128 * bj) = pack8(a, b); } }
    }
};
struct EpiGlu {
    static constexpr bool PERM = true, AFTER_DRAIN = false;
    bf16_t* OC; const float* bias;
    __device__ __forceinline__ void operator()(const f32x4 (&acc)[2][2][4][2], const pg8::Unit& u, int wr, int wc, int fr_, int fq_) const {
        int fr = fr_, fq = fq_; asm volatile("" : "+v"(fr), "+v"(fq));
        const int rowb = u.pm * 256 + wr * 64 + fr, col = u.pn * 128 + 32 * wc + 8 * fq;
        const f32x4 ba0 = *(const f32x4*)(bias + col), ba1 = *(const f32x4*)(bias + col + 4), bb0 = *(const f32x4*)(bias + 512 + col), bb1 = *(const f32x4*)(bias + 512 + col + 4);
#pragma unroll
        for (int ai = 0; ai < 2; ++ai)
#pragma unroll
            for (int m = 0; m < 4; ++m) { const int row = rowb + ai * 128 + m * 16;
                f32x4 a0 = acc[ai][0][m][0] + ba0, a1 = acc[ai][0][m][1] + ba1, b0 = acc[ai][1][m][0] + bb0, b1 = acc[ai][1][m][1] + bb1;
#pragma unroll
                for (int e = 0; e < 4; ++e) { a0[e] *= sigmoidf_(b0[e]); a1[e] *= sigmoidf_(b1[e]); }
                *(uint4*)(OC + (size_t)row * 512 + col) = pack8(a0, a1); }
    }
};
struct EpiBranch {
    static constexpr bool PERM = true, AFTER_DRAIN = false;
    const bf16_t* G; bf16_t* MG;
    __device__ __forceinline__ void operator()(const f32x4 (&acc)[2][2][4][2], const pg8::Unit& u, int wr, int wc, int fr_, int fq_) const {
        int fr = fr_, fq = fq_; asm volatile("" : "+v"(fr), "+v"(fq));
        const int rowb = u.pm * 256 + wr * 64 + fr, cb = u.pn * 256 + 32 * wc + 8 * fq, r = u.z;
#pragma unroll
        for (int ai = 0; ai < 2; ++ai)
#pragma unroll
            for (int m = 0; m < 4; ++m) { const int row = rowb + ai * 128 + m * 16;
#pragma unroll
                for (int bj = 0; bj < 2; ++bj) { const int col = cb + 128 * bj;
                    const uint4 gr = *(const uint4*)(G + (size_t)row * 3072 + r * 1024 + col);
                    f32x4 g0, g1;
                    g0[0] = __uint_as_float(gr.x << 16); g0[1] = __uint_as_float(gr.x & 0xffff0000u); g0[2] = __uint_as_float(gr.y << 16); g0[3] = __uint_as_float(gr.y & 0xffff0000u);
                    g1[0] = __uint_as_float(gr.z << 16); g1[1] = __uint_as_float(gr.z & 0xffff0000u); g1[2] = __uint_as_float(gr.w << 16); g1[3] = __uint_as_float(gr.w & 0xffff0000u);
                    f32x4 a = acc[ai][bj][m][0] * g0, b = acc[ai][bj][m][1] * g1;
                    bf16_t* mp = MG + (size_t)row * 1024 + col;
                    if (r > 0) { const uint4 pr = *(const uint4*)mp;
                        a[0] += __uint_as_float(pr.x << 16); a[1] += __uint_as_float(pr.x & 0xffff0000u); a[2] += __uint_as_float(pr.y << 16); a[3] += __uint_as_float(pr.y & 0xffff0000u);
                        b[0] += __uint_as_float(pr.z << 16); b[1] += __uint_as_float(pr.z & 0xffff0000u); b[2] += __uint_as_float(pr.w << 16); b[3] += __uint_as_float(pr.w & 0xffff0000u); }
                    *(uint4*)mp = pack8(a, b); } }
    }
};
struct EpiRes {
    static constexpr bool PERM = true, AFTER_DRAIN = false;
    const void* x0; const void* x1; void* o0; void* o1; const float* MODg; int in_bf16, out_bf16;
    __device__ __forceinline__ void operator()(const f32x4 (&acc)[2][2][4][2], const pg8::Unit& u, int wr, int wc, int fr_, int fq_) const {
        int fr = fr_, fq = fq_; asm volatile("" : "+v"(fr), "+v"(fq));
        const int rowb = u.pm * 256 + wr * 64 + fr, cb = u.pn * 256 + 32 * wc + 8 * fq;
        const float* mg = MODg + (size_t)cond_row(u.pm * 256) * 6144;
        const bool ctx = u.pm < NPROMPT / 256;
        const void* xi0 = ctx ? x0 : x1; void* xo0 = ctx ? o0 : o1;
#pragma unroll
        for (int bj = 0; bj < 2; ++bj) { const int col = cb + 128 * bj;
            const f32x4 m0 = *(const f32x4*)(mg + col), m1 = *(const f32x4*)(mg + col + 4);
#pragma unroll
            for (int ai = 0; ai < 2; ++ai)
#pragma unroll
                for (int m = 0; m < 4; ++m) { const int row = rowb + ai * 128 + m * 16;
                    const size_t off = (size_t)(ctx ? row : row - NPROMPT) * D + col;
                    f32x4 a, b;
                    if (in_bf16) { const uint4 w = *(const uint4*)((const bf16_t*)xi0 + off);
                        a[0] = __uint_as_float(w.x << 16); a[1] = __uint_as_float(w.x & 0xffff0000u); a[2] = __uint_as_float(w.y << 16); a[3] = __uint_as_float(w.y & 0xffff0000u);
                        b[0] = __uint_as_float(w.z << 16); b[1] = __uint_as_float(w.z & 0xffff0000u); b[2] = __uint_as_float(w.w << 16); b[3] = __uint_as_float(w.w & 0xffff0000u); }
                    else { a = *(const f32x4*)((const float*)xi0 + off); b = *(const f32x4*)((const float*)xi0 + off + 4); }
                    a += m0 * acc[ai][bj][m][0]; b += m1 * acc[ai][bj][m][1];
                    if (out_bf16) *(uint4*)((bf16_t*)xo0 + off) = pack8(a, b);
                    else { *(f32x4*)((float*)xo0 + off) = a; *(f32x4*)((float*)xo0 + off + 4) = b; } } }
    }
};
struct EpiFfn {
    static constexpr bool PERM = true, AFTER_DRAIN = false;
    bf16_t* H;
    __device__ __forceinline__ void operator()(const f32x4 (&acc)[2][2][4][2], const pg8::Unit& u, int wr, int wc, int fr_, int fq_) const {
        int fr = fr_, fq = fq_; asm volatile("" : "+v"(fr), "+v"(fq));
        const int rowb = u.pm * 256 + wr * 64 + fr, col = u.pn * 128 + 32 * wc + 8 * fq;
#pragma unroll
        for (int ai = 0; ai < 2; ++ai) {
            if (u.h != 0 && u.h != ai + 1) continue;
#pragma unroll
            for (int m = 0; m < 4; ++m) { const int row = rowb + ai * 128 + m * 16;
                f32x4 a0 = acc[ai][0][m][0], a1 = acc[ai][0][m][1];
#pragma unroll
                for (int e = 0; e < 4; ++e) { a0[e] = siluf_(a0[e]) * acc[ai][1][m][0][e]; a1[e] = siluf_(a1[e]) * acc[ai][1][m][1][e]; }
                *(uint4*)(H + (size_t)row * FFN + col) = pack8(a0, a1); } }
    }
};
struct FfnOrder {
    pg8::StaticOrder S;
    static constexpr bool HALF = true;
    __device__ bool next(int i, pg8::Unit& u) const {
        if (S.G != 256 || S.nwg != 1408) return S.next(i, u);
        if (i < 5) { S.map(i * 256 + S.c, u); return true; }
        if (i > 5) return false;
        S.map(1280 + ((S.c >> 4) << 3) + (S.c & 7), u); u.h = 1 + ((S.c >> 3) & 1); return true;
    }
    __device__ __forceinline__ void a_ready(const pg8::Unit&) const {}
    __device__ __forceinline__ void done(const pg8::Unit&) const {}
};
struct BranchOrder {
    pg8::StaticOrder S;
    static constexpr bool HALF = false;
    __device__ bool next(int i, pg8::Unit& u) const { if (i >= 3) return false; if (!S.next(0, u)) return false; u.z = i; return true; }
    __device__ __forceinline__ void a_ready(const pg8::Unit&) const {}
    __device__ __forceinline__ void done(const pg8::Unit&) const {}
};
constexpr int S5T = 32;
constexpr size_t TE_BYTES = 256 * 512 * 2, TC_BYTES = 512 * 768 * 2, TAB_TE = 0, TAB_TC = 32 * TE_BYTES;
__device__ __forceinline__ unsigned char* s5_tab(unsigned char* ws, int l) { return ws + (l == 0 ? W_TAB0 : W_TAB1); }
template <int MODE>
__device__ __forceinline__ void ph_s5_tables(const Ctx& C0) {
    PHASE_CTX(C0);
    float* sApr = (float*)C.lds;
    float* sApi = sApr + 2 * 33 * 64;
    float* sBr = sApi + 2 * 33 * 64;
    float* sBi = sBr + 2 * 64 * 16;
    float* sCr = sBi + 2 * 64 * 16;
    float* sCi = sCr + 2 * 16 * 64;
    float* sK = sCi + 2 * 16 * 64;
    float* sD = sK + 2 * 32 * 260;
    const int tid = C.tid;
    for (int item0 = (MODE == 0 ? C.G - 1 - C.bid : C.bid); item0 < (MODE == 0 ? 64 : 256); item0 += C.G) {
        const int item = MODE == 0 ? item0 * 4 : item0;
        const int l = item >> 7, g = (item >> 2) & 31, sub = item & 3;
        __syncthreads();
        constexpr int AUXF = 2 * 2 * 33 * 64 + 2 * 2 * 64 * 16 + 2 * 2 * 16 * 64;
        float* aux = WSP(float, W_KAUX) + ((size_t)l * 32 + g) * (AUXF + 16);
        if (MODE == 1) {
            f32x4 av[9];
#pragma unroll
            for (int q = 0; q < 9; ++q) { const int i = tid + q * NT; av[q] = i < AUXF / 4 ? ((const f32x4*)aux)[i] : (f32x4){0.f, 0.f, 0.f, 0.f}; }
            const float dv = tid < 16 ? aux[AUXF + tid] : 0.f;
#pragma unroll
            for (int q = 0; q < 9; ++q) { const int i = tid + q * NT; if (i < AUXF / 4) ((f32x4*)sApr)[i] = av[q]; }
            if (tid < 16) sD[tid] = dv;
        }
        if (MODE == 0) {
        for (int i = tid; i < 2 * 33 * 64; i += NT) {
            const int dir = i / (33 * 64), t = (i / 64) % 33, p = i & 63; const size_t ld = (size_t)l * 2 + dir;
            const float lr = c_s5_lam_re[(ld * 32 + g) * 64 + p], li = c_s5_lam_im[(ld * 32 + g) * 64 + p], dt = expf(c_s5_log_dt[ld * 32 + g]);
            const float mag = expf(lr * dt * (float)t); float sn, cs; sincosf(li * dt * (float)t, &sn, &cs);
            sApr[(dir * 33 + t) * 64 + p] = mag * cs; sApi[(dir * 33 + t) * 64 + p] = mag * sn; }
        if (tid < 128) {
            const int dir = tid >> 6, p = tid & 63; const size_t ld = (size_t)l * 2 + dir;
            const float lr = c_s5_lam_re[(ld * 32 + g) * 64 + p], li = c_s5_lam_im[(ld * 32 + g) * 64 + p], dt = expf(c_s5_log_dt[ld * 32 + g]);
            const float mag = expf(lr * dt); const float ar = mag * cosf(li * dt), ai = mag * sinf(li * dt), den = lr * lr + li * li;
            const float fr = ((ar - 1.f) * lr + ai * li) / den, fi = (ai * lr - (ar - 1.f) * li) / den;
            for (int c = 0; c < 16; ++c) { const float br_ = c_s5_b_re[((ld * 32 + g) * 64 + p) * 16 + c], bi_ = c_s5_b_im[((ld * 32 + g) * 64 + p) * 16 + c];
                sBr[(dir * 64 + p) * 16 + c] = fr * br_ - fi * bi_; sBi[(dir * 64 + p) * 16 + c] = fr * bi_ + fi * br_; }
            for (int o = 0; o < 16; ++o) { sCr[(dir * 16 + o) * 64 + p] = c_s5_c_re[((ld * 32 + g) * 16 + o) * 64 + p]; sCi[(dir * 16 + o) * 64 + p] = c_s5_c_im[((ld * 32 + g) * 16 + o) * 64 + p]; }
        }
        if (tid >= 128 && tid < 144) sD[tid - 128] = c_s5_d[(size_t)l * 512 + g * 16 + (tid - 128)];
        }
        __syncthreads();
        if (MODE == 0) {
            for (int i = tid; i < AUXF / 4; i += NT) ((f32x4*)aux)[i] = ((const f32x4*)sApr)[i];
            if (tid < 16) aux[AUXF + tid] = sD[tid];
        }
        if (tid < 128 && MODE == 0) {
            const int dir = tid >> 6, p = tid & 63; float* at = WSP(float, W_ATAB) + ((((size_t)l * 32 + g) * 2 + dir) * 64 + p) * 2;
            at[0] = sApr[(dir * 33 + 32) * 64 + p]; at[1] = sApi[(dir * 33 + 32) * 64 + p];
        }
        float* Kg = WSP(float, W_KG) + ((size_t)l * 32 + g) * 16384;
        if (MODE == 1) { f32x4 kv[8];
#pragma unroll
            for (int q = 0; q < 8; ++q) kv[q] = ((const f32x4*)Kg)[tid + q * NT];
#pragma unroll
            for (int q = 0; q < 8; ++q) { const int i = tid + q * NT; ((f32x4*)sK)[(i >> 6) * 65 + (i & 63)] = kv[q]; } }
        if (MODE == 0) for (int combo = tid; combo < 1024; combo += NT) {
            const int dir = combo >> 9, tau = (combo >> 4) & 31, o = combo & 15;
            float acc[16];
#pragma unroll
            for (int c = 0; c < 16; ++c) acc[c] = 0.f;
            for (int p = 0; p < 64; ++p) {
                const float cr = sCr[(dir * 16 + o) * 64 + p], ci = sCi[(dir * 16 + o) * 64 + p], ar = sApr[(dir * 33 + tau) * 64 + p], ai = sApi[(dir * 33 + tau) * 64 + p];
                const float wr = cr * ar - ci * ai, wi = cr * ai + ci * ar;
#pragma unroll
                for (int c = 0; c < 16; ++c) acc[c] += wr * sBr[(dir * 64 + p) * 16 + c] - wi * sBi[(dir * 64 + p) * 16 + c];
            }
#pragma unroll
            for (int c = 0; c < 16; ++c) Kg[((dir * 32 + tau) * 16 + o) * 16 + c] = acc[c];
        }
        if (MODE == 0) continue;
        __syncthreads();
        unsigned char* tab = s5_tab(WS_, l);
        bf16_t* TC = (bf16_t*)(tab + TAB_TC + (size_t)g * TC_BYTES);
        bf16_t* TE = (bf16_t*)(tab + TAB_TE + (size_t)g * TE_BYTES);
        for (int ch = tid; ch < 128 * 64; ch += NT) {
            const int n = sub * 128 + (ch >> 6), kc = ch & 63, j = n >> 4, o = n & 15, i = kc >> 1, c0 = (kc & 1) * 8;
            const float* src = sK + (i <= j ? j - i : 32 + i - j) * 260 + o * 16 + c0;
            f32x4 a = *(const f32x4*)src, b = *(const f32x4*)(src + 4);
            if (i == j) { const float* s1 = sK + 32 * 260 + o * 16 + c0; a += *(const f32x4*)s1; b += *(const f32x4*)(s1 + 4); const float dv = sD[o];
#pragma unroll
                for (int e = 0; e < 4; ++e) { a[e] += (o == c0 + e) ? dv : 0.f; b[e] += (o == c0 + 4 + e) ? dv : 0.f; } }
            *(uint4*)(TC + (size_t)n * 768 + kc * 8) = pack8(a, b);
        }
        for (int ch = tid; ch < 128 * 32; ch += NT) {
            const int n = sub * 128 + (ch >> 5), kq = ch & 31, j = n >> 4, o = n & 15;
            const int kk = kq * 8, dir = kk >> 7, ri = (kk >> 6) & 1, p0 = kk & 63; const int tau = dir == 0 ? j + 1 : S5T - j;
            const float* pc = sCr + (dir * 16 + o) * 64 + p0; const float* pa = sApr + (dir * 33 + tau) * 64 + p0;
            const f32x4 cr0 = *(const f32x4*)pc, cr1 = *(const f32x4*)(pc + 4), ci0 = *(const f32x4*)(pc + 2 * 16 * 64), ci1 = *(const f32x4*)(pc + 2 * 16 * 64 + 4);
            const f32x4 ar0 = *(const f32x4*)pa, ar1 = *(const f32x4*)(pa + 4), ai0 = *(const f32x4*)(pa + 2 * 33 * 64), ai1 = *(const f32x4*)(pa + 2 * 33 * 64 + 4);
            const f32x4 v0 = ri == 0 ? (cr0 * ar0 - ci0 * ai0) : -(cr0 * ai0 + ci0 * ar0), v1 = ri == 0 ? (cr1 * ar1 - ci1 * ai1) : -(cr1 * ai1 + ci1 * ar1);
            *(uint4*)(TC + (size_t)n * 768 + 512 + kq * 8) = pack8(v0, v1);
        }
        for (int ch = tid; ch < 64 * 64; ch += NT) {
            const int n = sub * 64 + (ch >> 6), kc = ch & 63, dir = n >> 7, ri = (n >> 6) & 1, p = n & 63, i = kc >> 1, c0 = (kc & 1) * 8;
            const int tau = dir == 0 ? S5T - 1 - i : i;
            const float ar = sApr[(dir * 33 + tau) * 64 + p], ai = sApi[(dir * 33 + tau) * 64 + p];
            float v[8];
#pragma unroll
            for (int e = 0; e < 8; ++e) { const float br_ = sBr[(dir * 64 + p) * 16 + c0 + e], bi_ = sBi[(dir * 64 + p) * 16 + c0 + e];
                v[e] = ri == 0 ? (ar * br_ - ai * bi_) : (ar * bi_ + ai * br_); }
            uint4 w; w.x = pk2(v[0], v[1]); w.y = pk2(v[2], v[3]); w.z = pk2(v[4], v[5]); w.w = pk2(v[6], v[7]);
            *(uint4*)(TE + (size_t)n * 512 + kc * 8) = w;
        }
    }
}
__device__ __forceinline__ void ph_s5_scan(const Ctx& C0, int l) {
    PHASE_CTX(C0);
    const int lane = C.lane;
    const float* HL = WSP(float, W_HLOC); bf16_t* UH = WSP(bf16_t, W_UH);
    for (int w0 = C.bid * NWAVE + C.wave; w0 < 36 * 64; w0 += C.G * NWAVE) {
        const int w = (w0 + 36 * 64 - 512) % (36 * 64);
        const int dir = w & 1, g = (w >> 1) & 31, s = 35 - (w >> 6);
        const bool latent = s >= 32;
        const int nch = latent ? 64 : 8, ch0 = latent ? 256 + (s - 32) * 64 : s * 8;
        const float* at = WSP(float, W_ATAB) + ((((size_t)l * 32 + g) * 2 + dir) * 64 + lane) * 2;
        const float ar = at[0], ai = at[1];
        float hr = 0.f, hi = 0.f;
        if (latent) { const float* si = c_state_s5 + ((((size_t)(s - 32) * 2 + l) * 2 + dir) * 2) * 2048 + g * 64 + lane; hr = si[0]; hi = si[2048]; }
#pragma unroll 1
        for (int n0 = 0; n0 < nch; n0 += 8) {
            float lr_[8], li_[8];
#pragma unroll
            for (int b = 0; b < 8; ++b) { const int ch = ch0 + (dir == 0 ? n0 + b : nch - 1 - n0 - b);
                const float* hl = HL + ((size_t)g * 512 + ch) * 256 + dir * 128 + lane; lr_[b] = hl[0]; li_[b] = hl[64]; }
#pragma unroll
            for (int b = 0; b < 8; ++b) { const int ch = ch0 + (dir == 0 ? n0 + b : nch - 1 - n0 - b);
                bf16_t* uh = UH + ((size_t)g * 512 + ch) * 768 + 512 + dir * 128 + lane;
                uh[0] = f2bf(hr); uh[64] = f2bf(hi);
                const float nr = ar * hr - ai * hi + lr_[b], ni = ar * hi + ai * hr + li_[b];
                hr = nr; hi = ni; }
        }
        if (!latent) { float* so = c_out + O_NS + ((((size_t)s * 2 + l) * 2 + dir) * 2) * 2048 + g * 64 + lane; so[0] = hr; so[2048] = hi; }
    }
}
struct ZOrder {
    int nz, nM, nN, G, c;
    static constexpr bool HALF = false;
    __device__ bool next(int i, pg8::Unit& u) const { const int L = i * G + c; if (c >= G || L >= nz * nM * nN) return false; u.h = 0; u.z = L / (nM * nN); const int r = L % (nM * nN); u.pm = r % nM; u.pn = r / nM; return true; }
    __device__ __forceinline__ void a_ready(const pg8::Unit&) const {}
    __device__ __forceinline__ void done(const pg8::Unit&) const {}
};
struct EpiHloc {
    static constexpr bool PERM = true, AFTER_DRAIN = false;
    float* HL;
    __device__ __forceinline__ void operator()(const f32x4 (&acc)[2][2][4][2], const pg8::Unit& u, int wr, int wc, int fr_, int fq_) const {
        int fr = fr_, fq = fq_; asm volatile("" : "+v"(fr), "+v"(fq));
        const int rowb = u.pm * 256 + wr * 64 + fr, cb = 32 * wc + 8 * fq;
#pragma unroll
        for (int ai = 0; ai < 2; ++ai)
#pragma unroll
            for (int m = 0; m < 4; ++m) { const int row = rowb + ai * 128 + m * 16;
#pragma unroll
                for (int bj = 0; bj < 2; ++bj) { float* o = HL + ((size_t)u.z * 512 + row) * 256 + 128 * bj + cb; *(f32x4*)o = acc[ai][bj][m][0]; *(f32x4*)(o + 4) = acc[ai][bj][m][1]; } }
    }
};
struct EpiS5Y {
    static constexpr bool PERM = true, AFTER_DRAIN = false;
    bf16_t* YC;
    __device__ __forceinline__ void operator()(const f32x4 (&acc)[2][2][4][2], const pg8::Unit& u, int wr, int wc, int fr_, int fq_) const {
        int fr = fr_, fq = fq_; asm volatile("" : "+v"(fr), "+v"(fq));
        const int rowb = u.pm * 256 + wr * 64 + fr, g = u.z;
#pragma unroll
        for (int ai = 0; ai < 2; ++ai)
#pragma unroll
            for (int m = 0; m < 4; ++m) { const int chunk = rowb + ai * 128 + m * 16;
#pragma unroll
                for (int bj = 0; bj < 2; ++bj) { const int n = u.pn * 256 + 128 * bj + 32 * wc + 8 * fq, j = n >> 4, o0 = n & 15;
                    f32x4 a = acc[ai][bj][m][0], b = acc[ai][bj][m][1];
#pragma unroll
                    for (int e = 0; e < 4; ++e) { a[e] = gelu_tanh(a[e]); b[e] = gelu_tanh(b[e]); }
                    *(uint4*)(YC + ((size_t)chunk * 32 + j) * 512 + g * 16 + o0) = pack8(a, b); } }
    }
};
template <class Epi, class Sched>
__device__ __forceinline__ void run_gemm(const Ctx& C, const bf16_t* A, const bf16_t* Bt, int N, int K, size_t za, size_t zb, const Sched& S, const Epi& E, int lda = 0, int ldb = 0) {
    __syncthreads();
    pg8::Gemm g{A, Bt, M, N, K, za, zb, lda ? lda : K, ldb ? ldb : K};
    pg8::gemm_phase<Epi, Sched, true, true>((LAS unsigned char*)C.lds, g, S, E);
}

#define LAYER_PTRS() const float* MODl = c_MOD + (size_t)l * 5 * 6144; const float* xin0 = l == 0 ? c_x_prompt : c_X; const float* xin1 = l == 0 ? c_x_sample : c_X + (size_t)NPROMPT * D; \
    unsigned char* wb = WS_ + W_WB + (size_t)l * WB_LAYER; (void)MODl; (void)xin0; (void)xin1; (void)wb
__device__ __forceinline__ void g_norm1(const Ctx& C0, int l) { PHASE_CTX(C0); LAYER_PTRS(); if (l == 0) ph_norm(C, c_x_prompt, c_x_sample, false, c_norm1_g + l * 1024, MODl, 0); else ph_norm(C, WSP(bf16_t, W_XB0), WSP(bf16_t, W_XB1), true, c_norm1_g + l * 1024, MODl, 0); }
__device__ __forceinline__ void g_norm2(const Ctx& C0, int l) { PHASE_CTX(C0); LAYER_PTRS(); ph_norm(C, WSP(bf16_t, W_XB0), WSP(bf16_t, W_XB1), true, c_norm2_g + l * 1024, MODl, 1); }
__device__ __forceinline__ void g_inproj(const Ctx& C0, int l) { PHASE_CTX(C0); LAYER_PTRS();
    EpiIn e{WS_, OUT_, c_qn_g + l * 64, c_kn_g + l * 64, l, 0}; pg8::StaticOrder S; S.init(M, 3840, C.G, C.bid);
    run_gemm(C, c_XN, (const bf16_t*)(wb + WB_WI), 3840, 1024, 0, 0, S, e); }
__device__ __forceinline__ void g_s5a(const Ctx& C0, int l) { PHASE_CTX(C0);
    EpiHloc e{WSP(float, W_HLOC)}; ZOrder S{32, 2, 1, C.G, C.bid};
    run_gemm(C, WSP(bf16_t, W_UH), (const bf16_t*)(s5_tab(WS_, l) + TAB_TE), 256, 512, (size_t)512 * 768 * 2, TE_BYTES, S, e, 768, 512); }
__device__ __forceinline__ void g_s5c(const Ctx& C0, int l) { PHASE_CTX(C0);
    EpiS5Y e{c_YF}; ZOrder S{32, 2, 2, C.G, C.bid};
    run_gemm(C, WSP(bf16_t, W_UH), (const bf16_t*)(s5_tab(WS_, l) + TAB_TC), 512, 768, (size_t)512 * 768 * 2, TC_BYTES, S, e, 768, 768); }
__device__ __forceinline__ void g_glu(const Ctx& C0, int l) { PHASE_CTX(C0); LAYER_PTRS();
    EpiGlu e{c_OC, c_s5_b_glu + (size_t)l * 1024}; pg8::StaticOrder S; S.init(M, 1024, C.G, C.bid);
    run_gemm(C, c_YF, (const bf16_t*)(wb + WB_WG), 1024, 512, 0, 0, S, e); }
__device__ __forceinline__ void g_gates(const Ctx& C0, int l) { PHASE_CTX(C0); LAYER_PTRS();
    EpiGate e{c_GATES}; pg8::StaticOrder S; S.init(M, 3072, C.G, C.bid);
    run_gemm(C, c_XN, (const bf16_t*)(wb + WB_WZ), 3072, 1024, 0, 0, S, e); }
__device__ __forceinline__ void g_branch(const Ctx& C0, int l) { PHASE_CTX(C0); LAYER_PTRS();
    EpiBranch e{c_GATES, c_MERGED}; BranchOrder S; S.S.init(M, 1024, C.G, C.bid);
    run_gemm(C, c_OA, (const bf16_t*)(wb + WB_WR), 1024, 512, (size_t)M * 512 * 2, (size_t)1024 * 512 * 2, S, e); }
__device__ __forceinline__ void g_out(const Ctx& C0, int l) { PHASE_CTX(C0); LAYER_PTRS();
    EpiRes e{WSP(bf16_t, W_XB0), WSP(bf16_t, W_XB1), WSP(bf16_t, W_XB0), WSP(bf16_t, W_XB1), MODl + 2048, 1, 1};
    if (l == 0) { e.x0 = c_x_prompt; e.x1 = c_x_sample; e.in_bf16 = 0; }
    pg8::StaticOrder S; S.init(M, 1024, C.G, C.bid);
    run_gemm(C, c_MERGED, (const bf16_t*)(wb + WB_WO), 1024, 1024, 0, 0, S, e); }
__device__ __forceinline__ void g_ffn(const Ctx& C0, int l) { PHASE_CTX(C0); LAYER_PTRS();
    EpiFfn e{c_H}; FfnOrder S; S.S.init(M, 5632, C.G, C.bid);
    run_gemm(C, c_XN, (const bf16_t*)(wb + WB_WU), 5632, 1024, 0, 0, S, e); }
__device__ __forceinline__ void g_down(const Ctx& C0, int l) { PHASE_CTX(C0); LAYER_PTRS();
    EpiRes e{WSP(bf16_t, W_XB0), WSP(bf16_t, W_XB1), WSP(bf16_t, W_XB0), WSP(bf16_t, W_XB1), MODl + 5120, 1, 1};
    if (l == 1) { e.o0 = c_X; e.o1 = c_X + (size_t)NPROMPT * D; e.out_bf16 = 0; }
    pg8::StaticOrder S; S.init(M, 1024, C.G, C.bid);
    run_gemm(C, c_H, (const bf16_t*)(wb + WB_WD), 1024, FFN, 0, 0, S, e); }

__global__ void __launch_bounds__(NT, 2) mk_fwd(Params P_unused) {
    extern __shared__ __attribute__((aligned(16))) unsigned char lds[];
    Ctx C;
    C.lds = lds; C.tid = threadIdx.x; C.lane = C.tid & 63; C.wave = __builtin_amdgcn_readfirstlane(C.tid >> 6); C.G = gridDim.x; C.bid = blockIdx.x;
    volatile LAS unsigned* MISCL = (volatile LAS unsigned*)((LAS unsigned char*)lds + LDS_MISC);
    if (C.tid < 64) MISCL[C.tid] = 0u;
    __syncthreads();
    XcdBarrier bar;
    { KArgPtr Pk = kargs(); bar = xcd_barrier_post((unsigned*)(WS_ + W_CTL) + 1024, MISCL + 8); }
#define GRID_BAR() xcd_barrier(bar)

#ifndef DUP
#define DUP -1
#endif
#define RUN(id, stmt) do { stmt; if (DUP == (id)) { stmt; } } while (0)
    RUN(0, ph_s5_tables<0>(C); ph_mod(C); ph_prep(C); ph_wconv(C));
    if (DUP == 30) ph_s5_tables<0>(C); if (DUP == 31) ph_mod(C); if (DUP == 32) ph_wconv(C);
    GRID_BAR();
#pragma unroll 1
    for (int l0 = 0; l0 < 2; ++l0) {
        const int l = launder_s(l0);
        if (l == 0) { RUN(33, ph_s5_tables<1>(C)); }
        RUN(1, g_norm1(C, l));
        GRID_BAR();
        RUN(2, g_inproj(C, l)); ph_cache(C, l, C.G - C.G / 4);
        GRID_BAR();
        RUN(3, ph_gla_prep(C, l)); RUN(4, g_s5a(C, l));
        GRID_BAR();
        RUN(5, ph_gla_scan(C, l)); RUN(6, ph_s5_scan(C, l)); RUN(7, ph_attn(C, l, 256, 512)); if (DUP == 16) ph_attn(C, l, 0, 256); if (DUP == 17) ph_attn(C, l, 256, 512);
        if (DUP >= 21 && DUP <= 26) ph_attn<DUP - 20>(C, l, 256, 512);
        GRID_BAR();
        RUN(8, ph_gla_out(C, l)); RUN(9, g_s5c(C, l));
        if (C.G == 256) { __syncthreads(); ph_attn(C, l, 0, 256, 128); } else ph_attn(C, l, 0, 256);
        GRID_BAR();
        RUN(10, g_glu(C, l)); RUN(11, g_gates(C, l));
        GRID_BAR();
        RUN(12, g_branch(C, l));
        GRID_BAR();
        g_out(C, l);
        GRID_BAR();
        RUN(13, g_norm2(C, l));
        GRID_BAR();
        RUN(14, g_ffn(C, l));
        GRID_BAR();
        g_down(C, l);
        GRID_BAR();
        if (DUP == 15) { for (int q = 0; q < 10; ++q) GRID_BAR(); }
    }
}

extern "C" void kernel_launch(void* const* d_in, const int* in_sizes, int n_in, void* d_out, int out_size, void* d_ws, size_t ws_size, hipStream_t stream) {
    static int grid = 0;
    if (grid == 0) {
        if (n_in != 35 || ws_size < W_END) { fprintf(stderr, "kernel_launch: unexpected n_in %d / ws %zu\n", n_in, ws_size); grid = -1; return; }
        int dev = 0, cus = 0, per_cu = 0;
        if (hipGetDevice(&dev) != hipSuccess || hipDeviceGetAttribute(&cus, hipDeviceAttributeMultiprocessorCount, dev) != hipSuccess) { grid = -1; return; }
        if (hipFuncSetAttribute((const void*)mk_fwd, hipFuncAttributeMaxDynamicSharedMemorySize, LDS_BYTES) != hipSuccess) { fprintf(stderr, "kernel_launch: hipFuncSetAttribute failed\n"); grid = -1; return; }
        if (hipOccupancyMaxActiveBlocksPerMultiprocessor(&per_cu, (const void*)mk_fwd, NT, LDS_BYTES) != hipSuccess || per_cu < 1) { fprintf(stderr, "kernel_launch: occupancy query says %d\n", per_cu); per_cu = 1; }
        (void)hipGetLastError();
        grid = cus;
    }
    if (grid < 0) return;
    (void)hipMemsetAsync((char*)d_ws + W_CTL, 0, CTL_BYTES, stream);
    Params p{};
    for (int i = 0; i < 35; ++i) p.in[i] = (const float*)d_in[i];
    p.out = (float*)d_out; p.ws = (unsigned char*)d_ws;
    hipLaunchKernelGGL(mk_fwd, dim3(grid), dim3(NT), LDS_BYTES, stream, p);
}
```

```cpp
#include <hip/hip_runtime.h>
#include <stdint.h>
#include <cstdio>

typedef unsigned short bf16_t;
typedef short bf16x8 __attribute__((ext_vector_type(8)));
typedef float f32x4 __attribute__((ext_vector_type(4)));
#define LAS __attribute__((address_space(3)))

constexpr int D = 1024, NPROMPT = 8192, M = 16384;
constexpr int SEQ = 256, DSEQ = 2048;
constexpr int IN_DIM = 6688, FFN = 2816;
constexpr float EPS = 1e-6f;
constexpr int C_AQ = 0, C_AK = 512, C_AV = 1024, C_BQ = 1536, C_BK = 1792, C_BV = 2048, C_BG = 2560, C_BR = 3072, C_CU = 3104, C_GZ = 3616;
constexpr int N_MIX = 3616;
constexpr size_t O_YP = 0, O_YS = 8388608, O_NK = 16777216, O_NV = 25165824, O_NG = 33554432, O_NS = 37748736;

constexpr size_t MiB = 1u << 20;
constexpr size_t W_CTL = 0, CTL_BYTES = 65536;
constexpr size_t W_MOD = 65536;
constexpr size_t W_MISC = 65536 + 262144;
constexpr size_t W_XN = 1 * MiB;
constexpr size_t W_AQ = 33 * MiB;
constexpr size_t W_AK = 49 * MiB;
constexpr size_t W_AV = 66 * MiB;
constexpr size_t W_BQ = 83 * MiB;
constexpr size_t W_BK = 91 * MiB;
constexpr size_t W_BV = 99 * MiB;
constexpr size_t W_BG = 115 * MiB;
constexpr size_t W_BR = 131 * MiB;
constexpr size_t W_CU = 133 * MiB;
constexpr size_t W_GF = 149 * MiB;
constexpr size_t W_GB = 165 * MiB;
constexpr size_t W_YF = 181 * MiB;
constexpr size_t W_OA = 197 * MiB;
constexpr size_t W_OB = 213 * MiB;
constexpr size_t W_OC = 229 * MiB;
constexpr size_t W_GATES = 245 * MiB;
constexpr size_t W_GDS = 149 * MiB;
constexpr size_t W_GLA = 245 * MiB;
constexpr size_t W_MERGED = 341 * MiB;
constexpr size_t W_H = 373 * MiB;
constexpr size_t W_MF = W_H;
constexpr size_t W_WB = 461 * MiB;
constexpr size_t WB_LAYER = 36 * MiB;
constexpr size_t WB_WI = 0, WB_WZ = WB_WI + 3840 * 1024 * 2, WB_WG = WB_WZ + 3072 * 1024 * 2, WB_WR = WB_WG + 1024 * 512 * 2, WB_WO = WB_WR + 3 * 1024 * 512 * 2,
                 WB_WU = WB_WO + 1024 * 1024 * 2, WB_WD = WB_WU + 5632 * 1024 * 2;
static_assert(WB_WD + 1024 * 2816 * 2 == WB_LAYER, "weight copy map");
constexpr size_t W_TAB0 = 373 * MiB;
constexpr size_t W_UH = 405 * MiB;
constexpr size_t W_HLOC = 429 * MiB;
constexpr size_t W_TAB1 = 533 * MiB;
constexpr size_t W_ATAB = 524288;
constexpr size_t W_KG = 565 * MiB;
constexpr size_t W_KAUX = 569 * MiB;
constexpr size_t W_XB0 = 133 * MiB;
constexpr size_t W_XB1 = 565 * MiB;
constexpr size_t W_END = 581 * MiB;

constexpr int NT = 512, NWAVE = 8;
constexpr int LDS_BYTES = 163840;
constexpr int LDS_MISC = 163840 - 256;

__device__ __forceinline__ float bf2f(bf16_t h) { return __uint_as_float((unsigned)h << 16); }
typedef float f32x2_t __attribute__((ext_vector_type(2)));
typedef __bf16 bf16x2_t __attribute__((ext_vector_type(2)));
__device__ __forceinline__ unsigned pk2(float lo, float hi) { const f32x2_t v = {lo, hi}; return __builtin_bit_cast(unsigned, __builtin_convertvector(v, bf16x2_t)); }
__device__ __forceinline__ unsigned pk2_valu(float lo, float hi) { unsigned r; asm("v_cvt_pk_bf16_f32 %0, %1, %2" : "=v"(r) : "v"(lo), "v"(hi)); return r; }
__device__ __forceinline__ bf16_t f2bf(float f) { return (bf16_t)(pk2(f, 0.f) & 0xffffu); }
__device__ __forceinline__ float shx(float v, int k, int lane) { return __builtin_bit_cast(float, __builtin_amdgcn_ds_bpermute((lane ^ k) << 2, __builtin_bit_cast(int, v))); }
__device__ __forceinline__ float xsum32(float v) { const auto rr = __builtin_amdgcn_permlane32_swap(__float_as_uint(v), __float_as_uint(v), false, false); return __uint_as_float(rr[0]) + __uint_as_float(rr[1]); }
__device__ __forceinline__ float sigmoidf_(float x) { return 1.f / (1.f + __expf(-x)); }
__device__ __forceinline__ float siluf_(float x) { return x / (1.f + __expf(-x)); }
__device__ __forceinline__ float gelu_tanh(float x) { return 0.5f * x * (1.f + tanhf(0.7978845608028654f * (x + 0.044715f * x * x * x))); }
__device__ __forceinline__ int cond_row(int m) { return m < NPROMPT ? 0 : 1 + ((m - NPROMPT) >> 11); }
__device__ __forceinline__ int krow_of(int m) { return m < NPROMPT ? m : NPROMPT + ((m - NPROMPT) >> 11) * 2304 + 256 + ((m - NPROMPT) & 2047); }

#define XB_TMO      128
#define XB_XCNT(j)  (256  + 64 * (j))
#define XB_XSUB(j)  (1280 + 64 * (j))
#define XB_XGEN(j)  (2304 + 64 * (j))
#define XB_TOP      3328
#define XB_TOPGEN   3392
#define XCD_BAR_WORDS 3456
#define XB_SPIN_CAP (1u << 18)
__device__ __forceinline__ unsigned xb_ld(unsigned* p)              { return __hip_atomic_load(p, __ATOMIC_RELAXED, __HIP_MEMORY_SCOPE_AGENT); }
__device__ __forceinline__ unsigned xb_add(unsigned* p, unsigned v) { return __hip_atomic_fetch_add(p, v, __ATOMIC_RELAXED, __HIP_MEMORY_SCOPE_AGENT); }
__device__ __forceinline__ unsigned xb_xcc_id() { return (unsigned)__builtin_amdgcn_s_getreg((3 << 11) | 20) & 0xFu; }
#define XB_SPIN(cond, bar) do { unsigned _sp = 0; while (cond) { __builtin_amdgcn_s_sleep(1); \
    if ((++_sp & 255u) == 0u) { if (xb_ld(&(bar)[XB_TMO])) break; if (_sp > XB_SPIN_CAP) { atomicAdd(&(bar)[XB_TMO], 1u); break; } } } } while (0)
struct XcdBarrier { unsigned* bar; unsigned x; volatile LAS unsigned* st; };
__device__ __forceinline__ XcdBarrier xcd_barrier_post(unsigned* bar, volatile LAS unsigned* st) {
    XcdBarrier b; b.bar = bar; b.x = xb_xcc_id(); b.st = st;
    if (threadIdx.x == 0) (void)xb_add(&bar[XB_XCNT(b.x)], 1u);
    return b;
}
__device__ __forceinline__ void xcd_barrier_complete(unsigned* bar, unsigned x, unsigned& nloc, unsigned& nx) {
    const unsigned G = gridDim.x * gridDim.y * gridDim.z;
    unsigned sum, cnt, mine, sp = 0u;
    for (;;) {
        sum = 0u; cnt = 0u; mine = 0u;
#pragma unroll
        for (unsigned j = 0; j < 16; ++j) { const unsigned c = xb_ld(&bar[XB_XCNT(j)]); sum += c; cnt += (c > 0u) ? 1u : 0u; mine = (j == x) ? c : mine; }
        if (sum == G) break;
        __builtin_amdgcn_s_sleep(1);
        if ((++sp & 255u) == 0u) { if (xb_ld(&bar[XB_TMO])) break; if (sp > XB_SPIN_CAP) { atomicAdd(&bar[XB_TMO], 1u); break; } }
    }
    nloc = mine > 0u ? mine : 1u; nx = cnt > 0u ? cnt : 1u;
}
__device__ __forceinline__ void xcd_barrier(const XcdBarrier& b) {
    asm volatile("s_waitcnt vmcnt(0)" ::: "memory");
    __syncthreads();
    if (threadIdx.x == 0) {
        unsigned* bar = b.bar; asm volatile("" : "+s"(bar));
        unsigned bx = b.x; asm volatile("" : "+s"(bx));
        __builtin_amdgcn_s_waitcnt(0);
        unsigned nloc = b.st[0], nx = b.st[1];
        if (nloc == 0u) { xcd_barrier_complete(bar, bx, nloc, nx); b.st[0] = nloc; b.st[1] = nx; }
        const unsigned old = xb_add(&bar[XB_XSUB(bx)], 1u);
        const unsigned gen = old / nloc;
        if (old + 1u == (gen + 1u) * nloc) {
            __builtin_amdgcn_fence(__ATOMIC_RELEASE, "agent");
            asm volatile("s_waitcnt vmcnt(0)" ::: "memory");
            const unsigned og = xb_add(&bar[XB_TOP], 1u);
            const unsigned tg = og / nx;
            if (og + 1u == (tg + 1u) * nx) xb_add(&bar[XB_TOPGEN], 1u);
            else XB_SPIN(xb_ld(&bar[XB_TOPGEN]) == tg, bar);
            __builtin_amdgcn_fence(__ATOMIC_ACQUIRE, "agent");
            xb_add(&bar[XB_XGEN(bx)], 1u);
            asm volatile("s_waitcnt vmcnt(0)" ::: "memory");
        } else {
            XB_SPIN(xb_ld(&bar[XB_XGEN(bx)]) == gen, bar);
            __builtin_amdgcn_fence(__ATOMIC_ACQUIRE, "agent");
            asm volatile("s_waitcnt vmcnt(0)" ::: "memory");
        }
    }
    __syncthreads();
}

__device__ __forceinline__ int launder_v(int x) { asm volatile("" : "+v"(x)); return x; }
__device__ __forceinline__ int launder_s(int x) { asm volatile("" : "+s"(x)); return x; }
struct Params { const float* in[35]; float* out; unsigned char* ws; };
struct Ctx {
    unsigned char* lds;
    int tid, lane, wave, G, bid;
};
typedef const __attribute__((address_space(4))) Params* KArgPtr;
__device__ __forceinline__ KArgPtr kargs() { KArgPtr p = (KArgPtr)__builtin_amdgcn_kernarg_segment_ptr(); asm volatile("" : "+s"(p)); return p; }
#define PHASE_CTX(C0) KArgPtr Pk = kargs(); Ctx C = (C0); C.tid = launder_v(C0.tid); C.lane = C.tid & 63; C.wave = __builtin_amdgcn_readfirstlane(C.tid >> 6); C.bid = launder_s(C0.bid)
#define GAS __attribute__((address_space(1)))
#define IN_(i) ((const float*)(GAS const float*)(Pk->in[i]))
#define WS_ ((unsigned char*)(GAS unsigned char*)(Pk->ws))
#define OUT_ ((float*)(GAS float*)(Pk->out))
#define WSP(T, off) ((T*)(WS_ + (off)))
#define c_x_prompt IN_(0)
#define c_x_sample IN_(1)
#define c_cache_k IN_(2)
#define c_cache_v IN_(3)
#define c_state_gla IN_(4)
#define c_state_s5 IN_(5)
#define c_c IN_(6)
#define c_c_ctx IN_(7)
#define c_w_mod IN_(8)
#define c_b_mod IN_(9)
#define c_norm1_g IN_(10)
#define c_norm2_g IN_(11)
#define c_w_in IN_(12)
#define c_qn_g IN_(13)
#define c_kn_g IN_(14)
#define c_diff_lam IN_(15)
#define c_subln_g IN_(16)
#define c_gla_wa2 IN_(17)
#define c_gla_ba IN_(18)
#define c_gla_on_g IN_(19)
#define c_s5_lam_re IN_(20)
#define c_s5_lam_im IN_(21)
#define c_s5_log_dt IN_(22)
#define c_s5_b_re IN_(23)
#define c_s5_b_im IN_(24)
#define c_s5_c_re IN_(25)
#define c_s5_c_im IN_(26)
#define c_s5_d IN_(27)
#define c_s5_w_glu IN_(28)
#define c_s5_b_glu IN_(29)
#define c_w_branch IN_(30)
#define c_w_out IN_(31)
#define c_w_gate IN_(32)
#define c_w_up IN_(33)
#define c_w_down IN_(34)
#define c_out OUT_
#define c_X (OUT_ + O_YP)
#define c_MOD WSP(float, W_MOD)
#define c_MISC WSP(float, W_MISC)
#define c_XN WSP(bf16_t, W_XN)
#define c_AQ WSP(bf16_t, W_AQ)
#define c_AK WSP(bf16_t, W_AK)
#define c_AV WSP(bf16_t, W_AV)
#define c_BQ WSP(bf16_t, W_BQ)
#define c_BK WSP(bf16_t, W_BK)
#define c_BV WSP(bf16_t, W_BV)
#define c_BG WSP(bf16_t, W_BG)
#define c_BR WSP(float, W_BR)
#define c_CU WSP(bf16_t, W_CU)
#define c_GF WSP(bf16_t, W_GF)
#define c_GB WSP(bf16_t, W_GB)
#define c_YF WSP(bf16_t, W_YF)
#define c_OA WSP(bf16_t, W_OA)
#define c_OB WSP(bf16_t, W_OB)
#define c_OC WSP(bf16_t, W_OC)
#define c_GATES WSP(bf16_t, W_GATES)
#define c_MERGED WSP(bf16_t, W_MERGED)
#define c_H WSP(bf16_t, W_H)

__device__ __forceinline__ void ph_mod(const Ctx& C0) {
    PHASE_CTX(C0);
    float (*sc)[1024] = (float (*)[1024])C.lds;
    float (*red)[5][64] = (float (*)[5][64])(C.lds + 5 * 1024 * 4);
    for (int item = C.bid; item < 192; item += C.G) {
        const int l = item / 96, n0 = (item % 96) * 64, tid = C.tid;
        __syncthreads();
        for (int i = tid; i < 5 * 1024; i += NT) { const int r = i >> 10, k = i & 1023; const float v = r == 0 ? c_c_ctx[k] : c_c[(r - 1) * 1024 + k]; sc[r][k] = siluf_(v); }
        __syncthreads();
        const int cn = tid & 63, ks = tid >> 6;
        float acc[5] = {0.f, 0.f, 0.f, 0.f, 0.f};
        const float* w = c_w_mod + (size_t)l * 1024 * 6144 + n0 + cn;
        for (int k = ks * 128; k < ks * 128 + 128; ++k) { const float wv = w[(size_t)k * 6144];
#pragma unroll
            for (int r = 0; r < 5; ++r) acc[r] += sc[r][k] * wv; }
#pragma unroll
        for (int r = 0; r < 5; ++r) red[ks][r][cn] = acc[r];
        __syncthreads();
        if (tid < 320) { const int r = tid >> 6, cc = tid & 63; float s = 0.f;
#pragma unroll
            for (int k8 = 0; k8 < 8; ++k8) s += red[k8][r][cc];
            c_MOD[((size_t)l * 5 + r) * 6144 + n0 + cc] = s + c_b_mod[(size_t)l * 6144 + n0 + cc]; }
    }
}
__device__ __forceinline__ void ph_prep(const Ctx& C0) {
    PHASE_CTX(C0);
    if (C.bid != C.G - 1) return;
    const int tid = C.tid; float* misc = c_MISC;
    if (tid < 2) {
        const float* lv = c_diff_lam + tid * 256; float s01 = 0.f, s23 = 0.f;
        for (int i = 0; i < 64; ++i) { s01 += lv[i] * lv[64 + i]; s23 += lv[128 + i] * lv[192 + i]; }
        const float lam_init = 0.8f - 0.6f * expf(-0.3f * (float)tid);
        misc[tid] = expf(s01) - expf(s23) + lam_init;
    }
    for (int i = tid; i < 64 * 16; i += NT) {
        const int pos = i >> 4, f = i & 15;
        const float inv = powf(10000.f, -(float)(2 * f) / 32.f);
        const float ang = (float)pos * inv;
        misc[64 + i] = cosf(ang); misc[64 + 1024 + i] = sinf(ang);
    }
}
__device__ __forceinline__ void ph_cache(const Ctx& C0, int l, int wg0 = 0) {
    PHASE_CTX(C0);
    if (C.bid < wg0) return;
#pragma unroll 4
    for (int i = (C.bid - wg0) * NT + C.tid; i < 4 * 256 * 128; i += (C.G - wg0) * NT) {
        const int col = (i & 127) * 4, j = (i >> 7) & 255, b = i >> 15;
        const size_t src = ((size_t)(b * 2 + l) * 256 + j) * 512 + col;
        const size_t dst = (size_t)(NPROMPT + b * 2304 + j) * 512 + col;
        const f32x4 kx = *(const f32x4*)(c_cache_k + src), vx = *(const f32x4*)(c_cache_v + src);
        uint2 ko, vo; ko.x = pk2(kx[0], kx[1]); ko.y = pk2(kx[2], kx[3]); vo.x = pk2(vx[0], vx[1]); vo.y = pk2(vx[2], vx[3]);
        *(uint2*)(c_AK + dst) = ko; *(uint2*)(c_AV + dst) = vo;
    }
}
__device__ __forceinline__ void ph_norm(const Ctx& C0, const void* x0, const void* x1, bool in_bf16, const float* g, const float* MODl, int which) {
    PHASE_CTX(C0);
    const int lane = C.lane;
    for (int m = C.bid * NWAVE + C.wave; m < M; m += C.G * NWAVE) {
        const size_t ro = m < NPROMPT ? (size_t)m * D : (size_t)(m - NPROMPT) * D;
        const float* mod = MODl + (size_t)cond_row(m) * 6144 + which * 3072;
        float4 v[4]; float ss = 0.f;
        if (in_bf16) { const bf16_t* xr = (const bf16_t*)(m < NPROMPT ? x0 : x1) + ro;
#pragma unroll
            for (int j = 0; j < 4; ++j) { const uint2 w = *(const uint2*)(xr + j * 256 + lane * 4);
                v[j] = make_float4(__uint_as_float(w.x << 16), __uint_as_float(w.x & 0xffff0000u), __uint_as_float(w.y << 16), __uint_as_float(w.y & 0xffff0000u)); }
        } else { const float* xr = (const float*)(m < NPROMPT ? x0 : x1) + ro;
#pragma unroll
            for (int j = 0; j < 4; ++j) v[j] = *(const float4*)(xr + j * 256 + lane * 4); }
#pragma unroll
        for (int j = 0; j < 4; ++j) ss += v[j].x * v[j].x + v[j].y * v[j].y + v[j].z * v[j].z + v[j].w * v[j].w;
#pragma unroll
        for (int o = 1; o < 32; o <<= 1) ss += shx(ss, o, lane);
        ss = xsum32(ss);
        const float rs = rsqrtf(ss * (1.f / D) + EPS);
#pragma unroll
        for (int j = 0; j < 4; ++j) {
            const int c0 = j * 256 + lane * 4;
            const float4 gg = *(const float4*)(g + c0), sh = *(const float4*)(mod + c0), sc = *(const float4*)(mod + 1024 + c0);
            ushort4 o;
            o.x = f2bf(v[j].x * rs * gg.x * (1.f + sc.x) + sh.x); o.y = f2bf(v[j].y * rs * gg.y * (1.f + sc.y) + sh.y);
            o.z = f2bf(v[j].z * rs * gg.z * (1.f + sc.z) + sh.z); o.w = f2bf(v[j].w * rs * gg.w * (1.f + sc.w) + sh.w);
            *(ushort4*)(c_XN + (size_t)m * D + c0) = o;
        }
    }
}

typedef float f32x16 __attribute__((ext_vector_type(16)));
typedef short s16x4 __attribute__((ext_vector_type(4)));
typedef unsigned u32x4_t __attribute__((ext_vector_type(4)));
constexpr int AT_KROW = 72;
constexpr int AT_VROW = 68;
constexpr int AT_KBYTES = 2 * 64 * AT_KROW * 2, AT_VBYTES = 128 * AT_VROW * 2, AT_BUF = AT_KBYTES + AT_VBYTES;
__device__ __forceinline__ unsigned pk_bf16(float lo, float hi) { return pk2(lo, hi); }
template <int XM = 0>
__device__ __forceinline__ void ph_attn(const Ctx& C0, int l, int item_lo = 0, int item_hi = 512, int nwg = 0) {
    PHASE_CTX(C0);
    const int tid = C.tid, lane = C.lane, w = C.wave, map = w >> 2, qb = w & 3, r32 = lane & 31, hi = lane >> 5;
    unsigned char* lds = C.lds;
    const float* subg = c_subln_g + l * 128;
    const float lam = c_MISC[l];
    const bf16_t* AKp = c_AK; const bf16_t* AVp = c_AV;
    const int sk_key = tid >> 3, sk_ch = tid & 7;
    const int sv_kp = tid & 31, sv_ec = tid >> 5;
    constexpr int AT_NBUF = 3;
    constexpr float CS = 0.125f * 1.4426950408889634f;
    const int NW = nwg > 0 ? nwg : C.G;
    if (C.bid >= NW) return;
    const int vbid = (NW % 8 == 0) ? (C.bid & 7) * (NW / 8) + (C.bid >> 3) : C.bid;
    for (int item = item_lo + vbid; item < item_hi; item += NW) {
        int m0, kr0, Lk, h;
        if (item < 256) { const int b = item >> 3; h = (item >> 1) & 3; const int q2 = item & 1; m0 = b * 256 + q2 * 128; kr0 = b * 256; Lk = 256; }
        else { const int j = item - 256; const int b = j >> 6; h = (j >> 4) & 3; const int q2 = j & 15; m0 = NPROMPT + b * 2048 + q2 * 128; kr0 = NPROMPT + b * 2304; Lk = 2304; }
        const int NTL = Lk >> 6;
        bf16x8* sQ = (bf16x8*)(lds + AT_NBUF * AT_BUF) + (w * 4) * 64 + lane;
        f32x16 o[4];
#pragma unroll
        for (int eb = 0; eb < 4; ++eb)
#pragma unroll
            for (int r = 0; r < 16; ++r) o[eb][r] = 0.f;
        float mrun = -1e30f, lsum = 0.f, alpha = 1.f, mc = 0.f;
        uint4 kreg0, kreg1, vreg0, vreg1;
        unsigned pfw[16];
#define PF(ks_) __builtin_bit_cast(bf16x8, (u32x4_t){pfw[4 * (ks_)], pfw[4 * (ks_) + 1], pfw[4 * (ks_) + 2], pfw[4 * (ks_) + 3]})
        f32x16 pa0, pa1;
#define AT_LOAD(t_) do { const bf16_t* kp_ = AKp + (size_t)(kr0 + (t_) * 64 + sk_key) * 512 + h * 128 + sk_ch * 16; kreg0 = *(const uint4*)kp_; kreg1 = *(const uint4*)(kp_ + 8); \
            const bf16_t* vp_ = AVp + (size_t)(kr0 + (t_) * 64 + 2 * sv_kp) * 512 + h * 128 + sv_ec * 8; vreg0 = *(const uint4*)vp_; vreg1 = *(const uint4*)(vp_ + 512); } while (0)
#define AT_WRITE(t_) do { unsigned char* wb_ = lds + ((t_) % AT_NBUF) * AT_BUF; \
            bf16_t* kd_ = (bf16_t*)wb_ + ((sk_ch >> 2) * 64 + sk_key) * AT_KROW + (sk_ch & 3) * 16; *(uint4*)kd_ = kreg0; *(uint4*)(kd_ + 8) = kreg1; \
            bf16_t* vt_ = (bf16_t*)(wb_ + AT_KBYTES) + (sv_ec * 8) * AT_VROW + 2 * sv_kp; \
            const unsigned a_[4] = {vreg0.x, vreg0.y, vreg0.z, vreg0.w}, b_[4] = {vreg1.x, vreg1.y, vreg1.z, vreg1.w}; \
            _Pragma("unroll") for (int i = 0; i < 4; ++i) { *(unsigned*)(vt_ + (2 * i) * AT_VROW) = (a_[i] & 0xffffu) | (b_[i] << 16); *(unsigned*)(vt_ + (2 * i + 1) * AT_VROW) = (a_[i] >> 16) | (b_[i] & 0xffff0000u); } } while (0)
#define SB() __builtin_amdgcn_sched_barrier(0)
#define AT_M(P0, P1) do { asm volatile("s_nop 15\n\ts_nop 7" : "+v"(P0), "+v"(P1)); float mt_ = -1e30f; \
            _Pragma("unroll") for (int r = 0; r < 16; ++r) asm("v_max3_f32 %0, %1, %2, %3" : "=v"(mt_) : "v"(mt_), "v"(P0[r]), "v"(P1[r])); \
            { const auto rr_ = __builtin_amdgcn_permlane32_swap(__float_as_uint(mt_), __float_as_uint(mt_), false, false); asm("v_max_f32_e32 %0, %1, %2" : "=v"(mt_) : "v"(__uint_as_float(rr_[0])), "v"(__uint_as_float(rr_[1]))); } \
            float mn_; asm("v_max_f32_e32 %0, %1, %2" : "=v"(mn_) : "v"(mrun), "v"(mt_)); \
            alpha = __builtin_amdgcn_exp2f((mrun - mn_) * CS); mrun = mn_; mc = -mn_ * CS; } while (0)
#define AT_EXP2(P, i_) do { if (XM == 2) { P[i_] = __builtin_fmaf(P[i_], CS, mc); P[(i_) + 1] = __builtin_fmaf(P[(i_) + 1], CS, mc); } else { P[i_] = __builtin_amdgcn_exp2f(__builtin_fmaf(P[i_], CS, mc)); P[(i_) + 1] = __builtin_amdgcn_exp2f(__builtin_fmaf(P[(i_) + 1], CS, mc)); } \
            asm volatile("" : "+v"(P[i_]), "+v"(P[(i_) + 1])); } while (0)
#define AT_X(HASV, tv_, P0, P1) do { const bf16_t* sVt_ = (const bf16_t*)(lds + ((tv_) % AT_NBUF) * AT_BUF + AT_KBYTES) + r32 * AT_VROW + 4 * hi; \
            _Pragma("unroll") for (int eb = 0; eb < 4; ++eb) { s16x4 vl_[4], vh_[4]; \
                if (HASV) { _Pragma("unroll") for (int ks = 0; ks < 4; ++ks) { vl_[ks] = *(const s16x4*)(sVt_ + eb * 32 * AT_VROW + ks * 16); vh_[ks] = *(const s16x4*)(sVt_ + eb * 32 * AT_VROW + ks * 16 + 8); } SB(); } \
                _Pragma("unroll") for (int ks = 0; ks < 4; ++ks) { \
                    if (HASV) { const bf16x8 vf_ = __builtin_shufflevector(vl_[ks], vh_[ks], 0, 1, 2, 3, 4, 5, 6, 7); o[eb] = __builtin_amdgcn_mfma_f32_32x32x16_bf16(vf_, PF(ks), o[eb], 0, 0, 0); } \
                    if (eb < 2) AT_EXP2(P0, eb * 8 + ks * 2); else AT_EXP2(P1, (eb - 2) * 8 + ks * 2); SB(); } } } while (0)
#define AT_Q(t_, P0, P1) do { const bf16_t* sKm_ = (const bf16_t*)(lds + ((t_) % AT_NBUF) * AT_BUF) + (map * 64) * AT_KROW + r32 * AT_KROW + hi * 8; \
            bf16x8 kf0_[4], kf1_[4], qf_[4]; \
            _Pragma("unroll") for (int s4 = 0; s4 < 4; ++s4) { qf_[s4] = sQ[s4 * 64]; kf0_[s4] = *(const bf16x8*)(sKm_ + s4 * 16); kf1_[s4] = *(const bf16x8*)(sKm_ + 32 * AT_KROW + s4 * 16); } \
            _Pragma("unroll") for (int r = 0; r < 16; ++r) { P0[r] = 0.f; P1[r] = 0.f; } SB(); \
            _Pragma("unroll") for (int s4 = 0; s4 < 4; ++s4) { P0 = __builtin_amdgcn_mfma_f32_32x32x16_bf16(kf0_[s4], qf_[s4], P0, 0, 0, 0); P1 = __builtin_amdgcn_mfma_f32_32x32x16_bf16(kf1_[s4], qf_[s4], P1, 0, 0, 0); } } while (0)
#define AT_S(P0, P1) do { float ps_ = 0.f; \
            _Pragma("unroll") for (int c = 0; c < 4; ++c) { ps_ += (P0[4 * c] + P0[4 * c + 1]) + (P0[4 * c + 2] + P0[4 * c + 3]) + (P1[4 * c] + P1[4 * c + 1]) + (P1[4 * c + 2] + P1[4 * c + 3]); \
                pfw[4 * (c >> 1) + (c & 1) * 2] = pk2_valu(P0[4 * c], P0[4 * c + 1]); pfw[4 * (c >> 1) + (c & 1) * 2 + 1] = pk2_valu(P0[4 * c + 2], P0[4 * c + 3]); \
                pfw[8 + 4 * (c >> 1) + (c & 1) * 2] = pk2_valu(P1[4 * c], P1[4 * c + 1]); pfw[8 + 4 * (c >> 1) + (c & 1) * 2 + 1] = pk2_valu(P1[4 * c + 2], P1[4 * c + 3]); } \
            lsum += ps_; } while (0)
#define AT_RESCALE() do { if (__any(alpha != 1.f)) { lsum *= alpha; _Pragma("unroll") for (int eb = 0; eb < 4; ++eb) _Pragma("unroll") for (int r = 0; r < 16; ++r) o[eb][r] *= alpha; } } while (0)
#define AT_STEP(t_) do { \
            if (XM != 5) { AT_Q(t_, pa0, pa1); } AT_M(pa0, pa1); \
            if ((t_) > 0 && XM != 3) { AT_X(true, (t_) - 1, pa0, pa1); } else { AT_X(false, 0, pa0, pa1); } \
            AT_RESCALE(); AT_S(pa0, pa1); \
            if (XM != 6) __syncthreads();                        \
            if ((t_) + 2 < NTL && XM != 4) { AT_WRITE((t_) + 2); if ((t_) + 3 < NTL) AT_LOAD((t_) + 3); } } while (0)
        { const bf16_t* qp = c_AQ + (size_t)(m0 + qb * 32 + r32) * 512 + h * 128 + map * 64 + hi * 8;
#pragma unroll
          for (int s4 = 0; s4 < 4; ++s4) sQ[s4 * 64] = *(const bf16x8*)(qp + s4 * 16); }
        AT_LOAD(0);
        __syncthreads();
        AT_WRITE(0); AT_LOAD(1); AT_WRITE(1); AT_LOAD(2);
        __syncthreads();
        AT_STEP(0); alpha = 1.f;
#pragma unroll 1
        for (int t = 1; t < NTL; ++t) { AT_STEP(t); }
        { const bf16_t* sVt_ = (const bf16_t*)(lds + ((NTL - 1) % AT_NBUF) * AT_BUF + AT_KBYTES) + r32 * AT_VROW + 4 * hi;
#pragma unroll
          for (int eb = 0; eb < 4; ++eb)
#pragma unroll
              for (int ks = 0; ks < 4; ++ks) { const s16x4 lo = *(const s16x4*)(sVt_ + eb * 32 * AT_VROW + ks * 16), hv = *(const s16x4*)(sVt_ + eb * 32 * AT_VROW + ks * 16 + 8);
                  o[eb] = __builtin_amdgcn_mfma_f32_32x32x16_bf16(__builtin_shufflevector(lo, hv, 0, 1, 2, 3, 4, 5, 6, 7), PF(ks), o[eb], 0, 0, 0); } }
#undef PF
#undef AT_Q
#undef AT_S
#undef AT_LOAD
#undef AT_WRITE
#undef SB
#undef AT_M
#undef AT_EXP2
#undef AT_X
#undef AT_RESCALE
#undef AT_STEP
        lsum = xsum32(lsum);
        const float inv = 1.f / lsum;
        __syncthreads();
        float* xb = (float*)lds + (size_t)qb * (32 * 129);
        if (map == 1) {
#pragma unroll
            for (int eb = 0; eb < 4; ++eb)
#pragma unroll
                for (int r = 0; r < 16; ++r) xb[r32 * 129 + eb * 32 + (r & 3) + 8 * (r >> 2) + 4 * hi] = o[eb][r] * inv;
        }
        __syncthreads();
        if (map == 0 && (XM == 0 || lsum == 12345.678f)) {
            float ss = 0.f;
#pragma unroll
            for (int eb = 0; eb < 4; ++eb)
#pragma unroll
                for (int r = 0; r < 16; ++r) { const float d = o[eb][r] * inv - lam * xb[r32 * 129 + eb * 32 + (r & 3) + 8 * (r >> 2) + 4 * hi]; o[eb][r] = d; ss += d * d; }
            ss = xsum32(ss);
            const float lam_init = 0.8f - 0.6f * __expf(-0.3f * (float)l);
            const float rs = rsqrtf(ss * (1.f / 128.f) + EPS) * (1.f - lam_init);
            bf16_t* op = c_OA + (size_t)(m0 + qb * 32 + r32) * 512 + h * 128;
#pragma unroll
            for (int eb = 0; eb < 4; ++eb)
#pragma unroll
                for (int r4 = 0; r4 < 4; ++r4) {
                    const int e0 = eb * 32 + 8 * r4 + 4 * hi;
                    uint2 wv;
                    wv.x = pk_bf16(o[eb][4 * r4] * rs * subg[e0], o[eb][4 * r4 + 1] * rs * subg[e0 + 1]);
                    wv.y = pk_bf16(o[eb][4 * r4 + 2] * rs * subg[e0 + 2], o[eb][4 * r4 + 3] * rs * subg[e0 + 3]);
                    *(uint2*)(op + e0) = wv;
                }
        }
    }
}

constexpr int GT = 64;
constexpr size_t G_QK = 0;
constexpr size_t G_KDT = 48 * MiB;
constexpr size_t G_VT = 64 * MiB;
constexpr size_t G_SST = 80 * MiB;
constexpr size_t G_DEC = 112 * MiB;
constexpr size_t G_CQB = 112 * MiB + 524288;
__device__ __forceinline__ void ph_gla_prep(const Ctx& C0, int l) {
    PHASE_CTX(C0);
    const int tid = C.tid, dir = tid >> 8, h = (tid >> 6) & 3, kc = tid & 63, c = h * 64 + kc;
    float* sBR = (float*)C.lds;
    float* sPre = (float*)(C.lds + 8192);
    unsigned char* gb = WS_ + W_GLA;
    float wa[16];
#pragma unroll
    for (int r = 0; r < 16; ++r) wa[r] = c_gla_wa2[(((size_t)l * 2 + dir) * 16 + r) * 256 + c];
    const float bias = c_gla_ba[((size_t)l * 2 + dir) * 256 + c];
    bf16_t* QA = (bf16_t*)(gb + G_QK + (size_t)(dir * 3 + 0) * 8 * MiB); bf16_t* KA = (bf16_t*)(gb + G_QK + (size_t)(dir * 3 + 1) * 8 * MiB);
    for (int gc = C.bid; gc < 256; gc += C.G) {
        const int m0 = gc * GT;
        __syncthreads();
        { const float4* src = (const float4*)(c_BR + (size_t)m0 * 32); ((float4*)sBR)[tid] = src[tid]; }
        __syncthreads();
        float run = 0.f;
#pragma unroll 4
        for (int t = 0; t < 64; ++t) {
            float x = bias;
#pragma unroll
            for (int r = 0; r < 16; ++r) x += sBR[t * 32 + dir * 16 + r] * wa[r];
            const float ls = fminf(x, 0.f) - __logf(1.f + __expf(-fabsf(x)));
            run += ls * (1.f / 16.f); sPre[t * 512 + tid] = run;
        }
        const float p31 = sPre[31 * 512 + tid], p63 = run;
        const float cqb = __expf(dir == 0 ? p31 : p63 - p31), ckd = __expf(dir == 0 ? p63 - p31 : p31);
        bf16_t* KDT = (bf16_t*)(gb + G_KDT) + ((((size_t)gc * 4 + h) * 2 + dir) * 64 + kc) * 64;
        const bf16_t* BQp = c_BQ; const bf16_t* BKp = c_BK;
        bf16_t qn[8], kn[8];
#pragma unroll
        for (int tt = 0; tt < 8; ++tt) { const size_t idx = (size_t)(m0 + tt) * 256 + c; qn[tt] = BQp[idx]; kn[tt] = BKp[idx]; }
#pragma unroll 1
        for (int t8 = 0; t8 < 8; ++t8) {
            unsigned kdw[4];
            bf16_t qc[8], kc8[8];
#pragma unroll
            for (int tt = 0; tt < 8; ++tt) { qc[tt] = qn[tt]; kc8[tt] = kn[tt]; }
            { const int tn = t8 < 7 ? (t8 + 1) * 8 : 56;
#pragma unroll
              for (int tt = 0; tt < 8; ++tt) { const size_t idx = (size_t)(m0 + tn + tt) * 256 + c; qn[tt] = BQp[idx]; kn[tt] = BKp[idx]; } }
#pragma unroll
            for (int tt = 0; tt < 8; ++tt) {
                const int t = t8 * 8 + tt;
                const int te = dir == 0 ? t : t - 1;
                const float e = te < 0 ? 0.f : sPre[(te < 0 ? 0 : te) * 512 + tid];
                const float d = e - p31;
                const size_t idx = (size_t)(m0 + t) * 256 + c;
                const float qv = bf2f(qc[tt]), kv = bf2f(kc8[tt]);
                const float ed = __expf(dir == 0 ? d : -d), eid = __expf(dir == 0 ? -d : d);
                QA[idx] = f2bf(qv * ed); KA[idx] = f2bf(kv * eid);
                const float kd = kv * eid * ckd;
                if (tt & 1) kdw[tt >> 1] |= (unsigned)f2bf(kd) << 16; else kdw[tt >> 1] = (unsigned)f2bf(kd);
            }
            *(uint4*)(KDT + t8 * 8) = make_uint4(kdw[0], kdw[1], kdw[2], kdw[3]);
        }
        ((float*)(gb + G_DEC))[(((size_t)gc * 4 + h) * 2 + dir) * 64 + kc] = __expf(p63);
        ((float*)(gb + G_CQB))[(((size_t)gc * 4 + h) * 2 + dir) * 64 + kc] = cqb;
        { const int hv = tid >> 7, vv = tid & 127; const bf16_t* BVp = c_BV;
          bf16_t* VT = (bf16_t*)(gb + G_VT) + (((size_t)gc * 4 + hv) * 128 + vv) * 64;
#pragma unroll 4
          for (int t8 = 0; t8 < 8; ++t8) { unsigned w4[4];
#pragma unroll
              for (int tt = 0; tt < 8; ++tt) { const unsigned x = BVp[(size_t)(m0 + t8 * 8 + tt) * 512 + hv * 128 + vv]; if (tt & 1) w4[tt >> 1] |= x << 16; else w4[tt >> 1] = x; }
              *(uint4*)(VT + t8 * 8) = make_uint4(w4[0], w4[1], w4[2], w4[3]); } }
        __syncthreads();
        { const int lane = C.lane, wv = C.wave, hh = wv >> 1, dd_ = wv & 1, r32 = lane & 31, hi = lane >> 5;
          const size_t cu = ((size_t)gc * 4 + hh) * 2 + dd_;
          const bf16_t* vtb = (const bf16_t*)(gb + G_VT) + ((size_t)gc * 4 + hh) * 128 * 64;
          const bf16_t* kdb = (const bf16_t*)(gb + G_KDT) + cu * 64 * 64;
          bf16_t* DS = WSP(bf16_t, W_GDS) + cu * 128 * 64;
#pragma unroll 2
          for (int t = 0; t < 8; ++t) { const int vb = t & 3, kb = t >> 2;
              f32x16 acc;
#pragma unroll
              for (int r = 0; r < 16; ++r) acc[r] = 0.f;
              bf16x8 a4[4], b4[4];
#pragma unroll
              for (int s4 = 0; s4 < 4; ++s4) { a4[s4] = *(const bf16x8*)(vtb + (size_t)(vb * 32 + r32) * 64 + s4 * 16 + hi * 8); b4[s4] = *(const bf16x8*)(kdb + (size_t)(kb * 32 + r32) * 64 + s4 * 16 + hi * 8); }
#pragma unroll
              for (int s4 = 0; s4 < 4; ++s4) acc = __builtin_amdgcn_mfma_f32_32x32x16_bf16(a4[s4], b4[s4], acc, 0, 0, 0);
#pragma unroll
              for (int r = 0; r < 16; ++r) DS[(size_t)(vb * 32 + (r & 3) + 8 * (r >> 2) + 4 * hi) * 64 + kb * 32 + r32] = f2bf(acc[r]); } }
    }
}
__device__ __forceinline__ int crow16(int r, int hi) { return (r & 3) + 8 * (r >> 2) + 4 * hi; }
__device__ __forceinline__ void ph_gla_scan(const Ctx& C0, int l) {
    PHASE_CTX(C0);
    const int tid = C.tid;
    unsigned char* gb = WS_ + W_GLA;
    const bf16_t* DSb = WSP(bf16_t, W_GDS);
    for (int task = C.bid; task < 576; task += C.G) {
        const int it = task < 64 ? 287 - (task >> 1) : (task - 64) >> 1, part = task & 1;
        const int dir = it & 1, h = (it >> 1) & 3, s = it >> 3;
        const bool latent = s >= 32;
        const int nch = latent ? 32 : 4, gc0 = latent ? 128 + (s - 32) * 32 : s * 4;
        const int v = part * 64 + (tid >> 3), kc0 = (tid & 7) * 8;
        float* sDec = (float*)C.lds; float* sCqb = sDec + 32 * 64;
        __syncthreads();
        for (int i = tid; i < nch * 64; i += NT) { const int n = i >> 6, kc = i & 63, gc = gc0 + (dir == 0 ? n : nch - 1 - n); const size_t cu = ((size_t)gc * 4 + h) * 2 + dir;
            sDec[i] = ((const float*)(gb + G_DEC))[cu * 64 + kc]; sCqb[i] = ((const float*)(gb + G_CQB))[cu * 64 + kc]; }
        float S[8];
        if (latent) { const float* si = c_state_gla + ((((size_t)(s - 32) * 2 + l) * 2 + dir) * 4 + h) * 8192 + v;
#pragma unroll
            for (int e = 0; e < 8; ++e) S[e] = si[(size_t)(kc0 + e) * 128]; }
        else {
#pragma unroll
            for (int e = 0; e < 8; ++e) S[e] = 0.f; }
        __syncthreads();
        const int nb = latent ? 16 : 4;
#pragma unroll 1
        for (int n0 = 0; n0 < nch; n0 += nb) {
            uint4 dsw[16];
#pragma unroll
            for (int b = 0; b < 16; ++b) if (b < nb) {
                const int gc = gc0 + (dir == 0 ? n0 + b : nch - 1 - n0 - b);
                const size_t cu = ((size_t)gc * 4 + h) * 2 + dir;
                dsw[b] = *(const uint4*)(DSb + (cu * 128 + v) * 64 + kc0); }
#pragma unroll
            for (int b = 0; b < 16; ++b) if (b < nb) {
                const int gc = gc0 + (dir == 0 ? n0 + b : nch - 1 - n0 - b);
                const size_t cu = ((size_t)gc * 4 + h) * 2 + dir;
                const f32x4 q0 = *(const f32x4*)(sCqb + (n0 + b) * 64 + kc0), q1 = *(const f32x4*)(sCqb + (n0 + b) * 64 + kc0 + 4), d0 = *(const f32x4*)(sDec + (n0 + b) * 64 + kc0), d1 = *(const f32x4*)(sDec + (n0 + b) * 64 + kc0 + 4);
                uint4 st; st.x = pk2(S[0] * q0[0], S[1] * q0[1]); st.y = pk2(S[2] * q0[2], S[3] * q0[3]); st.z = pk2(S[4] * q1[0], S[5] * q1[1]); st.w = pk2(S[6] * q1[2], S[7] * q1[3]);
                *(uint4*)((bf16_t*)(gb + G_SST) + (cu * 128 + v) * 64 + kc0) = st;
                const unsigned dw[4] = {dsw[b].x, dsw[b].y, dsw[b].z, dsw[b].w}; const float dc[8] = {d0[0], d0[1], d0[2], d0[3], d1[0], d1[1], d1[2], d1[3]};
#pragma unroll
                for (int q = 0; q < 4; ++q) { S[2 * q] = dc[2 * q] * S[2 * q] + __uint_as_float(dw[q] << 16); S[2 * q + 1] = dc[2 * q + 1] * S[2 * q + 1] + __uint_as_float(dw[q] & 0xffff0000u); }
            }
        }
        if (!latent) { float* so = c_out + O_NG + ((((size_t)s * 2 + l) * 2 + dir) * 4 + h) * 8192 + v;
#pragma unroll
            for (int e = 0; e < 8; ++e) so[(size_t)(kc0 + e) * 128] = S[e]; }
    }
}
__device__ __forceinline__ void ph_gla_out(const Ctx& C0, int l) {
    PHASE_CTX(C0);
    const int lane = C.lane, r32 = lane & 31, hi = lane >> 5;
    unsigned char* gb = WS_ + W_GLA;
    float* sO = (float*)C.lds + C.wave * (32 * 132);
    const float* ong = c_gla_on_g + l * 128;
    const bool bal = C.G == 256;
    const int nw = bal ? 1024 : C.G * NWAVE, wv = bal ? (C.bid - 128) * NWAVE + C.wave : C.bid * NWAVE + C.wave;
    if (bal && C.bid < 128) return;
    for (int task = wv; task < 2048; task += nw) {
        const int gc = task >> 3, h = (task >> 1) & 3, jb = task & 1, m0 = gc * GT;
        f32x16 o[4];
#pragma unroll
        for (int vq = 0; vq < 4; ++vq)
#pragma unroll
            for (int r = 0; r < 16; ++r) o[vq][r] = 0.f;
#pragma unroll
        for (int dir = 0; dir < 2; ++dir) {
            const bf16_t* QA = (const bf16_t*)(gb + G_QK + (size_t)(dir * 3 + 0) * 8 * MiB); const bf16_t* KA = (const bf16_t*)(gb + G_QK + (size_t)(dir * 3 + 1) * 8 * MiB);
            const size_t cu = ((size_t)gc * 4 + h) * 2 + dir;
            bf16x8 qf[4], kf[2][4];
            { const bf16_t* qp = QA + (size_t)(m0 + jb * 32 + r32) * 256 + h * 64 + hi * 8;
              const bf16_t* kp0 = KA + (size_t)(m0 + r32) * 256 + h * 64 + hi * 8; const bf16_t* kp1 = kp0 + (size_t)32 * 256;
#pragma unroll
              for (int s4 = 0; s4 < 4; ++s4) { qf[s4] = *(const bf16x8*)(qp + s4 * 16); kf[0][s4] = *(const bf16x8*)(kp0 + s4 * 16); kf[1][s4] = *(const bf16x8*)(kp1 + s4 * 16); } }
            const bf16_t* vtb = (const bf16_t*)(gb + G_VT) + (((size_t)gc * 4 + h) * 128 + r32) * 64 + 4 * hi;
            const bf16_t* stb = (const bf16_t*)(gb + G_SST) + (cu * 128 + r32) * 64 + hi * 8;
            s16x4 vlo[2][4], vhi[2][4]; bf16x8 sf[2][4];
#define GO_LOADV(b_, vq_) do { _Pragma("unroll") for (int s4 = 0; s4 < 4; ++s4) { vlo[b_][s4] = *(const s16x4*)(vtb + (size_t)(vq_) * 32 * 64 + s4 * 16); vhi[b_][s4] = *(const s16x4*)(vtb + (size_t)(vq_) * 32 * 64 + s4 * 16 + 8); sf[b_][s4] = *(const bf16x8*)(stb + (size_t)(vq_) * 32 * 64 + s4 * 16); } } while (0)
            GO_LOADV(0, 0);
            bf16x8 pf[4];
#pragma unroll
            for (int ib = 0; ib < 2; ++ib) {
                f32x16 p;
#pragma unroll
                for (int r = 0; r < 16; ++r) p[r] = 0.f;
#pragma unroll
                for (int s4 = 0; s4 < 4; ++s4) p = __builtin_amdgcn_mfma_f32_32x32x16_bf16(kf[ib][s4], qf[s4], p, 0, 0, 0);
                const int j = jb * 32 + r32;
#pragma unroll
                for (int r = 0; r < 16; ++r) { const int i = ib * 32 + crow16(r, hi); const bool keep = dir == 0 ? (i <= j) : (i >= j); if (!keep) p[r] = 0.f; }
#pragma unroll
                for (int s2 = 0; s2 < 2; ++s2) { union { bf16x8 v; unsigned u[4]; } a;
#pragma unroll
                    for (int q = 0; q < 4; ++q) a.u[q] = pk2(p[8 * s2 + 2 * q], p[8 * s2 + 2 * q + 1]);
                    pf[2 * ib + s2] = a.v; }
            }
#pragma unroll
            for (int vq = 0; vq < 4; ++vq) {
                if (vq < 3) GO_LOADV((vq + 1) & 1, vq + 1);
#pragma unroll
                for (int ks = 0; ks < 4; ++ks) { const bf16x8 vf = __builtin_shufflevector(vlo[vq & 1][ks], vhi[vq & 1][ks], 0, 1, 2, 3, 4, 5, 6, 7);
                    o[vq] = __builtin_amdgcn_mfma_f32_32x32x16_bf16(vf, pf[ks], o[vq], 0, 0, 0); }
#pragma unroll
                for (int s4 = 0; s4 < 4; ++s4) o[vq] = __builtin_amdgcn_mfma_f32_32x32x16_bf16(sf[vq & 1][s4], qf[s4], o[vq], 0, 0, 0);
            }
#undef GO_LOADV
        }
        float ss = 0.f;
#pragma unroll
        for (int vq = 0; vq < 4; ++vq)
#pragma unroll
            for (int r = 0; r < 16; ++r) ss += o[vq][r] * o[vq][r];
        ss = xsum32(ss);
        const float rs = rsqrtf(ss * (1.f / 128.f) + EPS);
#pragma unroll
        for (int vq = 0; vq < 4; ++vq)
#pragma unroll
            for (int q4 = 0; q4 < 4; ++q4) *(float4*)(sO + r32 * 132 + vq * 32 + 8 * q4 + 4 * hi) = make_float4(o[vq][4 * q4] * rs, o[vq][4 * q4 + 1] * rs, o[vq][4 * q4 + 2] * rs, o[vq][4 * q4 + 3] * rs);
        { const int j = lane >> 1, vc = (lane & 1) * 64; const float* row = sO + j * 132 + vc;
          const size_t off = (size_t)(m0 + jb * 32 + j) * 512 + h * 128 + vc;
          const bf16_t* BGp = c_BG + off; bf16_t* OBp = c_OB + off;
#pragma unroll
          for (int c8 = 0; c8 < 8; ++c8) {
              const float4 f0 = *(const float4*)(row + c8 * 8), f1 = *(const float4*)(row + c8 * 8 + 4);
              const uint4 gr = *(const uint4*)(BGp + c8 * 8); const float* og = ong + vc + c8 * 8;
              uint4 ow;
              ow.x = pk2(f0.x * og[0] * __uint_as_float(gr.x << 16), f0.y * og[1] * __uint_as_float(gr.x & 0xffff0000u));
              ow.y = pk2(f0.z * og[2] * __uint_as_float(gr.y << 16), f0.w * og[3] * __uint_as_float(gr.y & 0xffff0000u));
              ow.z = pk2(f1.x * og[4] * __uint_as_float(gr.z << 16), f1.y * og[5] * __uint_as_float(gr.z & 0xffff0000u));
              ow.w = pk2(f1.z * og[6] * __uint_as_float(gr.w << 16), f1.w * og[7] * __uint_as_float(gr.w & 0xffff0000u));
              *(uint4*)(OBp + c8 * 8) = ow; } }
    }
}

namespace pg8 {
#define PG8_LAS __attribute__((address_space(3)))
typedef unsigned short bf16_t;
typedef short bf16x8 __attribute__((ext_vector_type(8)));
typedef float f32x4 __attribute__((ext_vector_type(4)));
typedef unsigned u32x4 __attribute__((ext_vector_type(4)));
constexpr int BM = 256, BK = 64, HALF = 128, HTB = HALF * BK * 2  , STAGE_BYTES = 8 * HTB, NXCD = 8, WGM = 8;

__host__ __device__ __forceinline__ int lds_byte(int r, int c) { const int st = (r >> 4) * 2 + (c >> 5), rr = r & 15, cc = c & 31, ob = rr * 64 + cc * 2; return st * 1024 + (ob ^ (((ob >> 9) & 1) << 5)); }
__host__ __device__ __forceinline__ void stage_rc(int b, int& R, int& C) { const int st = b / 1024, sb = b % 1024, swz = sb ^ (((sb >> 9) & 1) << 5); R = (st >> 1) * 16 + swz / 64; C = (st & 1) * 32 + (swz % 64) / 2; }
__host__ __device__ __forceinline__ int perm32(int rho) { const int n = rho >> 4, i = rho & 15; return 8 * (i >> 2) + 4 * n + (i & 3); }

struct Unit { int pm, pn, z, h; };
struct Gemm { const bf16_t* A; const bf16_t* Bt; int M, N, K; size_t za, zb; int lda, ldb; };

struct StaticOrder {
    int nM, nN, nwg, G, c;
    __host__ __device__ void init(int M, int N, int G_, int c_) { nM = M / BM; nN = N / BM; nwg = nM * nN; G = G_; c = c_; }
    static constexpr bool HALF = false;
    __host__ __device__ void map(int L, Unit& u) const {
        int wgid = L; { const int q = nwg / NXCD, r = nwg % NXCD, xcd = wgid % NXCD, off = wgid / NXCD; wgid = (xcd < r ? xcd * (q + 1) : r * (q + 1) + (xcd - r) * q) + off; }
        const int nig = WGM * nN, gid = wgid / nig, fm = gid * WGM, gsz = (nM - fm) < WGM ? (nM - fm) : WGM;
        u.pm = fm + ((wgid % nig) % gsz); u.pn = (wgid % nig) / gsz; u.z = 0; u.h = 0;
    }
    __host__ __device__ bool next(int i, Unit& u) const {
        const long L = (long)i * G + c; if (L >= nwg) return false;
        map((int)L, u); return true;
    }
    __device__ __forceinline__ void a_ready(const Unit&) const {}
    __device__ __forceinline__ void done(const Unit&) const {}
};
__device__ __forceinline__ unsigned cvt_pk_bf16(float lo, float hi) { unsigned r; asm volatile("v_cvt_pk_bf16_f32 %0, %1, %2" : "=v"(r) : "v"(lo), "v"(hi)); return r; }
typedef float f32x2 __attribute__((ext_vector_type(2)));
template <class Epi, class Sched, bool ALIGN_EPI = false, bool SP2 = false>
__device__ __forceinline__ void gemm_phase(PG8_LAS unsigned char* lds, const Gemm g, const Sched& S, const Epi& E) {
    int tid_ = threadIdx.x; asm volatile("" : "+v"(tid_));
    const int tid = tid_, wid = __builtin_amdgcn_readfirstlane(tid >> 6), lane = tid & 63, wr = wid >> 2, wc = wid & 3, fr = lane & 15, fq = lane >> 4;
    const int K = g.K, nt = K / BK;
    unsigned voffA[2], voffB[2];
#pragma unroll
    for (int i = 0; i < 2; ++i) { int R, C; stage_rc(tid * 16 + i * 8192, R, C); const int Rb = Epi::PERM ? ((R & ~31) + perm32(R & 31)) : R;
        voffA[i] = (unsigned)(R * g.lda + C) * 2u; voffB[i] = (unsigned)(Rb * g.ldb + C) * 2u; }
    const size_t kstep = (size_t)(BK * 2);
    const size_t hstepA = (size_t)HALF * g.lda * 2, hstepB = (size_t)HALF * g.ldb * 2;
    const size_t tstepA = 2 * hstepA, tstepB = 2 * hstepB;
    const unsigned ldsw = (unsigned)wid * 1024u;
    const int aoff = lds_byte(wr * 64 + fr, fq * 8), boff = lds_byte(wc * 32 + fr, fq * 8);
#define PG8_SA(b, h) (((b) * 2 + (h)) * HTB)
#define PG8_SB(b, h) ((4 + (b) * 2 + (h)) * HTB)
#define PG8_STAGE(bufoff, gbase, voff) do { _Pragma("unroll") for (int _i = 0; _i < 2; ++_i) \
        __builtin_amdgcn_global_load_lds((const unsigned*)((const char*)(gbase) + (voff)[_i]), (PG8_LAS unsigned*)(lds + (bufoff) + ldsw + _i * 8192), 16, 0, 0); } while (0)
#define PG8_LDA(dst, b, h) do { _Pragma("unroll") for (int m = 0; m < 4; ++m) _Pragma("unroll") for (int k = 0; k < 2; ++k) dst[m][k] = *(const PG8_LAS bf16x8*)(lds + PG8_SA(b, h) + aoff + m * 2048 + k * 1024); } while (0)
#define PG8_LDB(dst, b, h) do { _Pragma("unroll") for (int n = 0; n < 2; ++n) _Pragma("unroll") for (int k = 0; k < 2; ++k) dst[n][k] = *(const PG8_LAS bf16x8*)(lds + PG8_SB(b, h) + boff + n * 2048 + k * 1024); } while (0)
#define PG8_MMA(ai, bj, At, Bt) do { __builtin_amdgcn_s_setprio(1); _Pragma("unroll") for (int m = 0; m < 4; ++m) _Pragma("unroll") for (int n = 0; n < 2; ++n) _Pragma("unroll") for (int k = 0; k < 2; ++k) \
        acc[ai][bj][m][n] = __builtin_amdgcn_mfma_f32_16x16x32_bf16(Bt[n][k], At[m][k], acc[ai][bj][m][n], 0, 0, 0); __builtin_amdgcn_s_setprio(0); } while (0)
#define PG8_WAIT_V(n) asm volatile("s_waitcnt vmcnt(" #n ")" ::: "memory")
#define PG8_WAIT_L(n) asm volatile("s_waitcnt lgkmcnt(" #n ")" ::: "memory")
#define PG8_BAR __builtin_amdgcn_s_barrier()
#define PG8_SCHED __builtin_amdgcn_sched_barrier(0)
    Unit cur, nxt; int ui = 0;
    if (!S.next(0, cur)) return;
    f32x4 acc[2][2][4][2];
#pragma unroll
    for (int a = 0; a < 2; ++a)
#pragma unroll
        for (int b = 0; b < 2; ++b)
#pragma unroll
            for (int m = 0; m < 4; ++m)
#pragma unroll
                for (int n = 0; n < 2; ++n) acc[a][b][m][n] = (f32x4){0.f, 0.f, 0.f, 0.f};
    bf16x8 At[4][2], B0[2][2], B1[2][2];
    const char* cA = (const char*)g.A + (size_t)cur.pm * tstepA + (size_t)cur.z * g.za; const char* cB = (const char*)g.Bt + (size_t)cur.pn * tstepB + (size_t)cur.z * g.zb;
    S.a_ready(cur);
    if constexpr (SP2) {
        PG8_STAGE(PG8_SB(0, 0), cB, voffB); PG8_STAGE(PG8_SB(0, 1), cB + hstepB, voffB); PG8_STAGE(PG8_SA(0, 0), cA, voffA); PG8_STAGE(PG8_SA(0, 1), cA + hstepA, voffA);
        if (wr == 1) PG8_BAR;
        PG8_WAIT_V(2); PG8_BAR;
        PG8_STAGE(PG8_SB(1, 0), cB + kstep, voffB); PG8_STAGE(PG8_SA(1, 0), cA + kstep, voffA); PG8_STAGE(PG8_SB(1, 1), cB + hstepB + kstep, voffB);
        PG8_WAIT_V(6); PG8_BAR;
    } else {
        PG8_STAGE(PG8_SB(0, 0), cB, voffB); PG8_STAGE(PG8_SA(0, 0), cA, voffA); PG8_STAGE(PG8_SB(0, 1), cB + hstepB, voffB); PG8_STAGE(PG8_SA(0, 1), cA + hstepA, voffA);
        if (wr == 1) PG8_BAR;
        PG8_WAIT_V(4); PG8_BAR;
        PG8_STAGE(PG8_SB(1, 0), cB + kstep, voffB); PG8_STAGE(PG8_SA(1, 0), cA + kstep, voffA); PG8_STAGE(PG8_SB(1, 1), cB + hstepB + kstep, voffB);
        PG8_WAIT_V(6); PG8_BAR;
    }
    for (;;) {
        const bool has_next = S.next(ui + 1, nxt);
        const char* nA = has_next ? (const char*)g.A + (size_t)nxt.pm * tstepA + (size_t)nxt.z * g.za : cA; const char* nB = has_next ? (const char*)g.Bt + (size_t)nxt.pn * tstepB + (size_t)nxt.z * g.zb : cB;
        for (int t = 0; t < nt; t += 2) {
            const bool last = (t == nt - 2);
            const char* a1 = cA + (size_t)(t + 1) * kstep;
            const char* a2 = last ? nA : cA + (size_t)(t + 2) * kstep; const char* b2 = last ? nB : cB + (size_t)(t + 2) * kstep;
            const char* a3 = a2 + kstep; const char* b3 = b2 + kstep;
            if (last && has_next) S.a_ready(nxt);
            if constexpr (SP2) {
            PG8_LDB(B0, 0, 0); PG8_LDB(B1, 0, 1); PG8_SCHED; PG8_LDA(At, 0, 0); PG8_STAGE(PG8_SA(1, 1), a1 + hstepA, voffA);
            PG8_WAIT_V(8); PG8_WAIT_L(0); PG8_BAR; if (!Sched::HALF || cur.h != 2) { PG8_MMA(0, 0, At, B0); PG8_MMA(0, 1, At, B1); } PG8_BAR; PG8_SCHED;
            PG8_LDA(At, 0, 1); PG8_STAGE(PG8_SB(0, 0), b2, voffB); PG8_STAGE(PG8_SB(0, 1), b2 + hstepB, voffB); PG8_STAGE(PG8_SA(0, 0), a2, voffA);
            PG8_WAIT_V(8); PG8_WAIT_L(0); PG8_BAR; if (!Sched::HALF || cur.h != 1) { PG8_MMA(1, 0, At, B0); PG8_MMA(1, 1, At, B1); } PG8_BAR; PG8_SCHED;
            PG8_LDB(B0, 1, 0); PG8_LDB(B1, 1, 1); PG8_SCHED; PG8_LDA(At, 1, 0); PG8_STAGE(PG8_SA(0, 1), a2 + hstepA, voffA);
            PG8_WAIT_V(8); PG8_WAIT_L(0); PG8_BAR; if (!Sched::HALF || cur.h != 2) { PG8_MMA(0, 0, At, B0); PG8_MMA(0, 1, At, B1); } PG8_BAR; PG8_SCHED;
            PG8_LDA(At, 1, 1); PG8_STAGE(PG8_SB(1, 0), b3, voffB); PG8_STAGE(PG8_SB(1, 1), b3 + hstepB, voffB); PG8_STAGE(PG8_SA(1, 0), a3, voffA);
            PG8_WAIT_V(8); PG8_WAIT_L(0); PG8_BAR; if (!Sched::HALF || cur.h != 1) { PG8_MMA(1, 0, At, B0); PG8_MMA(1, 1, At, B1); } PG8_BAR; PG8_SCHED;
            } else {
            PG8_LDB(B0, 0, 0); PG8_SCHED; PG8_LDA(At, 0, 0); PG8_STAGE(PG8_SA(1, 1), a1 + hstepA, voffA);
            PG8_WAIT_L(8); PG8_BAR; PG8_WAIT_L(0); PG8_MMA(0, 0, At, B0); PG8_BAR; PG8_SCHED;
            PG8_LDB(B1, 0, 1); PG8_STAGE(PG8_SB(0, 0), b2, voffB);
            PG8_BAR; PG8_WAIT_L(0); PG8_MMA(0, 1, At, B1); PG8_BAR;
            PG8_LDA(At, 0, 1); PG8_STAGE(PG8_SA(0, 0), a2, voffA);
            PG8_BAR; PG8_WAIT_L(0); PG8_MMA(1, 0, At, B0); PG8_BAR; PG8_SCHED;
            PG8_STAGE(PG8_SB(0, 1), b2 + hstepB, voffB);
            PG8_WAIT_V(6); PG8_BAR; PG8_MMA(1, 1, At, B1); PG8_BAR;
            PG8_LDB(B0, 1, 0); PG8_SCHED; PG8_LDA(At, 1, 0); PG8_STAGE(PG8_SA(0, 1), a2 + hstepA, voffA);
            PG8_WAIT_L(8); PG8_BAR; PG8_WAIT_L(0); PG8_MMA(0, 0, At, B0); PG8_BAR; PG8_SCHED;
            PG8_LDB(B1, 1, 1); PG8_STAGE(PG8_SB(1, 0), b3, voffB);
            PG8_BAR; PG8_WAIT_L(0); PG8_MMA(0, 1, At, B1); PG8_BAR;
            PG8_LDA(At, 1, 1); PG8_STAGE(PG8_SA(1, 0), a3, voffA);
            PG8_BAR; PG8_WAIT_L(0); PG8_MMA(1, 0, At, B0); PG8_BAR; PG8_SCHED;
            PG8_STAGE(PG8_SB(1, 1), b3 + hstepB, voffB);
            PG8_WAIT_V(6); PG8_BAR; PG8_MMA(1, 1, At, B1); PG8_BAR;
            }
        }
        if constexpr (ALIGN_EPI) { if (wr == 0) PG8_BAR; }
        if constexpr (!Epi::AFTER_DRAIN) { E(acc, cur, wr, wc, fr, fq); S.done(cur); }
        if (!has_next) break;
#pragma unroll
        for (int a = 0; a < 2; ++a)
#pragma unroll
            for (int b = 0; b < 2; ++b)
#pragma unroll
                for (int m = 0; m < 4; ++m)
#pragma unroll
                    for (int n = 0; n < 2; ++n) acc[a][b][m][n] = (f32x4){0.f, 0.f, 0.f, 0.f};
        cur = nxt; cA = nA; cB = nB; ++ui;
        if constexpr (ALIGN_EPI) { if (wr == 1) PG8_BAR; }
    }
    PG8_WAIT_V(0);
    if constexpr (!ALIGN_EPI) { if (wr == 0) PG8_BAR; }
    PG8_BAR;
    if constexpr (Epi::AFTER_DRAIN) { E.fused(acc, cur, wr, wc, fr, fq, lds, wid, lane); S.done(cur); }
#undef PG8_SA
#undef PG8_SB
#undef PG8_STAGE
#undef PG8_LDA
#undef PG8_LDB
#undef PG8_MMA
#undef PG8_WAIT_V
#undef PG8_WAIT_L
#undef PG8_BAR
#undef PG8_SCHED
}
}

__device__ __forceinline__ void wconv_item(const float* W, int ld, int col0, int k0, bf16_t* WT, int K, int drow0, LAS float* scr, int lane) {
    if (W == nullptr) {
#pragma unroll
        for (int j = 0; j < 4; ++j) { const int n = (lane >> 3) + 8 * j; *(uint4*)(WT + (size_t)(drow0 + n) * K + k0 + 8 * (lane & 7)) = make_uint4(0u, 0u, 0u, 0u); }
        return;
    }
    float wv[32];
#pragma unroll
    for (int i = 0; i < 32; ++i) { const int kk = 2 * i + (lane >> 5); wv[i] = W[(size_t)(k0 + kk) * ld + col0 + (lane & 31)]; }
#pragma unroll
    for (int i = 0; i < 32; ++i) { const int kk = 2 * i + (lane >> 5); scr[kk * 33 + (lane & 31)] = wv[i]; }
    asm volatile("s_waitcnt lgkmcnt(0)" ::: "memory");
    const int c = lane & 7;
#pragma unroll
    for (int j = 0; j < 4; ++j) { const int n = (lane >> 3) + 8 * j; const LAS float* s = scr + (8 * c) * 33 + n;
        uint4 o; o.x = pk2(s[0 * 33], s[1 * 33]); o.y = pk2(s[2 * 33], s[3 * 33]); o.z = pk2(s[4 * 33], s[5 * 33]); o.w = pk2(s[6 * 33], s[7 * 33]);
        *(uint4*)(WT + (size_t)(drow0 + n) * K + k0 + 8 * c) = o; }
    asm volatile("s_waitcnt lgkmcnt(0)" ::: "memory");
}
__device__ __forceinline__ void ph_wconv(const Ctx& C0) {
    PHASE_CTX(C0);
    LAS float* scr = (LAS float*)((LAS unsigned char*)C.lds + C.wave * 16384);
    const int lane = C.lane;
    __syncthreads();
    constexpr int I_WI = 120 * 16, I_WZ = 96 * 16, I_WG = 32 * 8, I_WR = 96 * 8, I_WO = 32 * 16, I_WU = 176 * 16, I_WD = 32 * 44;
    constexpr int I_LAYER = I_WI + I_WZ + I_WG + I_WR + I_WO + I_WU + I_WD;
    for (int it = C.bid * NWAVE + C.wave; it < 2 * I_LAYER; it += C.G * NWAVE) {
        const int l = it / I_LAYER; int r = it % I_LAYER;
        unsigned char* wb = WS_ + W_WB + (size_t)l * WB_LAYER;
        if (r < I_WI) { const int rb = r >> 4, kb = r & 15, pn = rb >> 3, tb = rb & 7; int col = -1;
            if (pn < 4) col = 256 * pn + 64 * (tb & 3) + 32 * (tb >> 2);
            else if (pn < 6) col = C_AV + 256 * (pn - 4) + 32 * tb;
            else if (pn == 6) col = C_BQ + 32 * tb; else if (pn == 7) col = C_BK + 32 * tb;
            else if (pn < 10) col = C_BV + 256 * (pn - 8) + 32 * tb; else if (pn < 12) col = C_BG + 256 * (pn - 10) + 32 * tb;
            else if (pn < 14) col = C_CU + 256 * (pn - 12) + 32 * tb; else if (tb == 0) col = C_BR;
            wconv_item(col < 0 ? nullptr : c_w_in + (size_t)l * 1024 * IN_DIM, IN_DIM, col, kb * 64, (bf16_t*)(wb + WB_WI), 1024, rb * 32, scr, lane); continue; }
        r -= I_WI;
        if (r < I_WZ) { const int rb = r >> 4, kb = r & 15; wconv_item(c_w_in + (size_t)l * 1024 * IN_DIM, IN_DIM, C_GZ + 32 * rb, kb * 64, (bf16_t*)(wb + WB_WZ), 1024, rb * 32, scr, lane); continue; }
        r -= I_WZ;
        if (r < I_WG) { const int rb = r >> 3, kb = r & 7, pn = rb >> 3, tb = rb & 7; wconv_item(c_s5_w_glu + (size_t)l * 512 * 1024, 1024, 512 * (tb >> 2) + 128 * pn + 32 * (tb & 3), kb * 64, (bf16_t*)(wb + WB_WG), 512, rb * 32, scr, lane); continue; }
        r -= I_WG;
        if (r < I_WR) { const int rb = r >> 3, kb = r & 7, br = rb >> 5, rbb = rb & 31; wconv_item(c_w_branch + ((size_t)l * 3 + br) * 512 * 1024, 1024, 32 * rbb, kb * 64, (bf16_t*)(wb + WB_WR), 512, rb * 32, scr, lane); continue; }
        r -= I_WR;
        if (r < I_WO) { const int rb = r >> 4, kb = r & 15; wconv_item(c_w_out + (size_t)l * 1024 * 1024, 1024, 32 * rb, kb * 64, (bf16_t*)(wb + WB_WO), 1024, rb * 32, scr, lane); continue; }
        r -= I_WO;
        if (r < I_WU) { const int rb = r >> 4, kb = r & 15, pn = rb >> 3, tb = rb & 7; const float* src = (tb >> 2) ? c_w_up : c_w_gate;
            wconv_item(src + (size_t)l * 1024 * FFN, FFN, 128 * pn + 32 * (tb & 3), kb * 64, (bf16_t*)(wb + WB_WU), 1024, rb * 32, scr, lane); continue; }
        r -= I_WU;
        { const int rb = r / 44, kb = r % 44; wconv_item(c_w_down + (size_t)l * FFN * 1024, 1024, 32 * rb, kb * 64, (bf16_t*)(wb + WB_WD), FFN, rb * 32, scr, lane); }
    }
}

__device__ __forceinline__ uint4 pack8(const f32x4& a, const f32x4& b) { uint4 w; w.x = pk2(a[0], a[1]); w.y = pk2(a[2], a[3]); w.z = pk2(b[0], b[1]); w.w = pk2(b[2], b[3]); return w; }
struct EpiIn {
    static constexpr bool PERM = true, AFTER_DRAIN = false;
    unsigned char* ws_; float* out_; const float* qg; const float* kg; int l; int pad_;
    __device__ __forceinline__ void operator()(const f32x4 (&acc)[2][2][4][2], const pg8::Unit& u, int wr, int wc, int fr_, int fq_) const {
        int fr = fr_, fq = fq_; asm volatile("" : "+v"(fr), "+v"(fq));
        KArgPtr Pk = kargs(); unsigned char* ws = Pk->ws; float* out = Pk->out;
        const int pn = u.pn, rowb = u.pm * 256 + wr * 64 + fr;
        if (pn < 4) {
            const bool isk = pn >= 2; const float* g = isk ? kg : qg;
            const bool latent = u.pm >= 32;
            const float* cosT = (const float*)(ws + W_MISC) + 64; const float* sinT = cosT + 1024;
            bf16_t* dstb = isk ? (bf16_t*)(ws + W_AK) : (bf16_t*)(ws + W_AQ);
            const int colb = (pn & 1) * 256 + 64 * wc + 8 * fq;
#pragma unroll
            for (int ai = 0; ai < 2; ++ai)
#pragma unroll
                for (int m = 0; m < 4; ++m) {
                    const int row = rowb + ai * 128 + m * 16;
                    f32x4 v[2][2]; float ss = 0.f;
#pragma unroll
                    for (int bj = 0; bj < 2; ++bj)
#pragma unroll
                        for (int n = 0; n < 2; ++n) { v[bj][n] = acc[ai][bj][m][n]; ss += v[bj][n][0] * v[bj][n][0] + v[bj][n][1] * v[bj][n][1] + v[bj][n][2] * v[bj][n][2] + v[bj][n][3] * v[bj][n][3]; }
                    ss += shx(ss, 16, fq * 16 + fr); ss = xsum32(ss);
                    const float rs = rsqrtf(ss * (1.f / 64.f) + EPS);
                    { const float* gp = (isk ? Pk->in[14] : Pk->in[13]) + l * 64 + launder_s(0);
#pragma unroll
                      for (int bj = 0; bj < 2; ++bj)
#pragma unroll
                        for (int n = 0; n < 2; ++n) v[bj][n] = v[bj][n] * rs * *(const f32x4*)(gp + 32 * bj + 8 * fq + 4 * n); }
                    if (isk && !latent) {
                        float* o = out + O_NK + ((size_t)((row >> 8) * 2 + l) * 256 + (row & 255)) * 512 + colb;
#pragma unroll
                        for (int bj = 0; bj < 2; ++bj) { *(f32x4*)(o + 32 * bj) = v[bj][0]; *(f32x4*)(o + 32 * bj + 4) = v[bj][1]; }
                    }
                    if (latent) {
                        const int t = (row - NPROMPT) & 2047;
#pragma unroll
                        for (int bj = 0; bj < 2; ++bj) {
                            const int pos = bj ? (t & 63) : (t >> 6);
#pragma unroll
                            for (int n = 0; n < 2; ++n) {
                                const f32x4 cc = *(const f32x4*)(cosT + pos * 16 + 8 * (fq & 1) + 4 * n), sn = *(const f32x4*)(sinT + pos * 16 + 8 * (fq & 1) + 4 * n);
                                f32x4 ot;
#pragma unroll
                                for (int e = 0; e < 4; ++e) ot[e] = shx(v[bj][n][e], 32, fq * 16 + fr);
                                v[bj][n] = (fq & 2) ? (v[bj][n] * cc + ot * sn) : (v[bj][n] * cc - ot * sn);
                            }
                        }
                    }
                    bf16_t* d = dstb + (size_t)(isk ? krow_of(row) : row) * 512 + colb;
#pragma unroll
                    for (int bj = 0; bj < 2; ++bj) *(uint4*)(d + 32 * bj) = pack8(v[bj][0], v[bj][1]);
                }
            return;
        }
        const int cb = 32 * wc + 8 * fq;
        if (pn < 6) {
            bf16_t* AV = (bf16_t*)(ws + W_AV);
#pragma unroll
            for (int ai = 0; ai < 2; ++ai)
#pragma unroll
                for (int m = 0; m < 4; ++m) { const int row = rowb + ai * 128 + m * 16;
#pragma unroll
                    for (int bj = 0; bj < 2; ++bj) { const int col = (pn - 4) * 256 + 128 * bj + cb;
                        *(uint4*)(AV + (size_t)krow_of(row) * 512 + col) = pack8(acc[ai][bj][m][0], acc[ai][bj][m][1]);
                        if (row < NPROMPT) { float* o = out + O_NV + ((size_t)((row >> 8) * 2 + l) * 256 + (row & 255)) * 512 + col; *(f32x4*)o = acc[ai][bj][m][0]; *(f32x4*)(o + 4) = acc[ai][bj][m][1]; } } }
            return;
        }
        if (pn == 14) {
            if (wc == 0) { float* BR = (float*)(ws + W_BR);
#pragma unroll
                for (int ai = 0; ai < 2; ++ai)
#pragma unroll
                    for (int m = 0; m < 4; ++m) { const int row = rowb + ai * 128 + m * 16; *(f32x4*)(BR + (size_t)row * 32 + 8 * fq) = acc[ai][0][m][0]; *(f32x4*)(BR + (size_t)row * 32 + 8 * fq + 4) = acc[ai][0][m][1]; } }
            return;
        }
        bf16_t* dst; int ldd, c0; int mode = 0;
        if (pn == 6) { dst = (bf16_t*)(ws + W_BQ); ldd = 256; c0 = 0; mode = 1; }
        else if (pn == 7) { dst = (bf16_t*)(ws + W_BK); ldd = 256; c0 = 0; }
        else if (pn < 10) { dst = (bf16_t*)(ws + W_BV); ldd = 512; c0 = (pn - 8) * 256; }
        else if (pn < 12) { dst = (bf16_t*)(ws + W_BG); ldd = 512; c0 = (pn - 10) * 256; mode = 2; }
        else {
            bf16_t* UH = (bf16_t*)(ws + W_UH);
#pragma unroll
            for (int ai = 0; ai < 2; ++ai)
#pragma unroll
                for (int m = 0; m < 4; ++m) { const int row = rowb + ai * 128 + m * 16;
#pragma unroll
                    for (int bj = 0; bj < 2; ++bj) { const int col = (pn - 12) * 256 + 128 * bj + cb, g = col >> 4, ch0 = col & 15;
                        *(uint4*)(UH + ((size_t)g * 512 + (row >> 5)) * 768 + (row & 31) * 16 + ch0) = pack8(acc[ai][bj][m][0], acc[ai][bj][m][1]); } }
            return;
        }
#pragma unroll
        for (int ai = 0; ai < 2; ++ai)
#pragma unroll
            for (int m = 0; m < 4; ++m) { const int row = rowb + ai * 128 + m * 16;
#pragma unroll
                for (int bj = 0; bj < 2; ++bj) { f32x4 a = acc[ai][bj][m][0], b = acc[ai][bj][m][1];
                    if (mode == 1) { a = a * 0.125f; b = b * 0.125f; }
                    if (mode == 2) {
#pragma unroll
                        for (int e = 0; e < 4; ++e) { a[e] = siluf_(a[e]); b[e] = siluf_(b[e]); } }
                    *(uint4*)(dst + (size_t)row * ldd + c0 + 128 * bj + cb) = pack8(a, b); } }
    }
};
struct EpiGate {
    static constexpr bool PERM = true, AFTER_DRAIN = false;
    bf16_t* G;
    __device__ __forceinline__ void operator()(const f32x4 (&acc)[2][2][4][2], const pg8::Unit& u, int wr, int wc, int fr_, int fq_) const {
        int fr = fr_, fq = fq_; asm volatile("" : "+v"(fr), "+v"(fq));
        const int rowb = u.pm * 256 + wr * 64 + fr, cb = u.pn * 256 + 32 * wc + 8 * fq;
#pragma unroll
        for (int ai = 0; ai < 2; ++ai)
#pragma unroll
            for (int m = 0; m < 4; ++m) { const int row = rowb + ai * 128 + m * 16;
#pragma unroll
                for (int bj = 0; bj < 2; ++bj) { f32x4 a = acc[ai][bj][m][0], b = acc[ai][bj][m][1];
#pragma unroll
                    for (int e = 0; e < 4; ++e) { a[e] = sigmoidf_(a[e]); b[e] = sigmoidf_(b[e]); }
                    *(uint4*)(G + (size_t)row * 3072 + cb + 128 * bj) = pack8(a, b); } }
    }
};
struct EpiGlu {
    static constexpr bool PERM = true, AFTER_DRAIN = false;
    bf16_t* OC; const float* bias;
    __device__ __forceinline__ void operator()(const f32x4 (&acc)[2][2][4][2], const pg8::Unit& u, int wr, int wc, int fr_, int fq_) const {
        int fr = fr_, fq = fq_; asm volatile("" : "+v"(fr), "+v"(fq));
        const int rowb = u.pm * 256 + wr * 64 + fr, col = u.pn * 128 + 32 * wc + 8 * fq;
        const f32x4 ba0 = *(const f32x4*)(bias + col), ba1 = *(const f32x4*)(bias + col + 4), bb0 = *(const f32x4*)(bias + 512 + col), bb1 = *(const f32x4*)(bias + 512 + col + 4);
#pragma unroll
        for (int ai = 0; ai < 2; ++ai)
#pragma unroll
            for (int m = 0; m < 4; ++m) { const int row = rowb + ai * 128 + m * 16;
                f32x4 a0 = acc[ai][0][m][0] + ba0, a1 = acc[ai][0][m][1] + ba1, b0 = acc[ai][1][m][0] + bb0, b1 = acc[ai][1][m][1] + bb1;
#pragma unroll
                for (int e = 0; e < 4; ++e) { a0[e] *= sigmoidf_(b0[e]); a1[e] *= sigmoidf_(b1[e]); }
                *(uint4*)(OC + (size_t)row * 512 + col) = pack8(a0, a1); }
    }
};
struct EpiBranch {
    static constexpr bool PERM = true, AFTER_DRAIN = false;
    const bf16_t* G; bf16_t* MG;
    __device__ __forceinline__ void operator()(const f32x4 (&acc)[2][2][4][2], const pg8::Unit& u, int wr, int wc, int fr_, int fq_) const {
        int fr = fr_, fq = fq_; asm volatile("" : "+v"(fr), "+v"(fq));
        const int rowb = u.pm * 256 + wr * 64 + fr, cb = u.pn * 256 + 32 * wc + 8 * fq, r = u.z;
#pragma unroll
        for (int ai = 0; ai < 2; ++ai)
#pragma unroll
            for (int m = 0; m < 4; ++m) { const int row = rowb + ai * 128 + m * 16;
#pragma unroll
                for (int bj = 0; bj < 2; ++bj) { const int col = cb + 128 * bj;
                    const uint4 gr = *(const uint4*)(G + (size_t)row * 3072 + r * 1024 + col);
                    f32x4 g0, g1;
                    g0[0] = __uint_as_float(gr.x << 16); g0[1] = __uint_as_float(gr.x & 0xffff0000u); g0[2] = __uint_as_float(gr.y << 16); g0[3] = __uint_as_float(gr.y & 0xffff0000u);
                    g1[0] = __uint_as_float(gr.z << 16); g1[1] = __uint_as_float(gr.z & 0xffff0000u); g1[2] = __uint_as_float(gr.w << 16); g1[3] = __uint_as_float(gr.w & 0xffff0000u);
                    f32x4 a = acc[ai][bj][m][0] * g0, b = acc[ai][bj][m][1] * g1;
                    bf16_t* mp = MG + (size_t)row * 1024 + col;
                    if (r > 0) { const uint4 pr = *(const uint4*)mp;
                        a[0] += __uint_as_float(pr.x << 16); a[1] += __uint_as_float(pr.x & 0xffff0000u); a[2] += __uint_as_float(pr.y << 16); a[3] += __uint_as_float(pr.y & 0xffff0000u);
                        b[0] += __uint_as_float(pr.z << 16); b[1] += __uint_as_float(pr.z & 0xffff0000u); b[2] += __uint_as_float(pr.w << 16); b[3] += __uint_as_float(pr.w & 0xffff0000u); }
                    *(uint4*)mp = pack8(a, b); } }
    }
};
struct EpiRes {
    static constexpr bool PERM = true, AFTER_DRAIN = false;
    const void* x0; const void* x1; void* o0; void* o1; const float* MODg; int in_bf16, out_bf16;
    __device__ __forceinline__ void operator()(const f32x4 (&acc)[2][2][4][2], const pg8::Unit& u, int wr, int wc, int fr_, int fq_) const {
        int fr = fr_, fq = fq_; asm volatile("" : "+v"(fr), "+v"(fq));
        const int rowb = u.pm * 256 + wr * 64 + fr, cb = u.pn * 256 + 32 * wc + 8 * fq;
        const float* mg = MODg + (size_t)cond_row(u.pm * 256) * 6144;
        const bool ctx = u.pm < NPROMPT / 256;
        const void* xi0 = ctx ? x0 : x1; void* xo0 = ctx ? o0 : o1;
#pragma unroll
        for (int bj = 0; bj < 2; ++bj) { const int col = cb + 128 * bj;
            const f32x4 m0 = *(const f32x4*)(mg + col), m1 = *(const f32x4*)(mg + col + 4);
#pragma unroll
            for (int ai = 0; ai < 2; ++ai)
#pragma unroll
                for (int m = 0; m < 4; ++m) { const int row = rowb + ai * 128 + m * 16;
                    const size_t off = (size_t)(ctx ? row : row - NPROMPT) * D + col;
                    f32x4 a, b;
                    if (in_bf16) { const uint4 w = *(const uint4*)((const bf16_t*)xi0 + off);
                        a[0] = __uint_as_float(w.x << 16); a[1] = __uint_as_float(w.x & 0xffff0000u); a[2] = __uint_as_float(w.y << 16); a[3] = __uint_as_float(w.y & 0xffff0000u);
                        b[0] = __uint_as_float(w.z << 16); b[1] = __uint_as_float(w.z & 0xffff0000u); b[2] = __uint_as_float(w.w << 16); b[3] = __uint_as_float(w.w & 0xffff0000u); }
                    else { a = *(const f32x4*)((const float*)xi0 + off); b = *(const f32x4*)((const float*)xi0 + off + 4); }
                    a += m0 * acc[ai][bj][m][0]; b += m1 * acc[ai][bj][m][1];
                    if (out_bf16) *(uint4*)((bf16_t*)xo0 + off) = pack8(a, b);
                    else { *(f32x4*)((float*)xo0 + off) = a; *(f32x4*)((float*)xo0 + off + 4) = b; } } }
    }
};
struct EpiFfn {
    static constexpr bool PERM = true, AFTER_DRAIN = false;
    bf16_t* H;
    __device__ __forceinline__ void operator()(const f32x4 (&acc)[2][2][4][2], const pg8::Unit& u, int wr, int wc, int fr_, int fq_) const {
        int fr = fr_, fq = fq_; asm volatile("" : "+v"(fr), "+v"(fq));
        const int rowb = u.pm * 256 + wr * 64 + fr, col = u.pn * 128 + 32 * wc + 8 * fq;
#pragma unroll
        for (int ai = 0; ai < 2; ++ai) {
            if (u.h != 0 && u.h != ai + 1) continue;
#pragma unroll
            for (int m = 0; m < 4; ++m) { const int row = rowb + ai * 128 + m * 16;
                f32x4 a0 = acc[ai][0][m][0], a1 = acc[ai][0][m][1];
#pragma unroll
                for (int e = 0; e < 4; ++e) { a0[e] = siluf_(a0[e]) * acc[ai][1][m][0][e]; a1[e] = siluf_(a1[e]) * acc[ai][1][m][1][e]; }
                *(uint4*)(H + (size_t)row * FFN + col) = pack8(a0, a1); } }
    }
};
struct FfnOrder {
    pg8::StaticOrder S;
    static constexpr bool HALF = true;
    __device__ bool next(int i, pg8::Unit& u) const {
        if (S.G != 256 || S.nwg != 1408) return S.next(i, u);
        if (i < 5) { S.map(i * 256 + S.c, u); return true; }
        if (i > 5) return false;
        S.map(1280 + ((S.c >> 4) << 3) + (S.c & 7), u); u.h = 1 + ((S.c >> 3) & 1); return true;
    }
    __device__ __forceinline__ void a_ready(const pg8::Unit&) const {}
    __device__ __forceinline__ void done(const pg8::Unit&) const {}
};
struct BranchOrder {
    pg8::StaticOrder S;
    static constexpr bool HALF = false;
    __device__ bool next(int i, pg8::Unit& u) const { if (i >= 3) return false; if (!S.next(0, u)) return false; u.z = i; return true; }
    __device__ __forceinline__ void a_ready(const pg8::Unit&) const {}
    __device__ __forceinline__ void done(const pg8::Unit&) const {}
};
constexpr int S5T = 32;
constexpr size_t TE_BYTES = 256 * 512 * 2, TC_BYTES = 512 * 768 * 2, TAB_TE = 0, TAB_TC = 32 * TE_BYTES;
__device__ __forceinline__ unsigned char* s5_tab(unsigned char* ws, int l) { return ws + (l == 0 ? W_TAB0 : W_TAB1); }
template <int MODE>
__device__ __forceinline__ void ph_s5_tables(const Ctx& C0) {
    PHASE_CTX(C0);
    float* sApr = (float*)C.lds;
    float* sApi = sApr + 2 * 33 * 64;
    float* sBr = sApi + 2 * 33 * 64;
    float* sBi = sBr + 2 * 64 * 16;
    float* sCr = sBi + 2 * 64 * 16;
    float* sCi = sCr + 2 * 16 * 64;
    float* sK = sCi + 2 * 16 * 64;
    float* sD = sK + 2 * 32 * 260;
    const int tid = C.tid;
    for (int item0 = (MODE == 0 ? C.G - 1 - C.bid : C.bid); item0 < (MODE == 0 ? 64 : 256); item0 += C.G) {
        const int item = MODE == 0 ? item0 * 4 : item0;
        const int l = item >> 7, g = (item >> 2) & 31, sub = item & 3;
        __syncthreads();
        constexpr int AUXF = 2 * 2 * 33 * 64 + 2 * 2 * 64 * 16 + 2 * 2 * 16 * 64;
        float* aux = WSP(float, W_KAUX) + ((size_t)l * 32 + g) * (AUXF + 16);
        if (MODE == 1) {
            f32x4 av[9];
#pragma unroll
            for (int q = 0; q < 9; ++q) { const int i = tid + q * NT; av[q] = i < AUXF / 4 ? ((const f32x4*)aux)[i] : (f32x4){0.f, 0.f, 0.f, 0.f}; }
            const float dv = tid < 16 ? aux[AUXF + tid] : 0.f;
#pragma unroll
            for (int q = 0; q < 9; ++q) { const int i = tid + q * NT; if (i < AUXF / 4) ((f32x4*)sApr)[i] = av[q]; }
            if (tid < 16) sD[tid] = dv;
        }
        if (MODE == 0) {
        if (tid >= 128 && tid < 256) {
            const int dir = (tid - 128) >> 6, p = tid & 63; const size_t ld = (size_t)l * 2 + dir;
            const float lr = c_s5_lam_re[(ld * 32 + g) * 64 + p], li = c_s5_lam_im[(ld * 32 + g) * 64 + p], dt = expf(c_s5_log_dt[ld * 32 + g]);
            const float mag = expf(lr * dt); float sn, cs; sincosf(li * dt, &sn, &cs);
            const float ar = mag * cs, ai = mag * sn; float xr = 1.f, xi = 0.f;
#pragma unroll 1
            for (int t = 0; t <= 32; ++t) { sApr[(dir * 33 + t) * 64 + p] = xr; sApi[(dir * 33 + t) * 64 + p] = xi; const float nr = xr * ar - xi * ai, ni = xr * ai + xi * ar; xr = nr; xi = ni; }
        }
        if (tid < 128) {
            const int dir = tid >> 6, p = tid & 63; const size_t ld = (size_t)l * 2 + dir;
            const float lr = c_s5_lam_re[(ld * 32 + g) * 64 + p], li = c_s5_lam_im[(ld * 32 + g) * 64 + p], dt = expf(c_s5_log_dt[ld * 32 + g]);
            const float mag = expf(lr * dt); const float ar = mag * cosf(li * dt), ai = mag * sinf(li * dt), den = lr * lr + li * li;
            const float fr = ((ar - 1.f) * lr + ai * li) / den, fi = (ai * lr - (ar - 1.f) * li) / den;
            for (int c = 0; c < 16; ++c) { const float br_ = c_s5_b_re[((ld * 32 + g) * 64 + p) * 16 + c], bi_ = c_s5_b_im[((ld * 32 + g) * 64 + p) * 16 + c];
                sBr[(dir * 64 + p) * 16 + c] = fr * br_ - fi * bi_; sBi[(dir * 64 + p) * 16 + c] = fr * bi_ + fi * br_; }
            for (int o = 0; o < 16; ++o) { sCr[(dir * 16 + o) * 64 + p] = c_s5_c_re[((ld * 32 + g) * 16 + o) * 64 + p]; sCi[(dir * 16 + o) * 64 + p] = c_s5_c_im[((ld * 32 + g) * 16 + o) * 64 + p]; }
        }
        if (tid >= 128 && tid < 144) sD[tid - 128] = c_s5_d[(size_t)l * 512 + g * 16 + (tid - 128)];
        }
        __syncthreads();
        if (MODE == 0) {
            for (int i = tid; i < AUXF / 4; i += NT) ((f32x4*)aux)[i] = ((const f32x4*)sApr)[i];
            if (tid < 16) aux[AUXF + tid] = sD[tid];
        }
        if (tid < 128 && MODE == 0) {
            const int dir = tid >> 6, p = tid & 63; float* at = WSP(float, W_ATAB) + ((((size_t)l * 32 + g) * 2 + dir) * 64 + p) * 2;
            at[0] = sApr[(dir * 33 + 32) * 64 + p]; at[1] = sApi[(dir * 33 + 32) * 64 + p];
        }
        float* Kg = WSP(float, W_KG) + ((size_t)l * 32 + g) * 16384;
        if (MODE == 1) { f32x4 kv[8];
#pragma unroll
            for (int q = 0; q < 8; ++q) kv[q] = ((const f32x4*)Kg)[tid + q * NT];
#pragma unroll
            for (int q = 0; q < 8; ++q) { const int i = tid + q * NT; ((f32x4*)sK)[(i >> 6) * 65 + (i & 63)] = kv[q]; } }
        if (MODE == 0) {
            const int dir = tid >> 8, tau0 = (tid >> 4) & 15, o = tid & 15;
            float acc0[16], acc1[16];
#pragma unroll
            for (int c = 0; c < 16; ++c) { acc0[c] = 0.f; acc1[c] = 0.f; }
#pragma unroll 2
            for (int p = 0; p < 64; ++p) {
                const float cr = sCr[(dir * 16 + o) * 64 + p], ci = sCi[(dir * 16 + o) * 64 + p];
                const float ar0 = sApr[(dir * 33 + tau0) * 64 + p], ai0 = sApi[(dir * 33 + tau0) * 64 + p], ar1 = sApr[(dir * 33 + tau0 + 16) * 64 + p], ai1 = sApi[(dir * 33 + tau0 + 16) * 64 + p];
                const float wr0 = cr * ar0 - ci * ai0, wi0 = cr * ai0 + ci * ar0, wr1 = cr * ar1 - ci * ai1, wi1 = cr * ai1 + ci * ar1;
#pragma unroll
                for (int c = 0; c < 16; ++c) { const float br_ = sBr[(dir * 64 + p) * 16 + c], bi_ = sBi[(dir * 64 + p) * 16 + c];
                    acc0[c] += wr0 * br_ - wi0 * bi_; acc1[c] += wr1 * br_ - wi1 * bi_; }
            }
#pragma unroll
            for (int c = 0; c < 16; ++c) { Kg[((dir * 32 + tau0) * 16 + o) * 16 + c] = acc0[c]; Kg[((dir * 32 + tau0 + 16) * 16 + o) * 16 + c] = acc1[c]; }
        }
        if (MODE == 0) continue;
        __syncthreads();
        unsigned char* tab = s5_tab(WS_, l);
        bf16_t* TC = (bf16_t*)(tab + TAB_TC + (size_t)g * TC_BYTES);
        bf16_t* TE = (bf16_t*)(tab + TAB_TE + (size_t)g * TE_BYTES);
        for (int ch = tid; ch < 128 * 64; ch += NT) {
            const int n = sub * 128 + (ch >> 6), kc = ch & 63, j = n >> 4, o = n & 15, i = kc >> 1, c0 = (kc & 1) * 8;
            const float* src = sK + (i <= j ? j - i : 32 + i - j) * 260 + o * 16 + c0;
            f32x4 a = *(const f32x4*)src, b = *(const f32x4*)(src + 4);
            if (i == j) { const float* s1 = sK + 32 * 260 + o * 16 + c0; a += *(const f32x4*)s1; b += *(const f32x4*)(s1 + 4); const float dv = sD[o];
#pragma unroll
                for (int e = 0; e < 4; ++e) { a[e] += (o == c0 + e) ? dv : 0.f; b[e] += (o == c0 + 4 + e) ? dv : 0.f; } }
            *(uint4*)(TC + (size_t)n * 768 + kc * 8) = pack8(a, b);
        }
        for (int ch = tid; ch < 128 * 32; ch += NT) {
            const int n = sub * 128 + (ch >> 5), kq = ch & 31, j = n >> 4, o = n & 15;
            const int kk = kq * 8, dir = kk >> 7, ri = (kk >> 6) & 1, p0 = kk & 63; const int tau = dir == 0 ? j + 1 : S5T - j;
            const float* pc = sCr + (dir * 16 + o) * 64 + p0; const float* pa = sApr + (dir * 33 + tau) * 64 + p0;
            const f32x4 cr0 = *(const f32x4*)pc, cr1 = *(const f32x4*)(pc + 4), ci0 = *(const f32x4*)(pc + 2 * 16 * 64), ci1 = *(const f32x4*)(pc + 2 * 16 * 64 + 4);
            const f32x4 ar0 = *(const f32x4*)pa, ar1 = *(const f32x4*)(pa + 4), ai0 = *(const f32x4*)(pa + 2 * 33 * 64), ai1 = *(const f32x4*)(pa + 2 * 33 * 64 + 4);
            const f32x4 v0 = ri == 0 ? (cr0 * ar0 - ci0 * ai0) : -(cr0 * ai0 + ci0 * ar0), v1 = ri == 0 ? (cr1 * ar1 - ci1 * ai1) : -(cr1 * ai1 + ci1 * ar1);
            *(uint4*)(TC + (size_t)n * 768 + 512 + kq * 8) = pack8(v0, v1);
        }
        for (int ch = tid; ch < 64 * 64; ch += NT) {
            const int n = sub * 64 + (ch >> 6), kc = ch & 63, dir = n >> 7, ri = (n >> 6) & 1, p = n & 63, i = kc >> 1, c0 = (kc & 1) * 8;
            const int tau = dir == 0 ? S5T - 1 - i : i;
            const float ar = sApr[(dir * 33 + tau) * 64 + p], ai = sApi[(dir * 33 + tau) * 64 + p];
            float v[8];
#pragma unroll
            for (int e = 0; e < 8; ++e) { const float br_ = sBr[(dir * 64 + p) * 16 + c0 + e], bi_ = sBi[(dir * 64 + p) * 16 + c0 + e];
                v[e] = ri == 0 ? (ar * br_ - ai * bi_) : (ar * bi_ + ai * br_); }
            uint4 w; w.x = pk2(v[0], v[1]); w.y = pk2(v[2], v[3]); w.z = pk2(v[4], v[5]); w.w = pk2(v[6], v[7]);
            *(uint4*)(TE + (size_t)n * 512 + kc * 8) = w;
        }
    }
}
__device__ __forceinline__ void ph_s5_scan(const Ctx& C0, int l) {
    PHASE_CTX(C0);
    const int lane = C.lane;
    const float* HL = WSP(float, W_HLOC); bf16_t* UH = WSP(bf16_t, W_UH);
    for (int w0 = C.bid * NWAVE + C.wave; w0 < 36 * 64; w0 += C.G * NWAVE) {
        const int w = (w0 + 36 * 64 - 512) % (36 * 64);
        const int dir = w & 1, g = (w >> 1) & 31, s = 35 - (w >> 6);
        const bool latent = s >= 32;
        const int nch = latent ? 64 : 8, ch0 = latent ? 256 + (s - 32) * 64 : s * 8;
        const float* at = WSP(float, W_ATAB) + ((((size_t)l * 32 + g) * 2 + dir) * 64 + lane) * 2;
        const float ar = at[0], ai = at[1];
        float hr = 0.f, hi = 0.f;
        if (latent) { const float* si = c_state_s5 + ((((size_t)(s - 32) * 2 + l) * 2 + dir) * 2) * 2048 + g * 64 + lane; hr = si[0]; hi = si[2048]; }
#pragma unroll 1
        for (int n0 = 0; n0 < nch; n0 += 8) {
            float lr_[8], li_[8];
#pragma unroll
            for (int b = 0; b < 8; ++b) { const int ch = ch0 + (dir == 0 ? n0 + b : nch - 1 - n0 - b);
                const float* hl = HL + ((size_t)g * 512 + ch) * 256 + dir * 128 + lane; lr_[b] = hl[0]; li_[b] = hl[64]; }
#pragma unroll
            for (int b = 0; b < 8; ++b) { const int ch = ch0 + (dir == 0 ? n0 + b : nch - 1 - n0 - b);
                bf16_t* uh = UH + ((size_t)g * 512 + ch) * 768 + 512 + dir * 128 + lane;
                uh[0] = f2bf(hr); uh[64] = f2bf(hi);
                const float nr = ar * hr - ai * hi + lr_[b], ni = ar * hi + ai * hr + li_[b];
                hr = nr; hi = ni; }
        }
        if (!latent) { float* so = c_out + O_NS + ((((size_t)s * 2 + l) * 2 + dir) * 2) * 2048 + g * 64 + lane; so[0] = hr; so[2048] = hi; }
    }
}
struct ZOrder {
    int nz, nM, nN, G, c;
    static constexpr bool HALF = false;
    __device__ bool next(int i, pg8::Unit& u) const { const int L = i * G + c; if (c >= G || L >= nz * nM * nN) return false; u.h = 0; u.z = L / (nM * nN); const int r = L % (nM * nN); u.pm = r % nM; u.pn = r / nM; return true; }
    __device__ __forceinline__ void a_ready(const pg8::Unit&) const {}
    __device__ __forceinline__ void done(const pg8::Unit&) const {}
};
struct EpiHloc {
    static constexpr bool PERM = true, AFTER_DRAIN = false;
    float* HL;
    __device__ __forceinline__ void operator()(const f32x4 (&acc)[2][2][4][2], const pg8::Unit& u, int wr, int wc, int fr_, int fq_) const {
        int fr = fr_, fq = fq_; asm volatile("" : "+v"(fr), "+v"(fq));
        const int rowb = u.pm * 256 + wr * 64 + fr, cb = 32 * wc + 8 * fq;
#pragma unroll
        for (int ai = 0; ai < 2; ++ai)
#pragma unroll
            for (int m = 0; m < 4; ++m) { const int row = rowb + ai * 128 + m * 16;
#pragma unroll
                for (int bj = 0; bj < 2; ++bj) { float* o = HL + ((size_t)u.z * 512 + row) * 256 + 128 * bj + cb; *(f32x4*)o = acc[ai][bj][m][0]; *(f32x4*)(o + 4) = acc[ai][bj][m][1]; } }
    }
};
struct EpiS5Y {
    static constexpr bool PERM = true, AFTER_DRAIN = false;
    bf16_t* YC;
    __device__ __forceinline__ void operator()(const f32x4 (&acc)[2][2][4][2], const pg8::Unit& u, int wr, int wc, int fr_, int fq_) const {
        int fr = fr_, fq = fq_; asm volatile("" : "+v"(fr), "+v"(fq));
        const int rowb = u.pm * 256 + wr * 64 + fr, g = u.z;
#pragma unroll
        for (int ai = 0; ai < 2; ++ai)
#pragma unroll
            for (int m = 0; m < 4; ++m) { const int chunk = rowb + ai * 128 + m * 16;
#pragma unroll
                for (int bj = 0; bj < 2; ++bj) { const int n = u.pn * 256 + 128 * bj + 32 * wc + 8 * fq, j = n >> 4, o0 = n & 15;
                    f32x4 a = acc[ai][bj][m][0], b = acc[ai][bj][m][1];
#pragma unroll
                    for (int e = 0; e < 4; ++e) { a[e] = gelu_tanh(a[e]); b[e] = gelu_tanh(b[e]); }
                    *(uint4*)(YC + ((size_t)chunk * 32 + j) * 512 + g * 16 + o0) = pack8(a, b); } }
    }
};
template <class Epi, class Sched>
__device__ __forceinline__ void run_gemm(const Ctx& C, const bf16_t* A, const bf16_t* Bt, int N, int K, size_t za, size_t zb, const Sched& S, const Epi& E, int lda = 0, int ldb = 0) {
    __syncthreads();
    pg8::Gemm g{A, Bt, M, N, K, za, zb, lda ? lda : K, ldb ? ldb : K};
    pg8::gemm_phase<Epi, Sched, true, true>((LAS unsigned char*)C.lds, g, S, E);
}

#define LAYER_PTRS() const float* MODl = c_MOD + (size_t)l * 5 * 6144; const float* xin0 = l == 0 ? c_x_prompt : c_X; const float* xin1 = l == 0 ? c_x_sample : c_X + (size_t)NPROMPT * D; \
    unsigned char* wb = WS_ + W_WB + (size_t)l * WB_LAYER; (void)MODl; (void)xin0; (void)xin1; (void)wb
__device__ __forceinline__ void g_norm1(const Ctx& C0, int l) { PHASE_CTX(C0); LAYER_PTRS(); if (l == 0) ph_norm(C, c_x_prompt, c_x_sample, false, c_norm1_g + l * 1024, MODl, 0); else ph_norm(C, WSP(bf16_t, W_XB0), WSP(bf16_t, W_XB1), true, c_norm1_g + l * 1024, MODl, 0); }
__device__ __forceinline__ void g_norm2(const Ctx& C0, int l) { PHASE_CTX(C0); LAYER_PTRS(); ph_norm(C, WSP(bf16_t, W_XB0), WSP(bf16_t, W_XB1), true, c_norm2_g + l * 1024, MODl, 1); }
__device__ __forceinline__ void g_inproj(const Ctx& C0, int l) { PHASE_CTX(C0); LAYER_PTRS();
    EpiIn e{WS_, OUT_, c_qn_g + l * 64, c_kn_g + l * 64, l, 0}; pg8::StaticOrder S; S.init(M, 3840, C.G, C.bid);
    run_gemm(C, c_XN, (const bf16_t*)(wb + WB_WI), 3840, 1024, 0, 0, S, e); }
__device__ __forceinline__ void g_s5a(const Ctx& C0, int l) { PHASE_CTX(C0);
    EpiHloc e{WSP(float, W_HLOC)}; ZOrder S{32, 2, 1, C.G, C.bid};
    run_gemm(C, WSP(bf16_t, W_UH), (const bf16_t*)(s5_tab(WS_, l) + TAB_TE), 256, 512, (size_t)512 * 768 * 2, TE_BYTES, S, e, 768, 512); }
__device__ __forceinline__ void g_s5c(const Ctx& C0, int l) { PHASE_CTX(C0);
    EpiS5Y e{c_YF}; ZOrder S{32, 2, 2, C.G, C.bid};
    run_gemm(C, WSP(bf16_t, W_UH), (const bf16_t*)(s5_tab(WS_, l) + TAB_TC), 512, 768, (size_t)512 * 768 * 2, TC_BYTES, S, e, 768, 768); }
__device__ __forceinline__ void g_glu(const Ctx& C0, int l) { PHASE_CTX(C0); LAYER_PTRS();
    EpiGlu e{c_OC, c_s5_b_glu + (size_t)l * 1024}; pg8::StaticOrder S; S.init(M, 1024, C.G, C.bid);
    run_gemm(C, c_YF, (const bf16_t*)(wb + WB_WG), 1024, 512, 0, 0, S, e); }
__device__ __forceinline__ void g_gates(const Ctx& C0, int l) { PHASE_CTX(C0); LAYER_PTRS();
    EpiGate e{c_GATES}; pg8::StaticOrder S; S.init(M, 3072, C.G, C.bid);
    run_gemm(C, c_XN, (const bf16_t*)(wb + WB_WZ), 3072, 1024, 0, 0, S, e); }
__device__ __forceinline__ void g_branch(const Ctx& C0, int l) { PHASE_CTX(C0); LAYER_PTRS();
    EpiBranch e{c_GATES, c_MERGED}; BranchOrder S; S.S.init(M, 1024, C.G, C.bid);
    run_gemm(C, c_OA, (const bf16_t*)(wb + WB_WR), 1024, 512, (size_t)M * 512 * 2, (size_t)1024 * 512 * 2, S, e); }
__device__ __forceinline__ void g_out(const Ctx& C0, int l) { PHASE_CTX(C0); LAYER_PTRS();
    EpiRes e{WSP(bf16_t, W_XB0), WSP(bf16_t, W_XB1), WSP(bf16_t, W_XB0), WSP(bf16_t, W_XB1), MODl + 2048, 1, 1};
    if (l == 0) { e.x0 = c_x_prompt; e.x1 = c_x_sample; e.in_bf16 = 0; }
    pg8::StaticOrder S; S.init(M, 1024, C.G, C.bid);
    run_gemm(C, c_MERGED, (const bf16_t*)(wb + WB_WO), 1024, 1024, 0, 0, S, e); }
__device__ __forceinline__ void g_ffn(const Ctx& C0, int l) { PHASE_CTX(C0); LAYER_PTRS();
    EpiFfn e{c_H}; FfnOrder S; S.S.init(M, 5632, C.G, C.bid);
    run_gemm(C, c_XN, (const bf16_t*)(wb + WB_WU), 5632, 1024, 0, 0, S, e); }
__device__ __forceinline__ void g_down(const Ctx& C0, int l) { PHASE_CTX(C0); LAYER_PTRS();
    EpiRes e{WSP(bf16_t, W_XB0), WSP(bf16_t, W_XB1), WSP(bf16_t, W_XB0), WSP(bf16_t, W_XB1), MODl + 5120, 1, 1};
    if (l == 1) { e.o0 = c_X; e.o1 = c_X + (size_t)NPROMPT * D; e.out_bf16 = 0; }
    pg8::StaticOrder S; S.init(M, 1024, C.G, C.bid);
    run_gemm(C, c_H, (const bf16_t*)(wb + WB_WD), 1024, FFN, 0, 0, S, e); }

__global__ void __launch_bounds__(NT, 2) mk_fwd(Params P_unused) {
    extern __shared__ __attribute__((aligned(16))) unsigned char lds[];
    Ctx C;
    C.lds = lds; C.tid = threadIdx.x; C.lane = C.tid & 63; C.wave = __builtin_amdgcn_readfirstlane(C.tid >> 6); C.G = gridDim.x; C.bid = blockIdx.x;
    volatile LAS unsigned* MISCL = (volatile LAS unsigned*)((LAS unsigned char*)lds + LDS_MISC);
    if (C.tid < 64) MISCL[C.tid] = 0u;
    __syncthreads();
    XcdBarrier bar;
    { KArgPtr Pk = kargs(); bar = xcd_barrier_post((unsigned*)(WS_ + W_CTL) + 1024, MISCL + 8); }
#define GRID_BAR() xcd_barrier(bar)

#ifndef DUP
#define DUP -1
#endif
#define RUN(id, stmt) do { stmt; if (DUP == (id)) { stmt; } } while (0)
    RUN(0, ph_s5_tables<0>(C); ph_mod(C); ph_prep(C); ph_wconv(C));
    if (DUP == 30) ph_s5_tables<0>(C); if (DUP == 31) ph_mod(C); if (DUP == 32) ph_wconv(C);
    GRID_BAR();
#pragma unroll 1
    for (int l0 = 0; l0 < 2; ++l0) {
        const int l = launder_s(l0);
        if (l == 0) { RUN(33, ph_s5_tables<1>(C)); }
        RUN(1, g_norm1(C, l));
        GRID_BAR();
        RUN(2, g_inproj(C, l)); ph_cache(C, l, C.G - C.G / 4);
        GRID_BAR();
        RUN(3, ph_gla_prep(C, l)); RUN(4, g_s5a(C, l));
        GRID_BAR();
        RUN(5, ph_gla_scan(C, l)); RUN(6, ph_s5_scan(C, l)); RUN(7, ph_attn(C, l, 256, 512)); if (DUP == 16) ph_attn(C, l, 0, 256); if (DUP == 17) ph_attn(C, l, 256, 512);
        if (DUP >= 21 && DUP <= 26) ph_attn<DUP - 20>(C, l, 256, 512);
        GRID_BAR();
        RUN(8, ph_gla_out(C, l)); RUN(9, g_s5c(C, l));
        if (C.G == 256) { __syncthreads(); ph_attn(C, l, 0, 256, 128); } else ph_attn(C, l, 0, 256);
        GRID_BAR();
        RUN(10, g_glu(C, l)); RUN(11, g_gates(C, l));
        GRID_BAR();
        RUN(12, g_branch(C, l));
        GRID_BAR();
        g_out(C, l);
        GRID_BAR();
        RUN(13, g_norm2(C, l));
        GRID_BAR();
        RUN(14, g_ffn(C, l));
        GRID_BAR();
        g_down(C, l);
        GRID_BAR();
        if (DUP == 15) { for (int q = 0; q < 10; ++q) GRID_BAR(); }
    }
}

extern "C" void kernel_launch(void* const* d_in, const int* in_sizes, int n_in, void* d_out, int out_size, void* d_ws, size_t ws_size, hipStream_t stream) {
    static int grid = 0;
    if (grid == 0) {
        if (n_in != 35 || ws_size < W_END) { fprintf(stderr, "kernel_launch: unexpected n_in %d / ws %zu\n", n_in, ws_size); grid = -1; return; }
        int dev = 0, cus = 0, per_cu = 0;
        if (hipGetDevice(&dev) != hipSuccess || hipDeviceGetAttribute(&cus, hipDeviceAttributeMultiprocessorCount, dev) != hipSuccess) { grid = -1; return; }
        if (hipFuncSetAttribute((const void*)mk_fwd, hipFuncAttributeMaxDynamicSharedMemorySize, LDS_BYTES) != hipSuccess) { fprintf(stderr, "kernel_launch: hipFuncSetAttribute failed\n"); grid = -1; return; }
        if (hipOccupancyMaxActiveBlocksPerMultiprocessor(&per_cu, (const void*)mk_fwd, NT, LDS_BYTES) != hipSuccess || per_cu < 1) { fprintf(stderr, "kernel_launch: occupancy query says %d\n", per_cu); per_cu = 1; }
        (void)hipGetLastError();
        grid = cus;
    }
    if (grid < 0) return;
    (void)hipMemsetAsync((char*)d_ws + W_CTL, 0, CTL_BYTES, stream);
    Params p{};
    for (int i = 0; i < 35; ++i) p.in[i] = (const float*)d_in[i];
    p.out = (float*)d_out; p.ws = (unsigned char*)d_ws;
    hipLaunchKernelGGL(mk_fwd, dim3(grid), dim3(NT), LDS_BYTES, stream, p);
}
```

```cpp
#include <hip/hip_runtime.h>
#include <stdint.h>
#include <cstdio>

typedef unsigned short bf16_t;
typedef short bf16x8 __attribute__((ext_vector_type(8)));
typedef float f32x4 __attribute__((ext_vector_type(4)));
#define LAS __attribute__((address_space(3)))

constexpr int D = 1024, NPROMPT = 8192, M = 16384;
constexpr int SEQ = 256, DSEQ = 2048;
constexpr int IN_DIM = 6688, FFN = 2816;
constexpr float EPS = 1e-6f;
constexpr int C_AQ = 0, C_AK = 512, C_AV = 1024, C_BQ = 1536, C_BK = 1792, C_BV = 2048, C_BG = 2560, C_BR = 3072, C_CU = 3104, C_GZ = 3616;
constexpr int N_MIX = 3616;
constexpr size_t O_YP = 0, O_YS = 8388608, O_NK = 16777216, O_NV = 25165824, O_NG = 33554432, O_NS = 37748736;

constexpr size_t MiB = 1u << 20;
constexpr size_t W_CTL = 0, CTL_BYTES = 65536;
constexpr size_t W_MOD = 65536;
constexpr size_t W_MISC = 65536 + 262144;
constexpr size_t W_XN = 1 * MiB;
constexpr size_t W_AQ = 33 * MiB;
constexpr size_t W_AK = 49 * MiB;
constexpr size_t W_AV = 66 * MiB;
constexpr size_t W_BQ = 83 * MiB;
constexpr size_t W_BK = 91 * MiB;
constexpr size_t W_BV = 99 * MiB;
constexpr size_t W_BG = 115 * MiB;
constexpr size_t W_BR = 131 * MiB;
constexpr size_t W_CU = 133 * MiB;
constexpr size_t W_GF = 149 * MiB;
constexpr size_t W_GB = 165 * MiB;
constexpr size_t W_YF = 181 * MiB;
constexpr size_t W_OA = 197 * MiB;
constexpr size_t W_OB = 213 * MiB;
constexpr size_t W_OC = 229 * MiB;
constexpr size_t W_GATES = 245 * MiB;
constexpr size_t W_GDS = 149 * MiB;
constexpr size_t W_GLA = 245 * MiB;
constexpr size_t W_MERGED = 341 * MiB;
constexpr size_t W_H = 373 * MiB;
constexpr size_t W_MF = W_H;
constexpr size_t W_WB = 461 * MiB;
constexpr size_t WB_LAYER = 36 * MiB;
constexpr size_t WB_WI = 0, WB_WZ = WB_WI + 3840 * 1024 * 2, WB_WG = WB_WZ + 3072 * 1024 * 2, WB_WR = WB_WG + 1024 * 512 * 2, WB_WO = WB_WR + 3 * 1024 * 512 * 2,
                 WB_WU = WB_WO + 1024 * 1024 * 2, WB_WD = WB_WU + 5632 * 1024 * 2;
static_assert(WB_WD + 1024 * 2816 * 2 == WB_LAYER, "weight copy map");
constexpr size_t W_TAB0 = 373 * MiB;
constexpr size_t W_UH = 405 * MiB;
constexpr size_t W_HLOC = 429 * MiB;
constexpr size_t W_TAB1 = 533 * MiB;
constexpr size_t W_ATAB = 524288;
constexpr size_t W_KG = 565 * MiB;
constexpr size_t W_KAUX = 569 * MiB;
constexpr size_t W_XB0 = 133 * MiB;
constexpr size_t W_XB1 = 565 * MiB;
constexpr size_t W_END = 581 * MiB;

constexpr int NT = 512, NWAVE = 8;
constexpr int LDS_BYTES = 163840;
constexpr int LDS_MISC = 163840 - 256;

__device__ __forceinline__ float bf2f(bf16_t h) { return __uint_as_float((unsigned)h << 16); }
typedef float f32x2_t __attribute__((ext_vector_type(2)));
typedef __bf16 bf16x2_t __attribute__((ext_vector_type(2)));
__device__ __forceinline__ unsigned pk2(float lo, float hi) { const f32x2_t v = {lo, hi}; return __builtin_bit_cast(unsigned, __builtin_convertvector(v, bf16x2_t)); }
__device__ __forceinline__ unsigned pk2_valu(float lo, float hi) { unsigned r; asm("v_cvt_pk_bf16_f32 %0, %1, %2" : "=v"(r) : "v"(lo), "v"(hi)); return r; }
__device__ __forceinline__ bf16_t f2bf(float f) { return (bf16_t)(pk2(f, 0.f) & 0xffffu); }
__device__ __forceinline__ float shx(float v, int k, int lane) { return __builtin_bit_cast(float, __builtin_amdgcn_ds_bpermute((lane ^ k) << 2, __builtin_bit_cast(int, v))); }
__device__ __forceinline__ float xsum32(float v) { const auto rr = __builtin_amdgcn_permlane32_swap(__float_as_uint(v), __float_as_uint(v), false, false); return __uint_as_float(rr[0]) + __uint_as_float(rr[1]); }
__device__ __forceinline__ float sigmoidf_(float x) { return 1.f / (1.f + __expf(-x)); }
__device__ __forceinline__ float siluf_(float x) { return x / (1.f + __expf(-x)); }
__device__ __forceinline__ float gelu_tanh(float x) { return 0.5f * x * (1.f + tanhf(0.7978845608028654f * (x + 0.044715f * x * x * x))); }
__device__ __forceinline__ int cond_row(int m) { return m < NPROMPT ? 0 : 1 + ((m - NPROMPT) >> 11); }
__device__ __forceinline__ int krow_of(int m) { return m < NPROMPT ? m : NPROMPT + ((m - NPROMPT) >> 11) * 2304 + 256 + ((m - NPROMPT) & 2047); }

#define XB_TMO      128
#define XB_XCNT(j)  (256  + 64 * (j))
#define XB_XSUB(j)  (1280 + 64 * (j))
#define XB_XGEN(j)  (2304 + 64 * (j))
#define XB_TOP      3328
#define XB_TOPGEN   3392
#define XCD_BAR_WORDS 3456
#define XB_SPIN_CAP (1u << 18)
__device__ __forceinline__ unsigned xb_ld(unsigned* p)              { return __hip_atomic_load(p, __ATOMIC_RELAXED, __HIP_MEMORY_SCOPE_AGENT); }
__device__ __forceinline__ unsigned xb_add(unsigned* p, unsigned v) { return __hip_atomic_fetch_add(p, v, __ATOMIC_RELAXED, __HIP_MEMORY_SCOPE_AGENT); }
__device__ __forceinline__ unsigned xb_xcc_id() { return (unsigned)__builtin_amdgcn_s_getreg((3 << 11) | 20) & 0xFu; }
#define XB_SPIN(cond, bar) do { unsigned _sp = 0; while (cond) { __builtin_amdgcn_s_sleep(1); \
    if ((++_sp & 255u) == 0u) { if (xb_ld(&(bar)[XB_TMO])) break; if (_sp > XB_SPIN_CAP) { atomicAdd(&(bar)[XB_TMO], 1u); break; } } } } while (0)
struct XcdBarrier { unsigned* bar; unsigned x; volatile LAS unsigned* st; };
__device__ __forceinline__ XcdBarrier xcd_barrier_post(unsigned* bar, volatile LAS unsigned* st) {
    XcdBarrier b; b.bar = bar; b.x = xb_xcc_id(); b.st = st;
    if (threadIdx.x == 0) (void)xb_add(&bar[XB_XCNT(b.x)], 1u);
    return b;
}
__device__ __forceinline__ void xcd_barrier_complete(unsigned* bar, unsigned x, unsigned& nloc, unsigned& nx) {
    const unsigned G = gridDim.x * gridDim.y * gridDim.z;
    unsigned sum, cnt, mine, sp = 0u;
    for (;;) {
        sum = 0u; cnt = 0u; mine = 0u;
#pragma unroll
        for (unsigned j = 0; j < 16; ++j) { const unsigned c = xb_ld(&bar[XB_XCNT(j)]); sum += c; cnt += (c > 0u) ? 1u : 0u; mine = (j == x) ? c : mine; }
        if (sum == G) break;
        __builtin_amdgcn_s_sleep(1);
        if ((++sp & 255u) == 0u) { if (xb_ld(&bar[XB_TMO])) break; if (sp > XB_SPIN_CAP) { atomicAdd(&bar[XB_TMO], 1u); break; } }
    }
    nloc = mine > 0u ? mine : 1u; nx = cnt > 0u ? cnt : 1u;
}
__device__ __forceinline__ void xcd_barrier(const XcdBarrier& b) {
    asm volatile("s_waitcnt vmcnt(0)" ::: "memory");
    __syncthreads();
    if (threadIdx.x == 0) {
        unsigned* bar = b.bar; asm volatile("" : "+s"(bar));
        unsigned bx = b.x; asm volatile("" : "+s"(bx));
        __builtin_amdgcn_s_waitcnt(0);
        unsigned nloc = b.st[0], nx = b.st[1];
        if (nloc == 0u) { xcd_barrier_complete(bar, bx, nloc, nx); b.st[0] = nloc; b.st[1] = nx; }
        const unsigned old = xb_add(&bar[XB_XSUB(bx)], 1u);
        const unsigned gen = old / nloc;
        if (old + 1u == (gen + 1u) * nloc) {
            __builtin_amdgcn_fence(__ATOMIC_RELEASE, "agent");
            asm volatile("s_waitcnt vmcnt(0)" ::: "memory");
            const unsigned og = xb_add(&bar[XB_TOP], 1u);
            const unsigned tg = og / nx;
            if (og + 1u == (tg + 1u) * nx) xb_add(&bar[XB_TOPGEN], 1u);
            else XB_SPIN(xb_ld(&bar[XB_TOPGEN]) == tg, bar);
            __builtin_amdgcn_fence(__ATOMIC_ACQUIRE, "agent");
            xb_add(&bar[XB_XGEN(bx)], 1u);
            asm volatile("s_waitcnt vmcnt(0)" ::: "memory");
        } else {
            XB_SPIN(xb_ld(&bar[XB_XGEN(bx)]) == gen, bar);
            __builtin_amdgcn_fence(__ATOMIC_ACQUIRE, "agent");
            asm volatile("s_waitcnt vmcnt(0)" ::: "memory");
        }
    }
    __syncthreads();
}

__device__ __forceinline__ int launder_v(int x) { asm volatile("" : "+v"(x)); return x; }
__device__ __forceinline__ int launder_s(int x) { asm volatile("" : "+s"(x)); return x; }
struct Params { const float* in[35]; float* out; unsigned char* ws; };
struct Ctx {
    unsigned char* lds;
    int tid, lane, wave, G, bid;
};
typedef const __attribute__((address_space(4))) Params* KArgPtr;
__device__ __forceinline__ KArgPtr kargs() { KArgPtr p = (KArgPtr)__builtin_amdgcn_kernarg_segment_ptr(); asm volatile("" : "+s"(p)); return p; }
#define PHASE_CTX(C0) KArgPtr Pk = kargs(); Ctx C = (C0); C.tid = launder_v(C0.tid); C.lane = C.tid & 63; C.wave = __builtin_amdgcn_readfirstlane(C.tid >> 6); C.bid = launder_s(C0.bid)
#define GAS __attribute__((address_space(1)))
#define IN_(i) ((const float*)(GAS const float*)(Pk->in[i]))
#define WS_ ((unsigned char*)(GAS unsigned char*)(Pk->ws))
#define OUT_ ((float*)(GAS float*)(Pk->out))
#define WSP(T, off) ((T*)(WS_ + (off)))
#define c_x_prompt IN_(0)
#define c_x_sample IN_(1)
#define c_cache_k IN_(2)
#define c_cache_v IN_(3)
#define c_state_gla IN_(4)
#define c_state_s5 IN_(5)
#define c_c IN_(6)
#define c_c_ctx IN_(7)
#define c_w_mod IN_(8)
#define c_b_mod IN_(9)
#define c_norm1_g IN_(10)
#define c_norm2_g IN_(11)
#define c_w_in IN_(12)
#define c_qn_g IN_(13)
#define c_kn_g IN_(14)
#define c_diff_lam IN_(15)
#define c_subln_g IN_(16)
#define c_gla_wa2 IN_(17)
#define c_gla_ba IN_(18)
#define c_gla_on_g IN_(19)
#define c_s5_lam_re IN_(20)
#define c_s5_lam_im IN_(21)
#define c_s5_log_dt IN_(22)
#define c_s5_b_re IN_(23)
#define c_s5_b_im IN_(24)
#define c_s5_c_re IN_(25)
#define c_s5_c_im IN_(26)
#define c_s5_d IN_(27)
#define c_s5_w_glu IN_(28)
#define c_s5_b_glu IN_(29)
#define c_w_branch IN_(30)
#define c_w_out IN_(31)
#define c_w_gate IN_(32)
#define c_w_up IN_(33)
#define c_w_down IN_(34)
#define c_out OUT_
#define c_X (OUT_ + O_YP)
#define c_MOD WSP(float, W_MOD)
#define c_MISC WSP(float, W_MISC)
#define c_XN WSP(bf16_t, W_XN)
#define c_AQ WSP(bf16_t, W_AQ)
#define c_AK WSP(bf16_t, W_AK)
#define c_AV WSP(bf16_t, W_AV)
#define c_BQ WSP(bf16_t, W_BQ)
#define c_BK WSP(bf16_t, W_BK)
#define c_BV WSP(bf16_t, W_BV)
#define c_BG WSP(bf16_t, W_BG)
#define c_BR WSP(float, W_BR)
#define c_CU WSP(bf16_t, W_CU)
#define c_GF WSP(bf16_t, W_GF)
#define c_GB WSP(bf16_t, W_GB)
#define c_YF WSP(bf16_t, W_YF)
#define c_OA WSP(bf16_t, W_OA)
#define c_OB WSP(bf16_t, W_OB)
#define c_OC WSP(bf16_t, W_OC)
#define c_GATES WSP(bf16_t, W_GATES)
#define c_MERGED WSP(bf16_t, W_MERGED)
#define c_H WSP(bf16_t, W_H)

__device__ __forceinline__ void ph_mod(const Ctx& C0) {
    PHASE_CTX(C0);
    float (*sc)[1024] = (float (*)[1024])C.lds;
    float (*red)[5][64] = (float (*)[5][64])(C.lds + 5 * 1024 * 4);
    for (int item = C.bid; item < 192; item += C.G) {
        const int l = item / 96, n0 = (item % 96) * 64, tid = C.tid;
        __syncthreads();
        for (int i = tid; i < 5 * 1024; i += NT) { const int r = i >> 10, k = i & 1023; const float v = r == 0 ? c_c_ctx[k] : c_c[(r - 1) * 1024 + k]; sc[r][k] = siluf_(v); }
        __syncthreads();
        const int cn = tid & 63, ks = tid >> 6;
        float acc[5] = {0.f, 0.f, 0.f, 0.f, 0.f};
        const float* w = c_w_mod + (size_t)l * 1024 * 6144 + n0 + cn;
        for (int k = ks * 128; k < ks * 128 + 128; ++k) { const float wv = w[(size_t)k * 6144];
#pragma unroll
            for (int r = 0; r < 5; ++r) acc[r] += sc[r][k] * wv; }
#pragma unroll
        for (int r = 0; r < 5; ++r) red[ks][r][cn] = acc[r];
        __syncthreads();
        if (tid < 320) { const int r = tid >> 6, cc = tid & 63; float s = 0.f;
#pragma unroll
            for (int k8 = 0; k8 < 8; ++k8) s += red[k8][r][cc];
            c_MOD[((size_t)l * 5 + r) * 6144 + n0 + cc] = s + c_b_mod[(size_t)l * 6144 + n0 + cc]; }
    }
}
__device__ __forceinline__ void ph_prep(const Ctx& C0) {
    PHASE_CTX(C0);
    if (C.bid != C.G - 1) return;
    const int tid = C.tid; float* misc = c_MISC;
    if (tid < 2) {
        const float* lv = c_diff_lam + tid * 256; float s01 = 0.f, s23 = 0.f;
        for (int i = 0; i < 64; ++i) { s01 += lv[i] * lv[64 + i]; s23 += lv[128 + i] * lv[192 + i]; }
        const float lam_init = 0.8f - 0.6f * expf(-0.3f * (float)tid);
        misc[tid] = expf(s01) - expf(s23) + lam_init;
    }
    for (int i = tid; i < 64 * 16; i += NT) {
        const int pos = i >> 4, f = i & 15;
        const float inv = powf(10000.f, -(float)(2 * f) / 32.f);
        const float ang = (float)pos * inv;
        misc[64 + i] = cosf(ang); misc[64 + 1024 + i] = sinf(ang);
    }
}
__device__ __forceinline__ void ph_cache(const Ctx& C0, int l, int wg0 = 0) {
    PHASE_CTX(C0);
    if (C.bid < wg0) return;
#pragma unroll 4
    for (int i = (C.bid - wg0) * NT + C.tid; i < 4 * 256 * 128; i += (C.G - wg0) * NT) {
        const int col = (i & 127) * 4, j = (i >> 7) & 255, b = i >> 15;
        const size_t src = ((size_t)(b * 2 + l) * 256 + j) * 512 + col;
        const size_t dst = (size_t)(NPROMPT + b * 2304 + j) * 512 + col;
        const f32x4 kx = *(const f32x4*)(c_cache_k + src), vx = *(const f32x4*)(c_cache_v + src);
        uint2 ko, vo; ko.x = pk2(kx[0], kx[1]); ko.y = pk2(kx[2], kx[3]); vo.x = pk2(vx[0], vx[1]); vo.y = pk2(vx[2], vx[3]);
        *(uint2*)(c_AK + dst) = ko; *(uint2*)(c_AV + dst) = vo;
    }
}
__device__ __forceinline__ void ph_norm(const Ctx& C0, const void* x0, const void* x1, bool in_bf16, const float* g, const float* MODl, int which) {
    PHASE_CTX(C0);
    const int lane = C.lane;
    for (int m = C.bid * NWAVE + C.wave; m < M; m += C.G * NWAVE) {
        const size_t ro = m < NPROMPT ? (size_t)m * D : (size_t)(m - NPROMPT) * D;
        const float* mod = MODl + (size_t)cond_row(m) * 6144 + which * 3072;
        float4 v[4]; float ss = 0.f;
        if (in_bf16) { const bf16_t* xr = (const bf16_t*)(m < NPROMPT ? x0 : x1) + ro;
#pragma unroll
            for (int j = 0; j < 4; ++j) { const uint2 w = *(const uint2*)(xr + j * 256 + lane * 4);
                v[j] = make_float4(__uint_as_float(w.x << 16), __uint_as_float(w.x & 0xffff0000u), __uint_as_float(w.y << 16), __uint_as_float(w.y & 0xffff0000u)); }
        } else { const float* xr = (const float*)(m < NPROMPT ? x0 : x1) + ro;
#pragma unroll
            for (int j = 0; j < 4; ++j) v[j] = *(const float4*)(xr + j * 256 + lane * 4); }
#pragma unroll
        for (int j = 0; j < 4; ++j) ss += v[j].x * v[j].x + v[j].y * v[j].y + v[j].z * v[j].z + v[j].w * v[j].w;
#pragma unroll
        for (int o = 1; o < 32; o <<= 1) ss += shx(ss, o, lane);
        ss = xsum32(ss);
        const float rs = rsqrtf(ss * (1.f / D) + EPS);
#pragma unroll
        for (int j = 0; j < 4; ++j) {
            const int c0 = j * 256 + lane * 4;
            const float4 gg = *(const float4*)(g + c0), sh = *(const float4*)(mod + c0), sc = *(const float4*)(mod + 1024 + c0);
            ushort4 o;
            o.x = f2bf(v[j].x * rs * gg.x * (1.f + sc.x) + sh.x); o.y = f2bf(v[j].y * rs * gg.y * (1.f + sc.y) + sh.y);
            o.z = f2bf(v[j].z * rs * gg.z * (1.f + sc.z) + sh.z); o.w = f2bf(v[j].w * rs * gg.w * (1.f + sc.w) + sh.w);
            *(ushort4*)(c_XN + (size_t)m * D + c0) = o;
        }
    }
}

typedef float f32x16 __attribute__((ext_vector_type(16)));
typedef short s16x4 __attribute__((ext_vector_type(4)));
typedef unsigned u32x4_t __attribute__((ext_vector_type(4)));
constexpr int AT_KROW = 72;
constexpr int AT_VROW = 68;
constexpr int AT_KBYTES = 2 * 64 * AT_KROW * 2, AT_VBYTES = 128 * AT_VROW * 2, AT_BUF = AT_KBYTES + AT_VBYTES;
__device__ __forceinline__ unsigned pk_bf16(float lo, float hi) { return pk2(lo, hi); }
template <int XM = 0>
__device__ __forceinline__ void ph_attn(const Ctx& C0, int l, int item_lo = 0, int item_hi = 512, int nwg = 0) {
    PHASE_CTX(C0);
    const int tid = C.tid, lane = C.lane, w = C.wave, map = w >> 2, qb = w & 3, r32 = lane & 31, hi = lane >> 5;
    unsigned char* lds = C.lds;
    const float* subg = c_subln_g + l * 128;
    const float lam = c_MISC[l];
    const bf16_t* AKp = c_AK; const bf16_t* AVp = c_AV;
    const int sk_key = tid >> 3, sk_ch = tid & 7;
    const int sv_kp = tid & 31, sv_ec = tid >> 5;
    constexpr int AT_NBUF = 3;
    constexpr float CS = 0.125f * 1.4426950408889634f;
    const int NW = nwg > 0 ? nwg : C.G;
    if (C.bid >= NW) return;
    const int vbid = (NW % 8 == 0) ? (C.bid & 7) * (NW / 8) + (C.bid >> 3) : C.bid;
    for (int item = item_lo + vbid; item < item_hi; item += NW) {
        int m0, kr0, Lk, h;
        if (item < 256) { const int b = item >> 3; h = (item >> 1) & 3; const int q2 = item & 1; m0 = b * 256 + q2 * 128; kr0 = b * 256; Lk = 256; }
        else { const int j = item - 256; const int b = j >> 6; h = (j >> 4) & 3; const int q2 = j & 15; m0 = NPROMPT + b * 2048 + q2 * 128; kr0 = NPROMPT + b * 2304; Lk = 2304; }
        const int NTL = Lk >> 6;
        bf16x8* sQ = (bf16x8*)(lds + AT_NBUF * AT_BUF) + (w * 4) * 64 + lane;
        f32x16 o[4];
#pragma unroll
        for (int eb = 0; eb < 4; ++eb)
#pragma unroll
            for (int r = 0; r < 16; ++r) o[eb][r] = 0.f;
        float mrun = -1e30f, lsum = 0.f, alpha = 1.f, mc = 0.f;
        uint4 kreg0, kreg1, vreg0, vreg1;
        unsigned pfw[16];
#define PF(ks_) __builtin_bit_cast(bf16x8, (u32x4_t){pfw[4 * (ks_)], pfw[4 * (ks_) + 1], pfw[4 * (ks_) + 2], pfw[4 * (ks_) + 3]})
        f32x16 pa0, pa1;
#define AT_LOAD(t_) do { const bf16_t* kp_ = AKp + (size_t)(kr0 + (t_) * 64 + sk_key) * 512 + h * 128 + sk_ch * 16; kreg0 = *(const uint4*)kp_; kreg1 = *(const uint4*)(kp_ + 8); \
            const bf16_t* vp_ = AVp + (size_t)(kr0 + (t_) * 64 + 2 * sv_kp) * 512 + h * 128 + sv_ec * 8; vreg0 = *(const uint4*)vp_; vreg1 = *(const uint4*)(vp_ + 512); } while (0)
#define AT_WRITE(t_) do { unsigned char* wb_ = lds + ((t_) % AT_NBUF) * AT_BUF; \
            bf16_t* kd_ = (bf16_t*)wb_ + ((sk_ch >> 2) * 64 + sk_key) * AT_KROW + (sk_ch & 3) * 16; *(uint4*)kd_ = kreg0; *(uint4*)(kd_ + 8) = kreg1; \
            bf16_t* vt_ = (bf16_t*)(wb_ + AT_KBYTES) + (sv_ec * 8) * AT_VROW + 2 * sv_kp; \
            const unsigned a_[4] = {vreg0.x, vreg0.y, vreg0.z, vreg0.w}, b_[4] = {vreg1.x, vreg1.y, vreg1.z, vreg1.w}; \
            _Pragma("unroll") for (int i = 0; i < 4; ++i) { *(unsigned*)(vt_ + (2 * i) * AT_VROW) = (a_[i] & 0xffffu) | (b_[i] << 16); *(unsigned*)(vt_ + (2 * i + 1) * AT_VROW) = (a_[i] >> 16) | (b_[i] & 0xffff0000u); } } while (0)
#define SB() __builtin_amdgcn_sched_barrier(0)
#define AT_M(P0, P1) do { asm volatile("s_nop 15\n\ts_nop 7" : "+v"(P0), "+v"(P1)); float mt_ = -1e30f; \
            _Pragma("unroll") for (int r = 0; r < 16; ++r) asm("v_max3_f32 %0, %1, %2, %3" : "=v"(mt_) : "v"(mt_), "v"(P0[r]), "v"(P1[r])); \
            { const auto rr_ = __builtin_amdgcn_permlane32_swap(__float_as_uint(mt_), __float_as_uint(mt_), false, false); asm("v_max_f32_e32 %0, %1, %2" : "=v"(mt_) : "v"(__uint_as_float(rr_[0])), "v"(__uint_as_float(rr_[1]))); } \
            float mn_; asm("v_max_f32_e32 %0, %1, %2" : "=v"(mn_) : "v"(mrun), "v"(mt_)); \
            alpha = __builtin_amdgcn_exp2f((mrun - mn_) * CS); mrun = mn_; mc = -mn_ * CS; } while (0)
#define AT_EXP2(P, i_) do { if (XM == 2) { P[i_] = __builtin_fmaf(P[i_], CS, mc); P[(i_) + 1] = __builtin_fmaf(P[(i_) + 1], CS, mc); } else { P[i_] = __builtin_amdgcn_exp2f(__builtin_fmaf(P[i_], CS, mc)); P[(i_) + 1] = __builtin_amdgcn_exp2f(__builtin_fmaf(P[(i_) + 1], CS, mc)); } \
            asm volatile("" : "+v"(P[i_]), "+v"(P[(i_) + 1])); } while (0)
#define AT_X(HASV, tv_, P0, P1) do { const bf16_t* sVt_ = (const bf16_t*)(lds + ((tv_) % AT_NBUF) * AT_BUF + AT_KBYTES) + r32 * AT_VROW + 4 * hi; \
            _Pragma("unroll") for (int eb = 0; eb < 4; ++eb) { s16x4 vl_[4], vh_[4]; \
                if (HASV) { _Pragma("unroll") for (int ks = 0; ks < 4; ++ks) { vl_[ks] = *(const s16x4*)(sVt_ + eb * 32 * AT_VROW + ks * 16); vh_[ks] = *(const s16x4*)(sVt_ + eb * 32 * AT_VROW + ks * 16 + 8); } SB(); } \
                _Pragma("unroll") for (int ks = 0; ks < 4; ++ks) { \
                    if (HASV) { const bf16x8 vf_ = __builtin_shufflevector(vl_[ks], vh_[ks], 0, 1, 2, 3, 4, 5, 6, 7); o[eb] = __builtin_amdgcn_mfma_f32_32x32x16_bf16(vf_, PF(ks), o[eb], 0, 0, 0); } \
                    if (eb < 2) AT_EXP2(P0, eb * 8 + ks * 2); else AT_EXP2(P1, (eb - 2) * 8 + ks * 2); SB(); } } } while (0)
#define AT_Q(t_, P0, P1) do { const bf16_t* sKm_ = (const bf16_t*)(lds + ((t_) % AT_NBUF) * AT_BUF) + (map * 64) * AT_KROW + r32 * AT_KROW + hi * 8; \
            bf16x8 kf0_[4], kf1_[4], qf_[4]; \
            _Pragma("unroll") for (int s4 = 0; s4 < 4; ++s4) { qf_[s4] = sQ[s4 * 64]; kf0_[s4] = *(const bf16x8*)(sKm_ + s4 * 16); kf1_[s4] = *(const bf16x8*)(sKm_ + 32 * AT_KROW + s4 * 16); } \
            _Pragma("unroll") for (int r = 0; r < 16; ++r) { P0[r] = 0.f; P1[r] = 0.f; } SB(); \
            _Pragma("unroll") for (int s4 = 0; s4 < 4; ++s4) { P0 = __builtin_amdgcn_mfma_f32_32x32x16_bf16(kf0_[s4], qf_[s4], P0, 0, 0, 0); P1 = __builtin_amdgcn_mfma_f32_32x32x16_bf16(kf1_[s4], qf_[s4], P1, 0, 0, 0); } } while (0)
#define AT_S(P0, P1) do { float ps_ = 0.f; \
            _Pragma("unroll") for (int c = 0; c < 4; ++c) { ps_ += (P0[4 * c] + P0[4 * c + 1]) + (P0[4 * c + 2] + P0[4 * c + 3]) + (P1[4 * c] + P1[4 * c + 1]) + (P1[4 * c + 2] + P1[4 * c + 3]); \
                pfw[4 * (c >> 1) + (c & 1) * 2] = pk2_valu(P0[4 * c], P0[4 * c + 1]); pfw[4 * (c >> 1) + (c & 1) * 2 + 1] = pk2_valu(P0[4 * c + 2], P0[4 * c + 3]); \
                pfw[8 + 4 * (c >> 1) + (c & 1) * 2] = pk2_valu(P1[4 * c], P1[4 * c + 1]); pfw[8 + 4 * (c >> 1) + (c & 1) * 2 + 1] = pk2_valu(P1[4 * c + 2], P1[4 * c + 3]); } \
            lsum += ps_; } while (0)
#define AT_RESCALE() do { if (__any(alpha != 1.f)) { lsum *= alpha; _Pragma("unroll") for (int eb = 0; eb < 4; ++eb) _Pragma("unroll") for (int r = 0; r < 16; ++r) o[eb][r] *= alpha; } } while (0)
#define AT_STEP(t_) do { \
            if (XM != 5) { AT_Q(t_, pa0, pa1); } AT_M(pa0, pa1); \
            if ((t_) > 0 && XM != 3) { AT_X(true, (t_) - 1, pa0, pa1); } else { AT_X(false, 0, pa0, pa1); } \
            AT_RESCALE(); AT_S(pa0, pa1); \
            if (XM != 6) __syncthreads();                        \
            if ((t_) + 2 < NTL && XM != 4) { AT_WRITE((t_) + 2); if ((t_) + 3 < NTL) AT_LOAD((t_) + 3); } } while (0)
        { const bf16_t* qp = c_AQ + (size_t)(m0 + qb * 32 + r32) * 512 + h * 128 + map * 64 + hi * 8;
#pragma unroll
          for (int s4 = 0; s4 < 4; ++s4) sQ[s4 * 64] = *(const bf16x8*)(qp + s4 * 16); }
        AT_LOAD(0);
        __syncthreads();
        AT_WRITE(0); AT_LOAD(1); AT_WRITE(1); AT_LOAD(2);
        __syncthreads();
        AT_STEP(0); alpha = 1.f;
#pragma unroll 1
        for (int t = 1; t < NTL; ++t) { AT_STEP(t); }
        { const bf16_t* sVt_ = (const bf16_t*)(lds + ((NTL - 1) % AT_NBUF) * AT_BUF + AT_KBYTES) + r32 * AT_VROW + 4 * hi;
#pragma unroll
          for (int eb = 0; eb < 4; ++eb)
#pragma unroll
              for (int ks = 0; ks < 4; ++ks) { const s16x4 lo = *(const s16x4*)(sVt_ + eb * 32 * AT_VROW + ks * 16), hv = *(const s16x4*)(sVt_ + eb * 32 * AT_VROW + ks * 16 + 8);
                  o[eb] = __builtin_amdgcn_mfma_f32_32x32x16_bf16(__builtin_shufflevector(lo, hv, 0, 1, 2, 3, 4, 5, 6, 7), PF(ks), o[eb], 0, 0, 0); } }
#undef PF
#undef AT_Q
#undef AT_S
#undef AT_LOAD
#undef AT_WRITE
#undef SB
#undef AT_M
#undef AT_EXP2
#undef AT_X
#undef AT_RESCALE
#undef AT_STEP
        lsum = xsum32(lsum);
        const float inv = 1.f / lsum;
        __syncthreads();
        float* xb = (float*)lds + (size_t)qb * (32 * 129);
        if (map == 1) {
#pragma unroll
            for (int eb = 0; eb < 4; ++eb)
#pragma unroll
                for (int r = 0; r < 16; ++r) xb[r32 * 129 + eb * 32 + (r & 3) + 8 * (r >> 2) + 4 * hi] = o[eb][r] * inv;
        }
        __syncthreads();
        if (map == 0 && (XM == 0 || lsum == 12345.678f)) {
            float ss = 0.f;
#pragma unroll
            for (int eb = 0; eb < 4; ++eb)
#pragma unroll
                for (int r = 0; r < 16; ++r) { const float d = o[eb][r] * inv - lam * xb[r32 * 129 + eb * 32 + (r & 3) + 8 * (r >> 2) + 4 * hi]; o[eb][r] = d; ss += d * d; }
            ss = xsum32(ss);
            const float lam_init = 0.8f - 0.6f * __expf(-0.3f * (float)l);
            const float rs = rsqrtf(ss * (1.f / 128.f) + EPS) * (1.f - lam_init);
            bf16_t* op = c_OA + (size_t)(m0 + qb * 32 + r32) * 512 + h * 128;
#pragma unroll
            for (int eb = 0; eb < 4; ++eb)
#pragma unroll
                for (int r4 = 0; r4 < 4; ++r4) {
                    const int e0 = eb * 32 + 8 * r4 + 4 * hi;
                    uint2 wv;
                    wv.x = pk_bf16(o[eb][4 * r4] * rs * subg[e0], o[eb][4 * r4 + 1] * rs * subg[e0 + 1]);
                    wv.y = pk_bf16(o[eb][4 * r4 + 2] * rs * subg[e0 + 2], o[eb][4 * r4 + 3] * rs * subg[e0 + 3]);
                    *(uint2*)(op + e0) = wv;
                }
        }
    }
}

constexpr int GT = 64;
constexpr size_t G_QK = 0;
constexpr size_t G_KDT = 48 * MiB;
constexpr size_t G_VT = 64 * MiB;
constexpr size_t G_SST = 80 * MiB;
constexpr size_t G_DEC = 112 * MiB;
constexpr size_t G_CQB = 112 * MiB + 524288;
__device__ __forceinline__ void ph_gla_prep(const Ctx& C0, int l) {
    PHASE_CTX(C0);
    const int tid = C.tid, dir = tid >> 8, h = (tid >> 6) & 3, kc = tid & 63, c = h * 64 + kc;
    float* sBR = (float*)C.lds;
    float* sPre = (float*)(C.lds + 8192);
    unsigned char* gb = WS_ + W_GLA;
    float wa[16];
#pragma unroll
    for (int r = 0; r < 16; ++r) wa[r] = c_gla_wa2[(((size_t)l * 2 + dir) * 16 + r) * 256 + c];
    const float bias = c_gla_ba[((size_t)l * 2 + dir) * 256 + c];
    bf16_t* QA = (bf16_t*)(gb + G_QK + (size_t)(dir * 3 + 0) * 8 * MiB); bf16_t* KA = (bf16_t*)(gb + G_QK + (size_t)(dir * 3 + 1) * 8 * MiB);
    for (int gc = C.bid; gc < 256; gc += C.G) {
        const int m0 = gc * GT;
        __syncthreads();
        { const float4* src = (const float4*)(c_BR + (size_t)m0 * 32); ((float4*)sBR)[tid] = src[tid]; }
        __syncthreads();
        float run = 0.f;
#pragma unroll 4
        for (int t = 0; t < 64; ++t) {
            float x = bias;
#pragma unroll
            for (int r = 0; r < 16; ++r) x += sBR[t * 32 + dir * 16 + r] * wa[r];
            const float ls = fminf(x, 0.f) - __logf(1.f + __expf(-fabsf(x)));
            run += ls * (1.f / 16.f); sPre[t * 512 + tid] = run;
        }
        const float p31 = sPre[31 * 512 + tid], p63 = run;
        const float cqb = __expf(dir == 0 ? p31 : p63 - p31), ckd = __expf(dir == 0 ? p63 - p31 : p31);
        bf16_t* KDT = (bf16_t*)(gb + G_KDT) + ((((size_t)gc * 4 + h) * 2 + dir) * 64 + kc) * 64;
        const bf16_t* BQp = c_BQ; const bf16_t* BKp = c_BK;
        bf16_t qn[16], kn[16];
#pragma unroll
        for (int tt = 0; tt < 16; ++tt) { const size_t idx = (size_t)(m0 + tt) * 256 + c; qn[tt] = BQp[idx]; kn[tt] = BKp[idx]; }
#pragma unroll 1
        for (int t16 = 0; t16 < 4; ++t16) {
            unsigned kdw[8];
            bf16_t qc[16], kc16[16];
#pragma unroll
            for (int tt = 0; tt < 16; ++tt) { qc[tt] = qn[tt]; kc16[tt] = kn[tt]; }
            { const int tn = t16 < 3 ? (t16 + 1) * 16 : 48;
#pragma unroll
              for (int tt = 0; tt < 16; ++tt) { const size_t idx = (size_t)(m0 + tn + tt) * 256 + c; qn[tt] = BQp[idx]; kn[tt] = BKp[idx]; } }
#pragma unroll
            for (int tt = 0; tt < 16; ++tt) {
                const int t = t16 * 16 + tt;
                const int te = dir == 0 ? t : t - 1;
                const float e = te < 0 ? 0.f : sPre[(te < 0 ? 0 : te) * 512 + tid];
                const float d = e - p31;
                const size_t idx = (size_t)(m0 + t) * 256 + c;
                const float qv = bf2f(qc[tt]), kv = bf2f(kc16[tt]);
                const float ed = __expf(dir == 0 ? d : -d), eid = __expf(dir == 0 ? -d : d);
                QA[idx] = f2bf(qv * ed); KA[idx] = f2bf(kv * eid);
                const float kd = kv * eid * ckd;
                if (tt & 1) kdw[tt >> 1] |= (unsigned)f2bf(kd) << 16; else kdw[tt >> 1] = (unsigned)f2bf(kd);
            }
            *(uint4*)(KDT + t16 * 16) = make_uint4(kdw[0], kdw[1], kdw[2], kdw[3]); *(uint4*)(KDT + t16 * 16 + 8) = make_uint4(kdw[4], kdw[5], kdw[6], kdw[7]);
        }
        ((float*)(gb + G_DEC))[(((size_t)gc * 4 + h) * 2 + dir) * 64 + kc] = __expf(p63);
        ((float*)(gb + G_CQB))[(((size_t)gc * 4 + h) * 2 + dir) * 64 + kc] = cqb;
        { const int hv = tid >> 7, vv = tid & 127; const bf16_t* BVp = c_BV;
          bf16_t* VT = (bf16_t*)(gb + G_VT) + (((size_t)gc * 4 + hv) * 128 + vv) * 64;
#pragma unroll 4
          for (int t8 = 0; t8 < 8; ++t8) { unsigned w4[4];
#pragma unroll
              for (int tt = 0; tt < 8; ++tt) { const unsigned x = BVp[(size_t)(m0 + t8 * 8 + tt) * 512 + hv * 128 + vv]; if (tt & 1) w4[tt >> 1] |= x << 16; else w4[tt >> 1] = x; }
              *(uint4*)(VT + t8 * 8) = make_uint4(w4[0], w4[1], w4[2], w4[3]); } }
        __syncthreads();
        { const int lane = C.lane, wv = C.wave, hh = wv >> 1, dd_ = wv & 1, r32 = lane & 31, hi = lane >> 5;
          const size_t cu = ((size_t)gc * 4 + hh) * 2 + dd_;
          const bf16_t* vtb = (const bf16_t*)(gb + G_VT) + ((size_t)gc * 4 + hh) * 128 * 64;
          const bf16_t* kdb = (const bf16_t*)(gb + G_KDT) + cu * 64 * 64;
          bf16_t* DS = WSP(bf16_t, W_GDS) + cu * 128 * 64;
          bf16x8 a4[4][4], b4[2][4];
#pragma unroll
          for (int vb = 0; vb < 4; ++vb)
#pragma unroll
              for (int s4 = 0; s4 < 4; ++s4) a4[vb][s4] = *(const bf16x8*)(vtb + (size_t)(vb * 32 + r32) * 64 + s4 * 16 + hi * 8);
#pragma unroll
          for (int kb = 0; kb < 2; ++kb)
#pragma unroll
              for (int s4 = 0; s4 < 4; ++s4) b4[kb][s4] = *(const bf16x8*)(kdb + (size_t)(kb * 32 + r32) * 64 + s4 * 16 + hi * 8);
#pragma unroll
          for (int t = 0; t < 8; ++t) { const int vb = t & 3, kb = t >> 2;
              f32x16 acc;
#pragma unroll
              for (int r = 0; r < 16; ++r) acc[r] = 0.f;
#pragma unroll
              for (int s4 = 0; s4 < 4; ++s4) acc = __builtin_amdgcn_mfma_f32_32x32x16_bf16(a4[vb][s4], b4[kb][s4], acc, 0, 0, 0);
#pragma unroll
              for (int r = 0; r < 16; ++r) DS[(size_t)(vb * 32 + (r & 3) + 8 * (r >> 2) + 4 * hi) * 64 + kb * 32 + r32] = f2bf(acc[r]); } }
    }
}
__device__ __forceinline__ int crow16(int r, int hi) { return (r & 3) + 8 * (r >> 2) + 4 * hi; }
__device__ __forceinline__ void ph_gla_scan(const Ctx& C0, int l) {
    PHASE_CTX(C0);
    const int tid = C.tid;
    unsigned char* gb = WS_ + W_GLA;
    const bf16_t* DSb = WSP(bf16_t, W_GDS);
    for (int task = C.bid; task < 576; task += C.G) {
        const int it = task < 64 ? 287 - (task >> 1) : (task - 64) >> 1, part = task & 1;
        const int dir = it & 1, h = (it >> 1) & 3, s = it >> 3;
        const bool latent = s >= 32;
        const int nch = latent ? 32 : 4, gc0 = latent ? 128 + (s - 32) * 32 : s * 4;
        const int v = part * 64 + (tid >> 3), kc0 = (tid & 7) * 8;
        float* sDec = (float*)C.lds; float* sCqb = sDec + 32 * 64;
        __syncthreads();
        for (int i = tid; i < nch * 64; i += NT) { const int n = i >> 6, kc = i & 63, gc = gc0 + (dir == 0 ? n : nch - 1 - n); const size_t cu = ((size_t)gc * 4 + h) * 2 + dir;
            sDec[i] = ((const float*)(gb + G_DEC))[cu * 64 + kc]; sCqb[i] = ((const float*)(gb + G_CQB))[cu * 64 + kc]; }
        float S[8];
        if (latent) { const float* si = c_state_gla + ((((size_t)(s - 32) * 2 + l) * 2 + dir) * 4 + h) * 8192 + v;
#pragma unroll
            for (int e = 0; e < 8; ++e) S[e] = si[(size_t)(kc0 + e) * 128]; }
        else {
#pragma unroll
            for (int e = 0; e < 8; ++e) S[e] = 0.f; }
        __syncthreads();
        const int nb = latent ? 16 : 4;
#pragma unroll 1
        for (int n0 = 0; n0 < nch; n0 += nb) {
            uint4 dsw[16];
#pragma unroll
            for (int b = 0; b < 16; ++b) if (b < nb) {
                const int gc = gc0 + (dir == 0 ? n0 + b : nch - 1 - n0 - b);
                const size_t cu = ((size_t)gc * 4 + h) * 2 + dir;
                dsw[b] = *(const uint4*)(DSb + (cu * 128 + v) * 64 + kc0); }
#pragma unroll
            for (int b = 0; b < 16; ++b) if (b < nb) {
                const int gc = gc0 + (dir == 0 ? n0 + b : nch - 1 - n0 - b);
                const size_t cu = ((size_t)gc * 4 + h) * 2 + dir;
                const f32x4 q0 = *(const f32x4*)(sCqb + (n0 + b) * 64 + kc0), q1 = *(const f32x4*)(sCqb + (n0 + b) * 64 + kc0 + 4), d0 = *(const f32x4*)(sDec + (n0 + b) * 64 + kc0), d1 = *(const f32x4*)(sDec + (n0 + b) * 64 + kc0 + 4);
                uint4 st; st.x = pk2(S[0] * q0[0], S[1] * q0[1]); st.y = pk2(S[2] * q0[2], S[3] * q0[3]); st.z = pk2(S[4] * q1[0], S[5] * q1[1]); st.w = pk2(S[6] * q1[2], S[7] * q1[3]);
                *(uint4*)((bf16_t*)(gb + G_SST) + (cu * 128 + v) * 64 + kc0) = st;
                const unsigned dw[4] = {dsw[b].x, dsw[b].y, dsw[b].z, dsw[b].w}; const float dc[8] = {d0[0], d0[1], d0[2], d0[3], d1[0], d1[1], d1[2], d1[3]};
#pragma unroll
                for (int q = 0; q < 4; ++q) { S[2 * q] = dc[2 * q] * S[2 * q] + __uint_as_float(dw[q] << 16); S[2 * q + 1] = dc[2 * q + 1] * S[2 * q + 1] + __uint_as_float(dw[q] & 0xffff0000u); }
            }
        }
        if (!latent) { float* so = c_out + O_NG + ((((size_t)s * 2 + l) * 2 + dir) * 4 + h) * 8192 + v;
#pragma unroll
            for (int e = 0; e < 8; ++e) so[(size_t)(kc0 + e) * 128] = S[e]; }
    }
}
__device__ __forceinline__ void ph_gla_out(const Ctx& C0, int l) {
    PHASE_CTX(C0);
    const int lane = C.lane, r32 = lane & 31, hi = lane >> 5;
    unsigned char* gb = WS_ + W_GLA;
    float* sO = (float*)C.lds + C.wave * (32 * 132);
    const float* ong = c_gla_on_g + l * 128;
    const bool bal = C.G == 256;
    const int nw = bal ? 1024 : C.G * NWAVE, wv = bal ? (C.bid - 128) * NWAVE + C.wave : C.bid * NWAVE + C.wave;
    if (bal && C.bid < 128) return;
    for (int task = wv; task < 2048; task += nw) {
        const int gc = task >> 3, h = (task >> 1) & 3, jb = task & 1, m0 = gc * GT;
        f32x16 o[4];
#pragma unroll
        for (int vq = 0; vq < 4; ++vq)
#pragma unroll
            for (int r = 0; r < 16; ++r) o[vq][r] = 0.f;
#pragma unroll
        for (int dir = 0; dir < 2; ++dir) {
            const bf16_t* QA = (const bf16_t*)(gb + G_QK + (size_t)(dir * 3 + 0) * 8 * MiB); const bf16_t* KA = (const bf16_t*)(gb + G_QK + (size_t)(dir * 3 + 1) * 8 * MiB);
            const size_t cu = ((size_t)gc * 4 + h) * 2 + dir;
            bf16x8 qf[4], kf[2][4];
            { const bf16_t* qp = QA + (size_t)(m0 + jb * 32 + r32) * 256 + h * 64 + hi * 8;
              const bf16_t* kp0 = KA + (size_t)(m0 + r32) * 256 + h * 64 + hi * 8; const bf16_t* kp1 = kp0 + (size_t)32 * 256;
#pragma unroll
              for (int s4 = 0; s4 < 4; ++s4) { qf[s4] = *(const bf16x8*)(qp + s4 * 16); kf[0][s4] = *(const bf16x8*)(kp0 + s4 * 16); kf[1][s4] = *(const bf16x8*)(kp1 + s4 * 16); } }
            const bf16_t* vtb = (const bf16_t*)(gb + G_VT) + (((size_t)gc * 4 + h) * 128 + r32) * 64 + 4 * hi;
            const bf16_t* stb = (const bf16_t*)(gb + G_SST) + (cu * 128 + r32) * 64 + hi * 8;
            s16x4 vlo[2][4], vhi[2][4]; bf16x8 sf[2][4];
#define GO_LOADV(b_, vq_) do { _Pragma("unroll") for (int s4 = 0; s4 < 4; ++s4) { vlo[b_][s4] = *(const s16x4*)(vtb + (size_t)(vq_) * 32 * 64 + s4 * 16); vhi[b_][s4] = *(const s16x4*)(vtb + (size_t)(vq_) * 32 * 64 + s4 * 16 + 8); sf[b_][s4] = *(const bf16x8*)(stb + (size_t)(vq_) * 32 * 64 + s4 * 16); } } while (0)
            GO_LOADV(0, 0);
            bf16x8 pf[4];
#pragma unroll
            for (int ib = 0; ib < 2; ++ib) {
                f32x16 p;
#pragma unroll
                for (int r = 0; r < 16; ++r) p[r] = 0.f;
#pragma unroll
                for (int s4 = 0; s4 < 4; ++s4) p = __builtin_amdgcn_mfma_f32_32x32x16_bf16(kf[ib][s4], qf[s4], p, 0, 0, 0);
                const int j = jb * 32 + r32;
#pragma unroll
                for (int r = 0; r < 16; ++r) { const int i = ib * 32 + crow16(r, hi); const bool keep = dir == 0 ? (i <= j) : (i >= j); if (!keep) p[r] = 0.f; }
#pragma unroll
                for (int s2 = 0; s2 < 2; ++s2) { union { bf16x8 v; unsigned u[4]; } a;
#pragma unroll
                    for (int q = 0; q < 4; ++q) a.u[q] = pk2(p[8 * s2 + 2 * q], p[8 * s2 + 2 * q + 1]);
                    pf[2 * ib + s2] = a.v; }
            }
#pragma unroll
            for (int vq = 0; vq < 4; ++vq) {
                if (vq < 3) GO_LOADV((vq + 1) & 1, vq + 1);
#pragma unroll
                for (int ks = 0; ks < 4; ++ks) { const bf16x8 vf = __builtin_shufflevector(vlo[vq & 1][ks], vhi[vq & 1][ks], 0, 1, 2, 3, 4, 5, 6, 7);
                    o[vq] = __builtin_amdgcn_mfma_f32_32x32x16_bf16(vf, pf[ks], o[vq], 0, 0, 0); }
#pragma unroll
                for (int s4 = 0; s4 < 4; ++s4) o[vq] = __builtin_amdgcn_mfma_f32_32x32x16_bf16(sf[vq & 1][s4], qf[s4], o[vq], 0, 0, 0);
            }
#undef GO_LOADV
        }
        float ss = 0.f;
#pragma unroll
        for (int vq = 0; vq < 4; ++vq)
#pragma unroll
            for (int r = 0; r < 16; ++r) ss += o[vq][r] * o[vq][r];
        ss = xsum32(ss);
        const float rs = rsqrtf(ss * (1.f / 128.f) + EPS);
#pragma unroll
        for (int vq = 0; vq < 4; ++vq)
#pragma unroll
            for (int q4 = 0; q4 < 4; ++q4) *(float4*)(sO + r32 * 132 + vq * 32 + 8 * q4 + 4 * hi) = make_float4(o[vq][4 * q4] * rs, o[vq][4 * q4 + 1] * rs, o[vq][4 * q4 + 2] * rs, o[vq][4 * q4 + 3] * rs);
        { const int j = lane >> 1, vc = (lane & 1) * 64; const float* row = sO + j * 132 + vc;
          const size_t off = (size_t)(m0 + jb * 32 + j) * 512 + h * 128 + vc;
          const bf16_t* BGp = c_BG + off; bf16_t* OBp = c_OB + off;
#pragma unroll
          for (int c8 = 0; c8 < 8; ++c8) {
              const float4 f0 = *(const float4*)(row + c8 * 8), f1 = *(const float4*)(row + c8 * 8 + 4);
              const uint4 gr = *(const uint4*)(BGp + c8 * 8); const float* og = ong + vc + c8 * 8;
              uint4 ow;
              ow.x = pk2(f0.x * og[0] * __uint_as_float(gr.x << 16), f0.y * og[1] * __uint_as_float(gr.x & 0xffff0000u));
              ow.y = pk2(f0.z * og[2] * __uint_as_float(gr.y << 16), f0.w * og[3] * __uint_as_float(gr.y & 0xffff0000u));
              ow.z = pk2(f1.x * og[4] * __uint_as_float(gr.z << 16), f1.y * og[5] * __uint_as_float(gr.z & 0xffff0000u));
              ow.w = pk2(f1.z * og[6] * __uint_as_float(gr.w << 16), f1.w * og[7] * __uint_as_float(gr.w & 0xffff0000u));
              *(uint4*)(OBp + c8 * 8) = ow; } }
    }
}

namespace pg8 {
#define PG8_LAS __attribute__((address_space(3)))
typedef unsigned short bf16_t;
typedef short bf16x8 __attribute__((ext_vector_type(8)));
typedef float f32x4 __attribute__((ext_vector_type(4)));
typedef unsigned u32x4 __attribute__((ext_vector_type(4)));
constexpr int BM = 256, BK = 64, HALF = 128, HTB = HALF * BK * 2  , STAGE_BYTES = 8 * HTB, NXCD = 8, WGM = 8;

__host__ __device__ __forceinline__ int lds_byte(int r, int c) { const int st = (r >> 4) * 2 + (c >> 5), rr = r & 15, cc = c & 31, ob = rr * 64 + cc * 2; return st * 1024 + (ob ^ (((ob >> 9) & 1) << 5)); }
__host__ __device__ __forceinline__ void stage_rc(int b, int& R, int& C) { const int st = b / 1024, sb = b % 1024, swz = sb ^ (((sb >> 9) & 1) << 5); R = (st >> 1) * 16 + swz / 64; C = (st & 1) * 32 + (swz % 64) / 2; }
__host__ __device__ __forceinline__ int perm32(int rho) { const int n = rho >> 4, i = rho & 15; return 8 * (i >> 2) + 4 * n + (i & 3); }

struct Unit { int pm, pn, z, h; };
struct Gemm { const bf16_t* A; const bf16_t* Bt; int M, N, K; size_t za, zb; int lda, ldb; };

struct StaticOrder {
    int nM, nN, nwg, G, c;
    __host__ __device__ void init(int M, int N, int G_, int c_) { nM = M / BM; nN = N / BM; nwg = nM * nN; G = G_; c = c_; }
    static constexpr bool HALF = false;
    __host__ __device__ void map(int L, Unit& u) const {
        int wgid = L; { const int q = nwg / NXCD, r = nwg % NXCD, xcd = wgid % NXCD, off = wgid / NXCD; wgid = (xcd < r ? xcd * (q + 1) : r * (q + 1) + (xcd - r) * q) + off; }
        const int nig = WGM * nN, gid = wgid / nig, fm = gid * WGM, gsz = (nM - fm) < WGM ? (nM - fm) : WGM;
        u.pm = fm + ((wgid % nig) % gsz); u.pn = (wgid % nig) / gsz; u.z = 0; u.h = 0;
    }
    __host__ __device__ bool next(int i, Unit& u) const {
        const long L = (long)i * G + c; if (L >= nwg) return false;
        map((int)L, u); return true;
    }
    __device__ __forceinline__ void a_ready(const Unit&) const {}
    __device__ __forceinline__ void done(const Unit&) const {}
};
__device__ __forceinline__ unsigned cvt_pk_bf16(float lo, float hi) { unsigned r; asm volatile("v_cvt_pk_bf16_f32 %0, %1, %2" : "=v"(r) : "v"(lo), "v"(hi)); return r; }
typedef float f32x2 __attribute__((ext_vector_type(2)));
template <class Epi, class Sched, bool ALIGN_EPI = false, bool SP2 = false>
__device__ __forceinline__ void gemm_phase(PG8_LAS unsigned char* lds, const Gemm g, const Sched& S, const Epi& E) {
    int tid_ = threadIdx.x; asm volatile("" : "+v"(tid_));
    const int tid = tid_, wid = __builtin_amdgcn_readfirstlane(tid >> 6), lane = tid & 63, wr = wid >> 2, wc = wid & 3, fr = lane & 15, fq = lane >> 4;
    const int K = g.K, nt = K / BK;
    unsigned voffA[2], voffB[2];
#pragma unroll
    for (int i = 0; i < 2; ++i) { int R, C; stage_rc(tid * 16 + i * 8192, R, C); const int Rb = Epi::PERM ? ((R & ~31) + perm32(R & 31)) : R;
        voffA[i] = (unsigned)(R * g.lda + C) * 2u; voffB[i] = (unsigned)(Rb * g.ldb + C) * 2u; }
    const size_t kstep = (size_t)(BK * 2);
    const size_t hstepA = (size_t)HALF * g.lda * 2, hstepB = (size_t)HALF * g.ldb * 2;
    const size_t tstepA = 2 * hstepA, tstepB = 2 * hstepB;
    const unsigned ldsw = (unsigned)wid * 1024u;
    const int aoff = lds_byte(wr * 64 + fr, fq * 8), boff = lds_byte(wc * 32 + fr, fq * 8);
#define PG8_SA(b, h) (((b) * 2 + (h)) * HTB)
#define PG8_SB(b, h) ((4 + (b) * 2 + (h)) * HTB)
#define PG8_STAGE(bufoff, gbase, voff) do { _Pragma("unroll") for (int _i = 0; _i < 2; ++_i) \
        __builtin_amdgcn_global_load_lds((const unsigned*)((const char*)(gbase) + (voff)[_i]), (PG8_LAS unsigned*)(lds + (bufoff) + ldsw + _i * 8192), 16, 0, 0); } while (0)
#define PG8_LDA(dst, b, h) do { _Pragma("unroll") for (int m = 0; m < 4; ++m) _Pragma("unroll") for (int k = 0; k < 2; ++k) dst[m][k] = *(const PG8_LAS bf16x8*)(lds + PG8_SA(b, h) + aoff + m * 2048 + k * 1024); } while (0)
#define PG8_LDB(dst, b, h) do { _Pragma("unroll") for (int n = 0; n < 2; ++n) _Pragma("unroll") for (int k = 0; k < 2; ++k) dst[n][k] = *(const PG8_LAS bf16x8*)(lds + PG8_SB(b, h) + boff + n * 2048 + k * 1024); } while (0)
#define PG8_MMA(ai, bj, At, Bt) do { __builtin_amdgcn_s_setprio(1); _Pragma("unroll") for (int m = 0; m < 4; ++m) _Pragma("unroll") for (int n = 0; n < 2; ++n) _Pragma("unroll") for (int k = 0; k < 2; ++k) \
        acc[ai][bj][m][n] = __builtin_amdgcn_mfma_f32_16x16x32_bf16(Bt[n][k], At[m][k], acc[ai][bj][m][n], 0, 0, 0); __builtin_amdgcn_s_setprio(0); } while (0)
#define PG8_WAIT_V(n) asm volatile("s_waitcnt vmcnt(" #n ")" ::: "memory")
#define PG8_WAIT_L(n) asm volatile("s_waitcnt lgkmcnt(" #n ")" ::: "memory")
#define PG8_BAR __builtin_amdgcn_s_barrier()
#define PG8_SCHED __builtin_amdgcn_sched_barrier(0)
    Unit cur, nxt; int ui = 0;
    if (!S.next(0, cur)) return;
    f32x4 acc[2][2][4][2];
#pragma unroll
    for (int a = 0; a < 2; ++a)
#pragma unroll
        for (int b = 0; b < 2; ++b)
#pragma unroll
            for (int m = 0; m < 4; ++m)
#pragma unroll
                for (int n = 0; n < 2; ++n) acc[a][b][m][n] = (f32x4){0.f, 0.f, 0.f, 0.f};
    bf16x8 At[4][2], B0[2][2], B1[2][2];
    const char* cA = (const char*)g.A + (size_t)cur.pm * tstepA + (size_t)cur.z * g.za; const char* cB = (const char*)g.Bt + (size_t)cur.pn * tstepB + (size_t)cur.z * g.zb;
    S.a_ready(cur);
    if constexpr (SP2) {
        PG8_STAGE(PG8_SB(0, 0), cB, voffB); PG8_STAGE(PG8_SB(0, 1), cB + hstepB, voffB); PG8_STAGE(PG8_SA(0, 0), cA, voffA); PG8_STAGE(PG8_SA(0, 1), cA + hstepA, voffA);
        if (wr == 1) PG8_BAR;
        PG8_WAIT_V(2); PG8_BAR;
        PG8_STAGE(PG8_SB(1, 0), cB + kstep, voffB); PG8_STAGE(PG8_SA(1, 0), cA + kstep, voffA); PG8_STAGE(PG8_SB(1, 1), cB + hstepB + kstep, voffB);
        PG8_WAIT_V(6); PG8_BAR;
    } else {
        PG8_STAGE(PG8_SB(0, 0), cB, voffB); PG8_STAGE(PG8_SA(0, 0), cA, voffA); PG8_STAGE(PG8_SB(0, 1), cB + hstepB, voffB); PG8_STAGE(PG8_SA(0, 1), cA + hstepA, voffA);
        if (wr == 1) PG8_BAR;
        PG8_WAIT_V(4); PG8_BAR;
        PG8_STAGE(PG8_SB(1, 0), cB + kstep, voffB); PG8_STAGE(PG8_SA(1, 0), cA + kstep, voffA); PG8_STAGE(PG8_SB(1, 1), cB + hstepB + kstep, voffB);
        PG8_WAIT_V(6); PG8_BAR;
    }
    for (;;) {
        const bool has_next = S.next(ui + 1, nxt);
        const char* nA = has_next ? (const char*)g.A + (size_t)nxt.pm * tstepA + (size_t)nxt.z * g.za : cA; const char* nB = has_next ? (const char*)g.Bt + (size_t)nxt.pn * tstepB + (size_t)nxt.z * g.zb : cB;
        for (int t = 0; t < nt; t += 2) {
            const bool last = (t == nt - 2);
            const char* a1 = cA + (size_t)(t + 1) * kstep;
            const char* a2 = last ? nA : cA + (size_t)(t + 2) * kstep; const char* b2 = last ? nB : cB + (size_t)(t + 2) * kstep;
            const char* a3 = a2 + kstep; const char* b3 = b2 + kstep;
            if (last && has_next) S.a_ready(nxt);
            if constexpr (SP2) {
            PG8_LDB(B0, 0, 0); PG8_LDB(B1, 0, 1); PG8_SCHED; PG8_LDA(At, 0, 0); PG8_STAGE(PG8_SA(1, 1), a1 + hstepA, voffA);
            PG8_WAIT_V(8); PG8_WAIT_L(0); PG8_BAR; if (!Sched::HALF || cur.h != 2) { PG8_MMA(0, 0, At, B0); PG8_MMA(0, 1, At, B1); } PG8_BAR; PG8_SCHED;
            PG8_LDA(At, 0, 1); PG8_STAGE(PG8_SB(0, 0), b2, voffB); PG8_STAGE(PG8_SB(0, 1), b2 + hstepB, voffB); PG8_STAGE(PG8_SA(0, 0), a2, voffA);
            PG8_WAIT_V(8); PG8_WAIT_L(0); PG8_BAR; if (!Sched::HALF || cur.h != 1) { PG8_MMA(1, 0, At, B0); PG8_MMA(1, 1, At, B1); } PG8_BAR; PG8_SCHED;
            PG8_LDB(B0, 1, 0); PG8_LDB(B1, 1, 1); PG8_SCHED; PG8_LDA(At, 1, 0); PG8_STAGE(PG8_SA(0, 1), a2 + hstepA, voffA);
            PG8_WAIT_V(8); PG8_WAIT_L(0); PG8_BAR; if (!Sched::HALF || cur.h != 2) { PG8_MMA(0, 0, At, B0); PG8_MMA(0, 1, At, B1); } PG8_BAR; PG8_SCHED;
            PG8_LDA(At, 1, 1); PG8_STAGE(PG8_SB(1, 0), b3, voffB); PG8_STAGE(PG8_SB(1, 1), b3 + hstepB, voffB); PG8_STAGE(PG8_SA(1, 0), a3, voffA);
            PG8_WAIT_V(8); PG8_WAIT_L(0); PG8_BAR; if (!Sched::HALF || cur.h != 1) { PG8_MMA(1, 0, At, B0); PG8_MMA(1, 1, At, B1); } PG8_BAR; PG8_SCHED;
            } else {
            PG8_LDB(B0, 0, 0); PG8_SCHED; PG8_LDA(At, 0, 0); PG8_STAGE(PG8_SA(1, 1), a1 + hstepA, voffA);
            PG8_WAIT_L(8); PG8_BAR; PG8_WAIT_L(0); PG8_MMA(0, 0, At, B0); PG8_BAR; PG8_SCHED;
            PG8_LDB(B1, 0, 1); PG8_STAGE(PG8_SB(0, 0), b2, voffB);
            PG8_BAR; PG8_WAIT_L(0); PG8_MMA(0, 1, At, B1); PG8_BAR;
            PG8_LDA(At, 0, 1); PG8_STAGE(PG8_SA(0, 0), a2, voffA);
            PG8_BAR; PG8_WAIT_L(0); PG8_MMA(1, 0, At, B0); PG8_BAR; PG8_SCHED;
            PG8_STAGE(PG8_SB(0, 1), b2 + hstepB, voffB);
            PG8_WAIT_V(6); PG8_BAR; PG8_MMA(1, 1, At, B1); PG8_BAR;
            PG8_LDB(B0, 1, 0); PG8_SCHED; PG8_LDA(At, 1, 0); PG8_STAGE(PG8_SA(0, 1), a2 + hstepA, voffA);
            PG8_WAIT_L(8); PG8_BAR; PG8_WAIT_L(0); PG8_MMA(0, 0, At, B0); PG8_BAR; PG8_SCHED;
            PG8_LDB(B1, 1, 1); PG8_STAGE(PG8_SB(1, 0), b3, voffB);
            PG8_BAR; PG8_WAIT_L(0); PG8_MMA(0, 1, At, B1); PG8_BAR;
            PG8_LDA(At, 1, 1); PG8_STAGE(PG8_SA(1, 0), a3, voffA);
            PG8_BAR; PG8_WAIT_L(0); PG8_MMA(1, 0, At, B0); PG8_BAR; PG8_SCHED;
            PG8_STAGE(PG8_SB(1, 1), b3 + hstepB, voffB);
            PG8_WAIT_V(6); PG8_BAR; PG8_MMA(1, 1, At, B1); PG8_BAR;
            }
        }
        if constexpr (ALIGN_EPI) { if (wr == 0) PG8_BAR; }
        if constexpr (!Epi::AFTER_DRAIN) { E(acc, cur, wr, wc, fr, fq); S.done(cur); }
        if (!has_next) break;
#pragma unroll
        for (int a = 0; a < 2; ++a)
#pragma unroll
            for (int b = 0; b < 2; ++b)
#pragma unroll
                for (int m = 0; m < 4; ++m)
#pragma unroll
                    for (int n = 0; n < 2; ++n) acc[a][b][m][n] = (f32x4){0.f, 0.f, 0.f, 0.f};
        cur = nxt; cA = nA; cB = nB; ++ui;
        if constexpr (ALIGN_EPI) { if (wr == 1) PG8_BAR; }
    }
    PG8_WAIT_V(0);
    if constexpr (!ALIGN_EPI) { if (wr == 0) PG8_BAR; }
    PG8_BAR;
    if constexpr (Epi::AFTER_DRAIN) { E.fused(acc, cur, wr, wc, fr, fq, lds, wid, lane); S.done(cur); }
#undef PG8_SA
#undef PG8_SB
#undef PG8_STAGE
#undef PG8_LDA
#undef PG8_LDB
#undef PG8_MMA
#undef PG8_WAIT_V
#undef PG8_WAIT_L
#undef PG8_BAR
#undef PG8_SCHED
}
}

__device__ __forceinline__ void wconv_item(const float* W, int ld, int col0, int k0, bf16_t* WT, int K, int drow0, LAS float* scr, int lane) {
    if (W == nullptr) {
#pragma unroll
        for (int j = 0; j < 4; ++j) { const int n = (lane >> 3) + 8 * j; *(uint4*)(WT + (size_t)(drow0 + n) * K + k0 + 8 * (lane & 7)) = make_uint4(0u, 0u, 0u, 0u); }
        return;
    }
    float wv[32];
#pragma unroll
    for (int i = 0; i < 32; ++i) { const int kk = 2 * i + (lane >> 5); wv[i] = W[(size_t)(k0 + kk) * ld + col0 + (lane & 31)]; }
#pragma unroll
    for (int i = 0; i < 32; ++i) { const int kk = 2 * i + (lane >> 5); scr[kk * 33 + (lane & 31)] = wv[i]; }
    asm volatile("s_waitcnt lgkmcnt(0)" ::: "memory");
    const int c = lane & 7;
#pragma unroll
    for (int j = 0; j < 4; ++j) { const int n = (lane >> 3) + 8 * j; const LAS float* s = scr + (8 * c) * 33 + n;
        uint4 o; o.x = pk2(s[0 * 33], s[1 * 33]); o.y = pk2(s[2 * 33], s[3 * 33]); o.z = pk2(s[4 * 33], s[5 * 33]); o.w = pk2(s[6 * 33], s[7 * 33]);
        *(uint4*)(WT + (size_t)(drow0 + n) * K + k0 + 8 * c) = o; }
    asm volatile("s_waitcnt lgkmcnt(0)" ::: "memory");
}
__device__ __forceinline__ void ph_wconv(const Ctx& C0) {
    PHASE_CTX(C0);
    LAS float* scr = (LAS float*)((LAS unsigned char*)C.lds + C.wave * 16384);
    const int lane = C.lane;
    __syncthreads();
    constexpr int I_WI = 120 * 16, I_WZ = 96 * 16, I_WG = 32 * 8, I_WR = 96 * 8, I_WO = 32 * 16, I_WU = 176 * 16, I_WD = 32 * 44;
    constexpr int I_LAYER = I_WI + I_WZ + I_WG + I_WR + I_WO + I_WU + I_WD;
    for (int it = C.bid * NWAVE + C.wave; it < 2 * I_LAYER; it += C.G * NWAVE) {
        const int l = it / I_LAYER; int r = it % I_LAYER;
        unsigned char* wb = WS_ + W_WB + (size_t)l * WB_LAYER;
        if (r < I_WI) { const int rb = r >> 4, kb = r & 15, pn = rb >> 3, tb = rb & 7; int col = -1;
            if (pn < 4) col = 256 * pn + 64 * (tb & 3) + 32 * (tb >> 2);
            else if (pn < 6) col = C_AV + 256 * (pn - 4) + 32 * tb;
            else if (pn == 6) col = C_BQ + 32 * tb; else if (pn == 7) col = C_BK + 32 * tb;
            else if (pn < 10) col = C_BV + 256 * (pn - 8) + 32 * tb; else if (pn < 12) col = C_BG + 256 * (pn - 10) + 32 * tb;
            else if (pn < 14) col = C_CU + 256 * (pn - 12) + 32 * tb; else if (tb == 0) col = C_BR;
            wconv_item(col < 0 ? nullptr : c_w_in + (size_t)l * 1024 * IN_DIM, IN_DIM, col, kb * 64, (bf16_t*)(wb + WB_WI), 1024, rb * 32, scr, lane); continue; }
        r -= I_WI;
        if (r < I_WZ) { const int rb = r >> 4, kb = r & 15; wconv_item(c_w_in + (size_t)l * 1024 * IN_DIM, IN_DIM, C_GZ + 32 * rb, kb * 64, (bf16_t*)(wb + WB_WZ), 1024, rb * 32, scr, lane); continue; }
        r -= I_WZ;
        if (r < I_WG) { const int rb = r >> 3, kb = r & 7, pn = rb >> 3, tb = rb & 7; wconv_item(c_s5_w_glu + (size_t)l * 512 * 1024, 1024, 512 * (tb >> 2) + 128 * pn + 32 * (tb & 3), kb * 64, (bf16_t*)(wb + WB_WG), 512, rb * 32, scr, lane); continue; }
        r -= I_WG;
        if (r < I_WR) { const int rb = r >> 3, kb = r & 7, br = rb >> 5, rbb = rb & 31; wconv_item(c_w_branch + ((size_t)l * 3 + br) * 512 * 1024, 1024, 32 * rbb, kb * 64, (bf16_t*)(wb + WB_WR), 512, rb * 32, scr, lane); continue; }
        r -= I_WR;
        if (r < I_WO) { const int rb = r >> 4, kb = r & 15; wconv_item(c_w_out + (size_t)l * 1024 * 1024, 1024, 32 * rb, kb * 64, (bf16_t*)(wb + WB_WO), 1024, rb * 32, scr, lane); continue; }
        r -= I_WO;
        if (r < I_WU) { const int rb = r >> 4, kb = r & 15, pn = rb >> 3, tb = rb & 7; const float* src = (tb >> 2) ? c_w_up : c_w_gate;
            wconv_item(src + (size_t)l * 1024 * FFN, FFN, 128 * pn + 32 * (tb & 3), kb * 64, (bf16_t*)(wb + WB_WU), 1024, rb * 32, scr, lane); continue; }
        r -= I_WU;
        { const int rb = r / 44, kb = r % 44; wconv_item(c_w_down + (size_t)l * FFN * 1024, 1024, 32 * rb, kb * 64, (bf16_t*)(wb + WB_WD), FFN, rb * 32, scr, lane); }
    }
}

__device__ __forceinline__ uint4 pack8(const f32x4& a, const f32x4& b) { uint4 w; w.x = pk2(a[0], a[1]); w.y = pk2(a[2], a[3]); w.z = pk2(b[0], b[1]); w.w = pk2(b[2], b[3]); return w; }
struct EpiIn {
    static constexpr bool PERM = true, AFTER_DRAIN = false;
    unsigned char* ws_; float* out_; const float* qg; const float* kg; int l; int pad_;
    __device__ __forceinline__ void operator()(const f32x4 (&acc)[2][2][4][2], const pg8::Unit& u, int wr, int wc, int fr_, int fq_) const {
        int fr = fr_, fq = fq_; asm volatile("" : "+v"(fr), "+v"(fq));
        KArgPtr Pk = kargs(); unsigned char* ws = Pk->ws; float* out = Pk->out;
        const int pn = u.pn, rowb = u.pm * 256 + wr * 64 + fr;
        if (pn < 4) {
            const bool isk = pn >= 2; const float* g = isk ? kg : qg;
            const bool latent = u.pm >= 32;
            const float* cosT = (const float*)(ws + W_MISC) + 64; const float* sinT = cosT + 1024;
            bf16_t* dstb = isk ? (bf16_t*)(ws + W_AK) : (bf16_t*)(ws + W_AQ);
            const int colb = (pn & 1) * 256 + 64 * wc + 8 * fq;
#pragma unroll
            for (int ai = 0; ai < 2; ++ai)
#pragma unroll
                for (int m = 0; m < 4; ++m) {
                    const int row = rowb + ai * 128 + m * 16;
                    f32x4 v[2][2]; float ss = 0.f;
#pragma unroll
                    for (int bj = 0; bj < 2; ++bj)
#pragma unroll
                        for (int n = 0; n < 2; ++n) { v[bj][n] = acc[ai][bj][m][n]; ss += v[bj][n][0] * v[bj][n][0] + v[bj][n][1] * v[bj][n][1] + v[bj][n][2] * v[bj][n][2] + v[bj][n][3] * v[bj][n][3]; }
                    ss += shx(ss, 16, fq * 16 + fr); ss = xsum32(ss);
                    const float rs = rsqrtf(ss * (1.f / 64.f) + EPS);
                    { const float* gp = (isk ? Pk->in[14] : Pk->in[13]) + l * 64 + launder_s(0);
#pragma unroll
                      for (int bj = 0; bj < 2; ++bj)
#pragma unroll
                        for (int n = 0; n < 2; ++n) v[bj][n] = v[bj][n] * rs * *(const f32x4*)(gp + 32 * bj + 8 * fq + 4 * n); }
                    if (isk && !latent) {
                        float* o = out + O_NK + ((size_t)((row >> 8) * 2 + l) * 256 + (row & 255)) * 512 + colb;
#pragma unroll
                        for (int bj = 0; bj < 2; ++bj) { *(f32x4*)(o + 32 * bj) = v[bj][0]; *(f32x4*)(o + 32 * bj + 4) = v[bj][1]; }
                    }
                    if (latent) {
                        const int t = (row - NPROMPT) & 2047;
#pragma unroll
                        for (int bj = 0; bj < 2; ++bj) {
                            const int pos = bj ? (t & 63) : (t >> 6);
#pragma unroll
                            for (int n = 0; n < 2; ++n) {
                                const f32x4 cc = *(const f32x4*)(cosT + pos * 16 + 8 * (fq & 1) + 4 * n), sn = *(const f32x4*)(sinT + pos * 16 + 8 * (fq & 1) + 4 * n);
                                f32x4 ot;
#pragma unroll
                                for (int e = 0; e < 4; ++e) ot[e] = shx(v[bj][n][e], 32, fq * 16 + fr);
                                v[bj][n] = (fq & 2) ? (v[bj][n] * cc + ot * sn) : (v[bj][n] * cc - ot * sn);
                            }
                        }
                    }
                    bf16_t* d = dstb + (size_t)(isk ? krow_of(row) : row) * 512 + colb;
#pragma unroll
                    for (int bj = 0; bj < 2; ++bj) *(uint4*)(d + 32 * bj) = pack8(v[bj][0], v[bj][1]);
                }
            return;
        }
        const int cb = 32 * wc + 8 * fq;
        if (pn < 6) {
            bf16_t* AV = (bf16_t*)(ws + W_AV);
#pragma unroll
            for (int ai = 0; ai < 2; ++ai)
#pragma unroll
                for (int m = 0; m < 4; ++m) { const int row = rowb + ai * 128 + m * 16;
#pragma unroll
                    for (int bj = 0; bj < 2; ++bj) { const int col = (pn - 4) * 256 + 128 * bj + cb;
                        *(uint4*)(AV + (size_t)krow_of(row) * 512 + col) = pack8(acc[ai][bj][m][0], acc[ai][bj][m][1]);
                        if (row < NPROMPT) { float* o = out + O_NV + ((size_t)((row >> 8) * 2 + l) * 256 + (row & 255)) * 512 + col; *(f32x4*)o = acc[ai][bj][m][0]; *(f32x4*)(o + 4) = acc[ai][bj][m][1]; } } }
            return;
        }
        if (pn == 14) {
            if (wc == 0) { float* BR = (float*)(ws + W_BR);
#pragma unroll
                for (int ai = 0; ai < 2; ++ai)
#pragma unroll
                    for (int m = 0; m < 4; ++m) { const int row = rowb + ai * 128 + m * 16; *(f32x4*)(BR + (size_t)row * 32 + 8 * fq) = acc[ai][0][m][0]; *(f32x4*)(BR + (size_t)row * 32 + 8 * fq + 4) = acc[ai][0][m][1]; } }
            return;
        }
        bf16_t* dst; int ldd, c0; int mode = 0;
        if (pn == 6) { dst = (bf16_t*)(ws + W_BQ); ldd = 256; c0 = 0; mode = 1; }
        else if (pn == 7) { dst = (bf16_t*)(ws + W_BK); ldd = 256; c0 = 0; }
        else if (pn < 10) { dst = (bf16_t*)(ws + W_BV); ldd = 512; c0 = (pn - 8) * 256; }
        else if (pn < 12) { dst = (bf16_t*)(ws + W_BG); ldd = 512; c0 = (pn - 10) * 256; mode = 2; }
        else {
            bf16_t* UH = (bf16_t*)(ws + W_UH);
#pragma unroll
            for (int ai = 0; ai < 2; ++ai)
#pragma unroll
                for (int m = 0; m < 4; ++m) { const int row = rowb + ai * 128 + m * 16;
#pragma unroll
                    for (int bj = 0; bj < 2; ++bj) { const int col = (pn - 12) * 256 + 128 * bj + cb, g = col >> 4, ch0 = col & 15;
                        *(uint4*)(UH + ((size_t)g * 512 + (row >> 5)) * 768 + (row & 31) * 16 + ch0) = pack8(acc[ai][bj][m][0], acc[ai][bj][m][1]); } }
            return;
        }
#pragma unroll
        for (int ai = 0; ai < 2; ++ai)
#pragma unroll
            for (int m = 0; m < 4; ++m) { const int row = rowb + ai * 128 + m * 16;
#pragma unroll
                for (int bj = 0; bj < 2; ++bj) { f32x4 a = acc[ai][bj][m][0], b = acc[ai][bj][m][1];
                    if (mode == 1) { a = a * 0.125f; b = b * 0.125f; }
                    if (mode == 2) {
#pragma unroll
                        for (int e = 0; e < 4; ++e) { a[e] = siluf_(a[e]); b[e] = siluf_(b[e]); } }
                    *(uint4*)(dst + (size_t)row * ldd + c0 + 128 * bj + cb) = pack8(a, b); } }
    }
};
struct EpiGate {
    static constexpr bool PERM = true, AFTER_DRAIN = false;
    bf16_t* G;
    __device__ __forceinline__ void operator()(const f32x4 (&acc)[2][2][4][2], const pg8::Unit& u, int wr, int wc, int fr_, int fq_) const {
        int fr = fr_, fq = fq_; asm volatile("" : "+v"(fr), "+v"(fq));
        const int rowb = u.pm * 256 + wr * 64 + fr, cb = u.pn * 256 + 32 * wc + 8 * fq;
#pragma unroll
        for (int ai = 0; ai < 2; ++ai)
#pragma unroll
            for (int m = 0; m < 4; ++m) { const int row = rowb + ai * 128 + m * 16;
#pragma unroll
                for (int bj = 0; bj < 2; ++bj) { f32x4 a = acc[ai][bj][m][0], b = acc[ai][bj][m][1];
#pragma unroll
                    for (int e = 0; e < 4; ++e) { a[e] = sigmoidf_(a[e]); b[e] = sigmoidf_(b[e]); }
                    *(uint4*)(G + (size_t)row * 3072 + cb + 128 * bj) = pack8(a, b); } }
    }
};
struct EpiGlu {
    static constexpr bool PERM = true, AFTER_DRAIN = false;
    bf16_t* OC; const float* bias;
    __device__ __forceinline__ void operator()(const f32x4 (&acc)[2][2][4][2], const pg8::Unit& u, int wr, int wc, int fr_, int fq_) const {
        int fr = fr_, fq = fq_; asm volatile("" : "+v"(fr), "+v"(fq));
        const int rowb = u.pm * 256 + wr * 64 + fr, col = u.pn * 128 + 32 * wc + 8 * fq;
        const f32x4 ba0 = *(const f32x4*)(bias + col), ba1 = *(const f32x4*)(bias + col + 4), bb0 = *(const f32x4*)(bias + 512 + col), bb1 = *(const f32x4*)(bias + 512 + col + 4);
#pragma unroll
        for (int ai = 0; ai < 2; ++ai)
#pragma unroll
            for (int m = 0; m < 4; ++m) { const int row = rowb + ai * 128 + m * 16;
                f32x4 a0 = acc[ai][0][m][0] + ba0, a1 = acc[ai][0][m][1] + ba1, b0 = acc[ai][1][m][0] + bb0, b1 = acc[ai][1][m][1] + bb1;
#pragma unroll
                for (int e = 0; e < 4; ++e) { a0[e] *= sigmoidf_(b0[e]); a1[e] *= sigmoidf_(b1[e]); }
                *(uint4*)(OC + (size_t)row * 512 + col) = pack8(a0, a1); }
    }
};
struct EpiBranch {
    static constexpr bool PERM = true, AFTER_DRAIN = false;
    const bf16_t* G; bf16_t* MG;
    __device__ __forceinline__ void operator()(const f32x4 (&acc)[2][2][4][2], const pg8::Unit& u, int wr, int wc, int fr_, int fq_) const {
        int fr = fr_, fq = fq_; asm volatile("" : "+v"(fr), "+v"(fq));
        const int rowb = u.pm * 256 + wr * 64 + fr, cb = u.pn * 256 + 32 * wc + 8 * fq, r = u.z;
#pragma unroll
        for (int ai = 0; ai < 2; ++ai)
#pragma unroll
            for (int m = 0; m < 4; ++m) { const int row = rowb + ai * 128 + m * 16;
#pragma unroll
                for (int bj = 0; bj < 2; ++bj) { const int col = cb + 128 * bj;
                    const uint4 gr = *(const uint4*)(G + (size_t)row * 3072 + r * 1024 + col);
                    f32x4 g0, g1;
                    g0[0] = __uint_as_float(gr.x << 16); g0[1] = __uint_as_float(gr.x & 0xffff0000u); g0[2] = __uint_as_float(gr.y << 16); g0[3] = __uint_as_float(gr.y & 0xffff0000u);
                    g1[0] = __uint_as_float(gr.z << 16); g1[1] = __uint_as_float(gr.z & 0xffff0000u); g1[2] = __uint_as_float(gr.w << 16); g1[3] = __uint_as_float(gr.w & 0xffff0000u);
                    f32x4 a = acc[ai][bj][m][0] * g0, b = acc[ai][bj][m][1] * g1;
                    bf16_t* mp = MG + (size_t)row * 1024 + col;
                    if (r > 0) { const uint4 pr = *(const uint4*)mp;
                        a[0] += __uint_as_float(pr.x << 16); a[1] += __uint_as_float(pr.x & 0xffff0000u); a[2] += __uint_as_float(pr.y << 16); a[3] += __uint_as_float(pr.y & 0xffff0000u);
                        b[0] += __uint_as_float(pr.z << 16); b[1] += __uint_as_float(pr.z & 0xffff0000u); b[2] += __uint_as_float(pr.w << 16); b[3] += __uint_as_float(pr.w & 0xffff0000u); }
                    *(uint4*)mp = pack8(a, b); } }
    }
};
struct EpiRes {
    static constexpr bool PERM = true, AFTER_DRAIN = false;
    const void* x0; const void* x1; void* o0; void* o1; const float* MODg; int in_bf16, out_bf16;
    __device__ __forceinline__ void operator()(const f32x4 (&acc)[2][2][4][2], const pg8::Unit& u, int wr, int wc, int fr_, int fq_) const {
        int fr = fr_, fq = fq_; asm volatile("" : "+v"(fr), "+v"(fq));
        const int rowb = u.pm * 256 + wr * 64 + fr, cb = u.pn * 256 + 32 * wc + 8 * fq;
        const float* mg = MODg + (size_t)cond_row(u.pm * 256) * 6144;
        const bool ctx = u.pm < NPROMPT / 256;
        const void* xi0 = ctx ? x0 : x1; void* xo0 = ctx ? o0 : o1;
#pragma unroll
        for (int bj = 0; bj < 2; ++bj) { const int col = cb + 128 * bj;
            const f32x4 m0 = *(const f32x4*)(mg + col), m1 = *(const f32x4*)(mg + col + 4);
#pragma unroll
            for (int ai = 0; ai < 2; ++ai)
#pragma unroll
                for (int m = 0; m < 4; ++m) { const int row = rowb + ai * 128 + m * 16;
                    const size_t off = (size_t)(ctx ? row : row - NPROMPT) * D + col;
                    f32x4 a, b;
                    if (in_bf16) { const uint4 w = *(const uint4*)((const bf16_t*)xi0 + off);
                        a[0] = __uint_as_float(w.x << 16); a[1] = __uint_as_float(w.x & 0xffff0000u); a[2] = __uint_as_float(w.y << 16); a[3] = __uint_as_float(w.y & 0xffff0000u);
                        b[0] = __uint_as_float(w.z << 16); b[1] = __uint_as_float(w.z & 0xffff0000u); b[2] = __uint_as_float(w.w << 16); b[3] = __uint_as_float(w.w & 0xffff0000u); }
                    else { a = *(const f32x4*)((const float*)xi0 + off); b = *(const f32x4*)((const float*)xi0 + off + 4); }
                    a += m0 * acc[ai][bj][m][0]; b += m1 * acc[ai][bj][m][1];
                    if (out_bf16) *(uint4*)((bf16_t*)xo0 + off) = pack8(a, b);
                    else { *(f32x4*)((float*)xo0 + off) = a; *(f32x4*)((float*)xo0 + off + 4) = b; } } }
    }
};
struct EpiFfn {
    static constexpr bool PERM = true, AFTER_DRAIN = false;
    bf16_t* H;
    __device__ __forceinline__ void operator()(const f32x4 (&acc)[2][2][4][2], const pg8::Unit& u, int wr, int wc, int fr_, int fq_) const {
        int fr = fr_, fq = fq_; asm volatile("" : "+v"(fr), "+v"(fq));
        const int rowb = u.pm * 256 + wr * 64 + fr, col = u.pn * 128 + 32 * wc + 8 * fq;
#pragma unroll
        for (int ai = 0; ai < 2; ++ai) {
            if (u.h != 0 && u.h != ai + 1) continue;
#pragma unroll
            for (int m = 0; m < 4; ++m) { const int row = rowb + ai * 128 + m * 16;
                f32x4 a0 = acc[ai][0][m][0], a1 = acc[ai][0][m][1];
#pragma unroll
                for (int e = 0; e < 4; ++e) { a0[e] = siluf_(a0[e]) * acc[ai][1][m][0][e]; a1[e] = siluf_(a1[e]) * acc[ai][1][m][1][e]; }
                *(uint4*)(H + (size_t)row * FFN + col) = pack8(a0, a1); } }
    }
};
struct FfnOrder {
    pg8::StaticOrder S;
    static constexpr bool HALF = true;
    __device__ bool next(int i, pg8::Unit& u) const {
        if (S.G != 256 || S.nwg != 1408) return S.next(i, u);
        if (i < 5) { S.map(i * 256 + S.c, u); return true; }
        if (i > 5) return false;
        S.map(1280 + ((S.c >> 4) << 3) + (S.c & 7), u); u.h = 1 + ((S.c >> 3) & 1); return true;
    }
    __device__ __forceinline__ void a_ready(const pg8::Unit&) const {}
    __device__ __forceinline__ void done(const pg8::Unit&) const {}
};
struct BranchOrder {
    pg8::StaticOrder S;
    static constexpr bool HALF = false;
    __device__ bool next(int i, pg8::Unit& u) const { if (i >= 3) return false; if (!S.next(0, u)) return false; u.z = i; return true; }
    __device__ __forceinline__ void a_ready(const pg8::Unit&) const {}
    __device__ __forceinline__ void done(const pg8::Unit&) const {}
};
constexpr int S5T = 32;
constexpr size_t TE_BYTES = 256 * 512 * 2, TC_BYTES = 512 * 768 * 2, TAB_TE = 0, TAB_TC = 32 * TE_BYTES;
__device__ __forceinline__ unsigned char* s5_tab(unsigned char* ws, int l) { return ws + (l == 0 ? W_TAB0 : W_TAB1); }
template <int MODE>
__device__ __forceinline__ void ph_s5_tables(const Ctx& C0) {
    PHASE_CTX(C0);
    float* sApr = (float*)C.lds;
    float* sApi = sApr + 2 * 33 * 64;
    float* sBr = sApi + 2 * 33 * 64;
    float* sBi = sBr + 2 * 64 * 16;
    float* sCr = sBi + 2 * 64 * 16;
    float* sCi = sCr + 2 * 16 * 64;
    float* sK = sCi + 2 * 16 * 64;
    float* sD = sK + 2 * 32 * 260;
    const int tid = C.tid;
    for (int item0 = (MODE == 0 ? C.G - 1 - C.bid : C.bid); item0 < (MODE == 0 ? 64 : 256); item0 += C.G) {
        const int item = MODE == 0 ? item0 * 4 : item0;
        const int l = item >> 7, g = (item >> 2) & 31, sub = item & 3;
        __syncthreads();
        constexpr int AUXF = 2 * 2 * 33 * 64 + 2 * 2 * 64 * 16 + 2 * 2 * 16 * 64;
        float* aux = WSP(float, W_KAUX) + ((size_t)l * 32 + g) * (AUXF + 16);
        if (MODE == 1) {
            f32x4 av[9];
#pragma unroll
            for (int q = 0; q < 9; ++q) { const int i = tid + q * NT; av[q] = i < AUXF / 4 ? ((const f32x4*)aux)[i] : (f32x4){0.f, 0.f, 0.f, 0.f}; }
            const float dv = tid < 16 ? aux[AUXF + tid] : 0.f;
#pragma unroll
            for (int q = 0; q < 9; ++q) { const int i = tid + q * NT; if (i < AUXF / 4) ((f32x4*)sApr)[i] = av[q]; }
            if (tid < 16) sD[tid] = dv;
        }
        if (MODE == 0) {
        if (tid >= 128 && tid < 256) {
            const int dir = (tid - 128) >> 6, p = tid & 63; const size_t ld = (size_t)l * 2 + dir;
            const float lr = c_s5_lam_re[(ld * 32 + g) * 64 + p], li = c_s5_lam_im[(ld * 32 + g) * 64 + p], dt = expf(c_s5_log_dt[ld * 32 + g]);
            const float mag = expf(lr * dt); float sn, cs; sincosf(li * dt, &sn, &cs);
            const float ar = mag * cs, ai = mag * sn; float xr = 1.f, xi = 0.f;
#pragma unroll 1
            for (int t = 0; t <= 32; ++t) { sApr[(dir * 33 + t) * 64 + p] = xr; sApi[(dir * 33 + t) * 64 + p] = xi; const float nr = xr * ar - xi * ai, ni = xr * ai + xi * ar; xr = nr; xi = ni; }
        }
        if (tid < 128) {
            const int dir = tid >> 6, p = tid & 63; const size_t ld = (size_t)l * 2 + dir;
            const float lr = c_s5_lam_re[(ld * 32 + g) * 64 + p], li = c_s5_lam_im[(ld * 32 + g) * 64 + p], dt = expf(c_s5_log_dt[ld * 32 + g]);
            const float mag = expf(lr * dt); const float ar = mag * cosf(li * dt), ai = mag * sinf(li * dt), den = lr * lr + li * li;
            const float fr = ((ar - 1.f) * lr + ai * li) / den, fi = (ai * lr - (ar - 1.f) * li) / den;
            for (int c = 0; c < 16; ++c) { const float br_ = c_s5_b_re[((ld * 32 + g) * 64 + p) * 16 + c], bi_ = c_s5_b_im[((ld * 32 + g) * 64 + p) * 16 + c];
                sBr[(dir * 64 + p) * 16 + c] = fr * br_ - fi * bi_; sBi[(dir * 64 + p) * 16 + c] = fr * bi_ + fi * br_; }
            for (int o = 0; o < 16; ++o) { sCr[(dir * 16 + o) * 64 + p] = c_s5_c_re[((ld * 32 + g) * 16 + o) * 64 + p]; sCi[(dir * 16 + o) * 64 + p] = c_s5_c_im[((ld * 32 + g) * 16 + o) * 64 + p]; }
        }
        if (tid >= 128 && tid < 144) sD[tid - 128] = c_s5_d[(size_t)l * 512 + g * 16 + (tid - 128)];
        }
        __syncthreads();
        if (MODE == 0) {
            for (int i = tid; i < AUXF / 4; i += NT) ((f32x4*)aux)[i] = ((const f32x4*)sApr)[i];
            if (tid < 16) aux[AUXF + tid] = sD[tid];
        }
        if (tid < 128 && MODE == 0) {
            const int dir = tid >> 6, p = tid & 63; float* at = WSP(float, W_ATAB) + ((((size_t)l * 32 + g) * 2 + dir) * 64 + p) * 2;
            at[0] = sApr[(dir * 33 + 32) * 64 + p]; at[1] = sApi[(dir * 33 + 32) * 64 + p];
        }
        float* Kg = WSP(float, W_KG) + ((size_t)l * 32 + g) * 16384;
        if (MODE == 1) { f32x4 kv[8];
#pragma unroll
            for (int q = 0; q < 8; ++q) kv[q] = ((const f32x4*)Kg)[tid + q * NT];
#pragma unroll
            for (int q = 0; q < 8; ++q) { const int i = tid + q * NT; ((f32x4*)sK)[(i >> 6) * 65 + (i & 63)] = kv[q]; } }
        if (MODE == 0) {
            const int dir = tid >> 8, tau0 = (tid >> 4) & 15, o = tid & 15;
            float acc0[16], acc1[16];
#pragma unroll
            for (int c = 0; c < 16; ++c) { acc0[c] = 0.f; acc1[c] = 0.f; }
#pragma unroll 2
            for (int p = 0; p < 64; ++p) {
                const float cr = sCr[(dir * 16 + o) * 64 + p], ci = sCi[(dir * 16 + o) * 64 + p];
                const float ar0 = sApr[(dir * 33 + tau0) * 64 + p], ai0 = sApi[(dir * 33 + tau0) * 64 + p], ar1 = sApr[(dir * 33 + tau0 + 16) * 64 + p], ai1 = sApi[(dir * 33 + tau0 + 16) * 64 + p];
                const float wr0 = cr * ar0 - ci * ai0, wi0 = cr * ai0 + ci * ar0, wr1 = cr * ar1 - ci * ai1, wi1 = cr * ai1 + ci * ar1;
#pragma unroll
                for (int c = 0; c < 16; ++c) { const float br_ = sBr[(dir * 64 + p) * 16 + c], bi_ = sBi[(dir * 64 + p) * 16 + c];
                    acc0[c] += wr0 * br_ - wi0 * bi_; acc1[c] += wr1 * br_ - wi1 * bi_; }
            }
#pragma unroll
            for (int c = 0; c < 16; ++c) { Kg[((dir * 32 + tau0) * 16 + o) * 16 + c] = acc0[c]; Kg[((dir * 32 + tau0 + 16) * 16 + o) * 16 + c] = acc1[c]; }
        }
        if (MODE == 0) continue;
        __syncthreads();
        unsigned char* tab = s5_tab(WS_, l);
        bf16_t* TC = (bf16_t*)(tab + TAB_TC + (size_t)g * TC_BYTES);
        bf16_t* TE = (bf16_t*)(tab + TAB_TE + (size_t)g * TE_BYTES);
        for (int ch = tid; ch < 128 * 64; ch += NT) {
            const int n = sub * 128 + (ch >> 6), kc = ch & 63, j = n >> 4, o = n & 15, i = kc >> 1, c0 = (kc & 1) * 8;
            const float* src = sK + (i <= j ? j - i : 32 + i - j) * 260 + o * 16 + c0;
            f32x4 a = *(const f32x4*)src, b = *(const f32x4*)(src + 4);
            if (i == j) { const float* s1 = sK + 32 * 260 + o * 16 + c0; a += *(const f32x4*)s1; b += *(const f32x4*)(s1 + 4); const float dv = sD[o];
#pragma unroll
                for (int e = 0; e < 4; ++e) { a[e] += (o == c0 + e) ? dv : 0.f; b[e] += (o == c0 + 4 + e) ? dv : 0.f; } }
            *(uint4*)(TC + (size_t)n * 768 + kc * 8) = pack8(a, b);
        }
        for (int ch = tid; ch < 128 * 32; ch += NT) {
            const int n = sub * 128 + (ch >> 5), kq = ch & 31, j = n >> 4, o = n & 15;
            const int kk = kq * 8, dir = kk >> 7, ri = (kk >> 6) & 1, p0 = kk & 63; const int tau = dir == 0 ? j + 1 : S5T - j;
            const float* pc = sCr + (dir * 16 + o) * 64 + p0; const float* pa = sApr + (dir * 33 + tau) * 64 + p0;
            const f32x4 cr0 = *(const f32x4*)pc, cr1 = *(const f32x4*)(pc + 4), ci0 = *(const f32x4*)(pc + 2 * 16 * 64), ci1 = *(const f32x4*)(pc + 2 * 16 * 64 + 4);
            const f32x4 ar0 = *(const f32x4*)pa, ar1 = *(const f32x4*)(pa + 4), ai0 = *(const f32x4*)(pa + 2 * 33 * 64), ai1 = *(const f32x4*)(pa + 2 * 33 * 64 + 4);
            const f32x4 v0 = ri == 0 ? (cr0 * ar0 - ci0 * ai0) : -(cr0 * ai0 + ci0 * ar0), v1 = ri == 0 ? (cr1 * ar1 - ci1 * ai1) : -(cr1 * ai1 + ci1 * ar1);
            *(uint4*)(TC + (size_t)n * 768 + 512 + kq * 8) = pack8(v0, v1);
        }
        for (int ch = tid; ch < 64 * 64; ch += NT) {
            const int n = sub * 64 + (ch >> 6), kc = ch & 63, dir = n >> 7, ri = (n >> 6) & 1, p = n & 63, i = kc >> 1, c0 = (kc & 1) * 8;
            const int tau = dir == 0 ? S5T - 1 - i : i;
            const float ar = sApr[(dir * 33 + tau) * 64 + p], ai = sApi[(dir * 33 + tau) * 64 + p];
            float v[8];
#pragma unroll
            for (int e = 0; e < 8; ++e) { const float br_ = sBr[(dir * 64 + p) * 16 + c0 + e], bi_ = sBi[(dir * 64 + p) * 16 + c0 + e];
                v[e] = ri == 0 ? (ar * br_ - ai * bi_) : (ar * bi_ + ai * br_); }
            uint4 w; w.x = pk2(v[0], v[1]); w.y = pk2(v[2], v[3]); w.z = pk2(v[4], v[5]); w.w = pk2(v[6], v[7]);
            *(uint4*)(TE + (size_t)n * 512 + kc * 8) = w;
        }
    }
}
__device__ __forceinline__ void ph_s5_scan(const Ctx& C0, int l) {
    PHASE_CTX(C0);
    const int lane = C.lane;
    const float* HL = WSP(float, W_HLOC); bf16_t* UH = WSP(bf16_t, W_UH);
    for (int w0 = C.bid * NWAVE + C.wave; w0 < 36 * 64; w0 += C.G * NWAVE) {
        const int w = (w0 + 36 * 64 - 512) % (36 * 64);
        const int dir = w & 1, g = (w >> 1) & 31, s = 35 - (w >> 6);
        const bool latent = s >= 32;
        const int nch = latent ? 64 : 8, ch0 = latent ? 256 + (s - 32) * 64 : s * 8;
        const float* at = WSP(float, W_ATAB) + ((((size_t)l * 32 + g) * 2 + dir) * 64 + lane) * 2;
        const float ar = at[0], ai = at[1];
        float hr = 0.f, hi = 0.f;
        if (latent) { const float* si = c_state_s5 + ((((size_t)(s - 32) * 2 + l) * 2 + dir) * 2) * 2048 + g * 64 + lane; hr = si[0]; hi = si[2048]; }
#pragma unroll 1
        for (int n0 = 0; n0 < nch; n0 += 8) {
            float lr_[8], li_[8];
#pragma unroll
            for (int b = 0; b < 8; ++b) { const int ch = ch0 + (dir == 0 ? n0 + b : nch - 1 - n0 - b);
                const float* hl = HL + ((size_t)g * 512 + ch) * 256 + dir * 128 + lane; lr_[b] = hl[0]; li_[b] = hl[64]; }
#pragma unroll
            for (int b = 0; b < 8; ++b) { const int ch = ch0 + (dir == 0 ? n0 + b : nch - 1 - n0 - b);
                bf16_t* uh = UH + ((size_t)g * 512 + ch) * 768 + 512 + dir * 128 + lane;
                uh[0] = f2bf(hr); uh[64] = f2bf(hi);
                const float nr = ar * hr - ai * hi + lr_[b], ni = ar * hi + ai * hr + li_[b];
                hr = nr; hi = ni; }
        }
        if (!latent) { float* so = c_out + O_NS + ((((size_t)s * 2 + l) * 2 + dir) * 2) * 2048 + g * 64 + lane; so[0] = hr; so[2048] = hi; }
    }
}
struct ZOrder {
    int nz, nM, nN, G, c;
    static constexpr bool HALF = false;
    __device__ bool next(int i, pg8::Unit& u) const { const int L = i * G + c; if (c >= G || L >= nz * nM * nN) return false; u.h = 0; u.z = L / (nM * nN); const int r = L % (nM * nN); u.pm = r % nM; u.pn = r / nM; return true; }
    __device__ __forceinline__ void a_ready(const pg8::Unit&) const {}
    __device__ __forceinline__ void done(const pg8::Unit&) const {}
};
struct EpiHloc {
    static constexpr bool PERM = true, AFTER_DRAIN = false;
    float* HL;
    __device__ __forceinline__ void operator()(const f32x4 (&acc)[2][2][4][2], const pg8::Unit& u, int wr, int wc, int fr_, int fq_) const {
        int fr = fr_, fq = fq_; asm volatile("" : "+v"(fr), "+v"(fq));
        const int rowb = u.pm * 256 + wr * 64 + fr, cb = 32 * wc + 8 * fq;
#pragma unroll
        for (int ai = 0; ai < 2; ++ai)
#pragma unroll
            for (int m = 0; m < 4; ++m) { const int row = rowb + ai * 128 + m * 16;
#pragma unroll
                for (int bj = 0; bj < 2; ++bj) { float* o = HL + ((size_t)u.z * 512 + row) * 256 + 128 * bj + cb; *(f32x4*)o = acc[ai][bj][m][0]; *(f32x4*)(o + 4) = acc[ai][bj][m][1]; } }
    }
};
struct EpiS5Y {
    static constexpr bool PERM = true, AFTER_DRAIN = false;
    bf16_t* YC;
    __device__ __forceinline__ void operator()(const f32x4 (&acc)[2][2][4][2], const pg8::Unit& u, int wr, int wc, int fr_, int fq_) const {
        int fr = fr_, fq = fq_; asm volatile("" : "+v"(fr), "+v"(fq));
        const int rowb = u.pm * 256 + wr * 64 + fr, g = u.z;
#pragma unroll
        for (int ai = 0; ai < 2; ++ai)
#pragma unroll
            for (int m = 0; m < 4; ++m) { const int chunk = rowb + ai * 128 + m * 16;
#pragma unroll
                for (int bj = 0; bj < 2; ++bj) { const int n = u.pn * 256 + 128 * bj + 32 * wc + 8 * fq, j = n >> 4, o0 = n & 15;
                    f32x4 a = acc[ai][bj][m][0], b = acc[ai][bj][m][1];
#pragma unroll
                    for (int e = 0; e < 4; ++e) { a[e] = gelu_tanh(a[e]); b[e] = gelu_tanh(b[e]); }
                    *(uint4*)(YC + ((size_t)chunk * 32 + j) * 512 + g * 16 + o0) = pack8(a, b); } }
    }
};
template <class Epi, class Sched>
__device__ __forceinline__ void run_gemm(const Ctx& C, const bf16_t* A, const bf16_t* Bt, int N, int K, size_t za, size_t zb, const Sched& S, const Epi& E, int lda = 0, int ldb = 0) {
    __syncthreads();
    pg8::Gemm g{A, Bt, M, N, K, za, zb, lda ? lda : K, ldb ? ldb : K};
    pg8::gemm_phase<Epi, Sched, true, true>((LAS unsigned char*)C.lds, g, S, E);
}

#define LAYER_PTRS() const float* MODl = c_MOD + (size_t)l * 5 * 6144; const float* xin0 = l == 0 ? c_x_prompt : c_X; const float* xin1 = l == 0 ? c_x_sample : c_X + (size_t)NPROMPT * D; \
    unsigned char* wb = WS_ + W_WB + (size_t)l * WB_LAYER; (void)MODl; (void)xin0; (void)xin1; (void)wb
__device__ __forceinline__ void g_norm1(const Ctx& C0, int l) { PHASE_CTX(C0); LAYER_PTRS(); if (l == 0) ph_norm(C, c_x_prompt, c_x_sample, false, c_norm1_g + l * 1024, MODl, 0); else ph_norm(C, WSP(bf16_t, W_XB0), WSP(bf16_t, W_XB1), true, c_norm1_g + l * 1024, MODl, 0); }
__device__ __forceinline__ void g_norm2(const Ctx& C0, int l) { PHASE_CTX(C0); LAYER_PTRS(); ph_norm(C, WSP(bf16_t, W_XB0), WSP(bf16_t, W_XB1), true, c_norm2_g + l * 1024, MODl, 1); }
__device__ __forceinline__ void g_inproj(const Ctx& C0, int l) { PHASE_CTX(C0); LAYER_PTRS();
    EpiIn e{WS_, OUT_, c_qn_g + l * 64, c_kn_g + l * 64, l, 0}; pg8::StaticOrder S; S.init(M, 3840, C.G, C.bid);
    run_gemm(C, c_XN, (const bf16_t*)(wb + WB_WI), 3840, 1024, 0, 0, S, e); }
__device__ __forceinline__ void g_s5a(const Ctx& C0, int l) { PHASE_CTX(C0);
    EpiHloc e{WSP(float, W_HLOC)}; ZOrder S{32, 2, 1, C.G, C.bid};
    run_gemm(C, WSP(bf16_t, W_UH), (const bf16_t*)(s5_tab(WS_, l) + TAB_TE), 256, 512, (size_t)512 * 768 * 2, TE_BYTES, S, e, 768, 512); }
__device__ __forceinline__ void g_s5c(const Ctx& C0, int l) { PHASE_CTX(C0);
    EpiS5Y e{c_YF}; ZOrder S{32, 2, 2, C.G, C.bid};
    run_gemm(C, WSP(bf16_t, W_UH), (const bf16_t*)(s5_tab(WS_, l) + TAB_TC), 512, 768, (size_t)512 * 768 * 2, TC_BYTES, S, e, 768, 768); }
__device__ __forceinline__ void g_glu(const Ctx& C0, int l) { PHASE_CTX(C0); LAYER_PTRS();
    EpiGlu e{c_OC, c_s5_b_glu + (size_t)l * 1024}; pg8::StaticOrder S; S.init(M, 1024, C.G, C.bid);
    run_gemm(C, c_YF, (const bf16_t*)(wb + WB_WG), 1024, 512, 0, 0, S, e); }
__device__ __forceinline__ void g_gates(const Ctx& C0, int l) { PHASE_CTX(C0); LAYER_PTRS();
    EpiGate e{c_GATES}; pg8::StaticOrder S; S.init(M, 3072, C.G, C.bid);
    run_gemm(C, c_XN, (const bf16_t*)(wb + WB_WZ), 3072, 1024, 0, 0, S, e); }
__device__ __forceinline__ void g_branch(const Ctx& C0, int l) { PHASE_CTX(C0); LAYER_PTRS();
    EpiBranch e{c_GATES, c_MERGED}; BranchOrder S; S.S.init(M, 1024, C.G, C.bid);
    run_gemm(C, c_OA, (const bf16_t*)(wb + WB_WR), 1024, 512, (size_t)M * 512 * 2, (size_t)1024 * 512 * 2, S, e); }
__device__ __forceinline__ void g_out(const Ctx& C0, int l) { PHASE_CTX(C0); LAYER_PTRS();
    EpiRes e{WSP(bf16_t, W_XB0), WSP(bf16_t, W_XB1), WSP(bf16_t, W_XB0), WSP(bf16_t, W_XB1), MODl + 2048, 1, 1};
    if (l == 0) { e.x0 = c_x_prompt; e.x1 = c_x_sample; e.in_bf16 = 0; }
    pg8::StaticOrder S; S.init(M, 1024, C.G, C.bid);
    run_gemm(C, c_MERGED, (const bf16_t*)(wb + WB_WO), 1024, 1024, 0, 0, S, e); }
__device__ __forceinline__ void g_ffn(const Ctx& C0, int l) { PHASE_CTX(C0); LAYER_PTRS();
    EpiFfn e{c_H}; FfnOrder S; S.S.init(M, 5632, C.G, C.bid);
    run_gemm(C, c_XN, (const bf16_t*)(wb + WB_WU), 5632, 1024, 0, 0, S, e); }
__device__ __forceinline__ void g_down(const Ctx& C0, int l) { PHASE_CTX(C0); LAYER_PTRS();
    EpiRes e{WSP(bf16_t, W_XB0), WSP(bf16_t, W_XB1), WSP(bf16_t, W_XB0), WSP(bf16_t, W_XB1), MODl + 5120, 1, 1};
    if (l == 1) { e.o0 = c_X; e.o1 = c_X + (size_t)NPROMPT * D; e.out_bf16 = 0; }
    pg8::StaticOrder S; S.init(M, 1024, C.G, C.bid);
    run_gemm(C, c_H, (const bf16_t*)(wb + WB_WD), 1024, FFN, 0, 0, S, e); }

__global__ void __launch_bounds__(NT, 2) mk_fwd(Params P_unused) {
    extern __shared__ __attribute__((aligned(16))) unsigned char lds[];
    Ctx C;
    C.lds = lds; C.tid = threadIdx.x; C.lane = C.tid & 63; C.wave = __builtin_amdgcn_readfirstlane(C.tid >> 6); C.G = gridDim.x; C.bid = blockIdx.x;
    volatile LAS unsigned* MISCL = (volatile LAS unsigned*)((LAS unsigned char*)lds + LDS_MISC);
    if (C.tid < 64) MISCL[C.tid] = 0u;
    __syncthreads();
    XcdBarrier bar;
    { KArgPtr Pk = kargs(); bar = xcd_barrier_post((unsigned*)(WS_ + W_CTL) + 1024, MISCL + 8); }
#define GRID_BAR() xcd_barrier(bar)

#ifndef DUP
#define DUP -1
#endif
#define RUN(id, stmt) do { stmt; if (DUP == (id)) { stmt; } } while (0)
    RUN(0, ph_s5_tables<0>(C); ph_mod(C); ph_prep(C); ph_wconv(C));
    if (DUP == 30) ph_s5_tables<0>(C); if (DUP == 31) ph_mod(C); if (DUP == 32) ph_wconv(C);
    GRID_BAR();
#pragma unroll 1
    for (int l0 = 0; l0 < 2; ++l0) {
        const int l = launder_s(l0);
        if (l == 0) { RUN(33, ph_s5_tables<1>(C)); }
        RUN(1, g_norm1(C, l));
        GRID_BAR();
        RUN(2, g_inproj(C, l)); ph_cache(C, l, C.G - C.G / 4);
        GRID_BAR();
        RUN(3, ph_gla_prep(C, l)); RUN(4, g_s5a(C, l));
        GRID_BAR();
        RUN(5, ph_gla_scan(C, l)); RUN(6, ph_s5_scan(C, l)); RUN(7, ph_attn(C, l, 256, 512)); if (DUP == 16) ph_attn(C, l, 0, 256); if (DUP == 17) ph_attn(C, l, 256, 512);
        if (DUP >= 21 && DUP <= 26) ph_attn<DUP - 20>(C, l, 256, 512);
        GRID_BAR();
        RUN(8, ph_gla_out(C, l)); RUN(9, g_s5c(C, l));
        if (C.G == 256) { __syncthreads(); ph_attn(C, l, 0, 256, 128); } else ph_attn(C, l, 0, 256);
        GRID_BAR();
        RUN(10, g_glu(C, l)); RUN(11, g_gates(C, l));
        GRID_BAR();
        RUN(12, g_branch(C, l));
        GRID_BAR();
        g_out(C, l);
        GRID_BAR();
        RUN(13, g_norm2(C, l));
        GRID_BAR();
        RUN(14, g_ffn(C, l));
        GRID_BAR();
        g_down(C, l);
        GRID_BAR();
        if (DUP == 15) { for (int q = 0; q < 10; ++q) GRID_BAR(); }
    }
}

extern "C" void kernel_launch(void* const* d_in, const int* in_sizes, int n_in, void* d_out, int out_size, void* d_ws, size_t ws_size, hipStream_t stream) {
    static int grid = 0;
    if (grid == 0) {
        if (n_in != 35 || ws_size < W_END) { fprintf(stderr, "kernel_launch: unexpected n_in %d / ws %zu\n", n_in, ws_size); grid = -1; return; }
        int dev = 0, cus = 0, per_cu = 0;
        if (hipGetDevice(&dev) != hipSuccess || hipDeviceGetAttribute(&cus, hipDeviceAttributeMultiprocessorCount, dev) != hipSuccess) { grid = -1; return; }
        if (hipFuncSetAttribute((const void*)mk_fwd, hipFuncAttributeMaxDynamicSharedMemorySize, LDS_BYTES) != hipSuccess) { fprintf(stderr, "kernel_launch: hipFuncSetAttribute failed\n"); grid = -1; return; }
        if (hipOccupancyMaxActiveBlocksPerMultiprocessor(&per_cu, (const void*)mk_fwd, NT, LDS_BYTES) != hipSuccess || per_cu < 1) { fprintf(stderr, "kernel_launch: occupancy query says %d\n", per_cu); per_cu = 1; }
        (void)hipGetLastError();
        grid = cus;
    }
    if (grid < 0) return;
    (void)hipMemsetAsync((char*)d_ws + W_CTL, 0, CTL_BYTES, stream);
    Params p{};
    for (int i = 0; i < 35; ++i) p.in[i] = (const float*)d_in[i];
    p.out = (float*)d_out; p.ws = (unsigned char*)d_ws;
    hipLaunchKernelGGL(mk_fwd, dim3(grid), dim3(NT), LDS_BYTES, stream, p);
}
```
